# Optimizing an MI355X kernel written in HIP

```python
import math
import jax, jax.numpy as jnp
from jax import lax
import numpy as np

D_MODEL = 1024
BATCH = 4
SEQ = 4096
DEPTH = 2

D_MIX = D_MODEL
N_MIXERS = 4
D_GROUP = D_MIX // N_MIXERS
HEADS_PER_MIXER = 4
HEAD_DIM = D_GROUP // HEADS_PER_MIXER
CHUNK = 128
CONF_KERNEL = 31
POOL_WINDOWS = (2, 4, 8, 16)
SHORT_KERNEL = 3
N_EXPERTS = 16
N_EXPERT_GROUPS = 4
EXPERTS_PER_GROUP = N_EXPERTS // N_EXPERT_GROUPS
TOP_K = 2
D_EXPERT = 512
D_IN_GMLP = 2 * D_GROUP
D_IN_CONF = 2 * D_GROUP
D_IN_POOL = D_GROUP
D_IN_SCONV = 3 * D_GROUP
D_IN = D_IN_GMLP + D_IN_CONF + D_IN_POOL + D_IN_SCONV
ALPHA = (2 * DEPTH) ** 0.25
BETA = (8 * DEPTH) ** -0.25
LN_EPS = 1e-5
RMS_EPS = 1e-6

kernel_name = "hybrid_gmlp_conformer_pool_shortconv_sharedrouter_moe"


def layer_norm(x, g, b):
    xf = x.astype(jnp.float32)
    mu = jnp.mean(xf, -1, keepdims=True)
    var = jnp.mean(jnp.square(xf - mu), -1, keepdims=True)
    y = (xf - mu) * lax.rsqrt(var + LN_EPS)
    return (y * g.astype(jnp.float32) + b.astype(jnp.float32)).astype(x.dtype)


def group_rms_norm(y, g):
    B_, S_, _ = y.shape
    yf = y.astype(jnp.float32).reshape(B_, S_, N_MIXERS, D_GROUP)
    yf = yf * lax.rsqrt(jnp.mean(jnp.square(yf), -1, keepdims=True) + RMS_EPS)
    return (yf.reshape(B_, S_, D_MIX) * g.astype(jnp.float32)).astype(y.dtype)


def causal_depthwise_conv(x, w):
    K, C = w.shape
    return lax.conv_general_dilated(
        x, w[:, None, :].astype(x.dtype), window_strides=(1,),
        padding=[(K - 1, 0)], dimension_numbers=('NWC', 'WIO', 'NWC'),
        feature_group_count=C)


def spatial_gating_mixer(z, ln_g, ln_b, w_s, b_s):
    u, v = jnp.split(z, 2, axis=-1)
    v = layer_norm(v, ln_g, ln_b)
    B_, S_, _ = v.shape
    v = v.reshape(B_, S_ // CHUNK, CHUNK, HEADS_PER_MIXER, HEAD_DIM)
    mask = jnp.tril(jnp.ones((CHUNK, CHUNK), dtype=bool))
    w = jnp.where(mask, w_s, 0).astype(v.dtype)
    s = jnp.einsum('hts,bnshd->bnthd', w, v) + b_s.T[:, :, None].astype(v.dtype)
    return u * s.reshape(B_, S_, D_GROUP)


def conformer_conv_mixer(z, dw_w, dw_b, ln_g, ln_b, pw):
    a, g = jnp.split(z, 2, axis=-1)
    h = a * jax.nn.sigmoid(g)
    h = causal_depthwise_conv(h, dw_w) + dw_b.astype(h.dtype)
    h = jax.nn.silu(layer_norm(h, ln_g, ln_b))
    return h @ pw


def multiscale_pool_mixer(z, w_grp, scale):
    B_, S_, _ = z.shape
    G = len(POOL_WINDOWS)
    zg = z.astype(jnp.float32).reshape(B_, S_, G, HEAD_DIM)
    csum = jnp.pad(jnp.cumsum(zg, axis=1), ((0, 0), (1, 0), (0, 0), (0, 0)))
    windows = jnp.array(POOL_WINDOWS, dtype=jnp.int32)
    t = jnp.arange(S_, dtype=jnp.int32)[:, None]
    lo_idx = jnp.maximum(t + 1 - windows, 0)
    window_sum = csum[:, 1:] - csum[:, lo_idx, jnp.arange(G)]
    count = jnp.minimum(t + 1, windows).astype(jnp.float32)
    pooled = (window_sum / count[None, :, :, None] - zg).astype(z.dtype)
    y = jnp.einsum('bsgd,gde->bsge', pooled, w_grp).reshape(B_, S_, D_GROUP)
    return y * scale


def short_gated_conv_mixer(z, conv_w):
    b_gate, c_gate, h = jnp.split(z, 3, axis=-1)
    return b_gate * causal_depthwise_conv(c_gate * h, conv_w)


def hybrid_mixer(x, w_in, gm_ln_g, gm_ln_b, gm_w_s, gm_b_s, cf_dw_w, cf_dw_b,
                 cf_ln_g, cf_ln_b, cf_pw, pool_w, pool_scale, sc_w, mix_norm_g, w_o):
    z = x @ w_in
    o1 = D_IN_GMLP
    o2 = o1 + D_IN_CONF
    o3 = o2 + D_IN_POOL
    z_a, z_b, z_c, z_d = z[..., :o1], z[..., o1:o2], z[..., o2:o3], z[..., o3:]
    y = jnp.concatenate([
        spatial_gating_mixer(z_a, gm_ln_g, gm_ln_b, gm_w_s, gm_b_s),
        conformer_conv_mixer(z_b, cf_dw_w, cf_dw_b, cf_ln_g, cf_ln_b, cf_pw),
        multiscale_pool_mixer(z_c, pool_w, pool_scale),
        short_gated_conv_mixer(z_d, sc_w),
    ], axis=-1)
    return group_rms_norm(y, mix_norm_g) @ w_o


def grouped_moe(x, router_w, router_b, w_gate, w_up, w_down):
    B_, S_, D = x.shape
    xt = x.reshape(-1, D)
    logits = (xt @ router_w).astype(jnp.float32)
    sel = logits + router_b.astype(jnp.float32)
    grp = sel.reshape(-1, N_EXPERT_GROUPS, EXPERTS_PER_GROUP)
    grp_score = lax.top_k(grp, TOP_K)[0].sum(-1)
    best = jnp.argmax(grp_score, axis=-1)
    in_group = (jnp.arange(N_EXPERTS) // EXPERTS_PER_GROUP)[None, :] == best[:, None]
    masked = jnp.where(in_group, sel, -jnp.inf)
    _, idx = lax.top_k(masked, TOP_K)
    gates = jax.nn.softmax(jnp.take_along_axis(logits, idx, axis=-1), axis=-1)
    dense_gates = (jax.nn.one_hot(idx, N_EXPERTS, dtype=jnp.float32) * gates[..., None]).sum(1)
    y = jnp.zeros(xt.shape, jnp.float32)
    for e in range(N_EXPERTS):
        h = jax.nn.silu(xt @ w_gate[e]) * (xt @ w_up[e])
        y = y + dense_gates[:, e:e + 1] * (h @ w_down[e]).astype(jnp.float32)
    return y.astype(x.dtype).reshape(B_, S_, D)


def setup_inputs(seed: int = 0) -> dict:
    key = jax.random.key(seed)
    ks = jax.random.split(key, 24)
    L = DEPTH

    def nrm(k, shape, scale):
        return jax.random.normal(k, shape, jnp.float32) * scale

    return {
        "x": nrm(ks[0], (BATCH, SEQ, D_MODEL), 1.0),
        "w_in": nrm(ks[1], (L, D_MODEL, D_IN), D_MODEL ** -0.5),
        "gm_ln_g": 1.0 + nrm(ks[2], (L, D_GROUP), 0.02),
        "gm_ln_b": nrm(ks[3], (L, D_GROUP), 0.02),
        "gm_w_s": nrm(ks[4], (L, HEADS_PER_MIXER, CHUNK, CHUNK), CHUNK ** -0.5),
        "gm_b_s": 1.0 + nrm(ks[5], (L, HEADS_PER_MIXER, CHUNK), 0.02),
        "cf_dw_w": nrm(ks[6], (L, CONF_KERNEL, D_GROUP), CONF_KERNEL ** -0.5),
        "cf_dw_b": nrm(ks[7], (L, D_GROUP), 0.02),
        "cf_ln_g": 1.0 + nrm(ks[8], (L, D_GROUP), 0.02),
        "cf_ln_b": nrm(ks[9], (L, D_GROUP), 0.02),
        "cf_pw": nrm(ks[10], (L, D_GROUP, D_GROUP), D_GROUP ** -0.5),
        "pool_w": nrm(ks[11], (L, len(POOL_WINDOWS), HEAD_DIM, HEAD_DIM), HEAD_DIM ** -0.5),
        "pool_scale": 1.0 + nrm(ks[12], (L, D_GROUP), 0.02),
        "sc_w": nrm(ks[13], (L, SHORT_KERNEL, D_GROUP), SHORT_KERNEL ** -0.5),
        "mix_norm_g": 1.0 + nrm(ks[14], (L, D_MIX), 0.02),
        "w_o": nrm(ks[15], (L, D_MIX, D_MODEL), BETA * D_MIX ** -0.5),
        "ln1_g": 1.0 + nrm(ks[16], (L, D_MODEL), 0.02),
        "ln1_b": nrm(ks[17], (L, D_MODEL), 0.02),
        "router_w": nrm(ks[18], (D_MODEL, N_EXPERTS), D_MODEL ** -0.5),
        "router_b": nrm(ks[19], (N_EXPERTS,), 0.01),
        "exp_w_gate": nrm(ks[20], (L, N_EXPERTS, D_MODEL, D_EXPERT), D_MODEL ** -0.5),
        "exp_w_up": nrm(ks[21], (L, N_EXPERTS, D_MODEL, D_EXPERT), D_MODEL ** -0.5),
        "exp_w_down": nrm(ks[22], (L, N_EXPERTS, D_EXPERT, D_MODEL), BETA * D_EXPERT ** -0.5),
        "ln2_g": 1.0 + nrm(ks[23], (L, D_MODEL), 0.02),
        "ln2_b": nrm(jax.random.fold_in(ks[23], 1), (L, D_MODEL), 0.02),
    }


def reference(x, w_in, gm_ln_g, gm_ln_b, gm_w_s, gm_b_s, cf_dw_w, cf_dw_b, cf_ln_g,
              cf_ln_b, cf_pw, pool_w, pool_scale, sc_w, mix_norm_g, w_o, ln1_g, ln1_b,
              router_w, router_b, exp_w_gate, exp_w_up, exp_w_down, ln2_g, ln2_b):
    for l in range(DEPTH):
        m = hybrid_mixer(x, w_in[l], gm_ln_g[l], gm_ln_b[l], gm_w_s[l], gm_b_s[l],
                         cf_dw_w[l], cf_dw_b[l], cf_ln_g[l], cf_ln_b[l], cf_pw[l],
                         pool_w[l], pool_scale[l], sc_w[l], mix_norm_g[l], w_o[l])
        x = layer_norm(ALPHA * x + m, ln1_g[l], ln1_b[l])
        f = grouped_moe(x, router_w, router_b, exp_w_gate[l], exp_w_up[l], exp_w_down[l])
        x = layer_norm(ALPHA * x + f, ln2_g[l], ln2_b[l])
    return x
```

```cpp
#include <hip/hip_runtime.h>
#include <cstdio>
#include <cstdint>

#ifndef MK_ONE_LAUNCH
#define MK_ONE_LAUNCH 0
#endif

constexpr int NB = 4, SEQ = 4096, DM = 1024, M = NB * SEQ, DIN = 2048, NE = 16, DE = 512, NL = 2;
constexpr int DG = 256, CHUNK = 128, CONFK = 31;
constexpr float ALPHA = 1.41421356237309515f;
constexpr float LN_EPS = 1e-5f, RMS_EPS = 1e-6f;
constexpr int NWAVES = 8, NT = NWAVES * 64;
constexpr int LDS_BYTES = 147456;

typedef unsigned short bf16;
typedef float f32x4 __attribute__((ext_vector_type(4)));
typedef unsigned u32x4 __attribute__((ext_vector_type(4)));
typedef unsigned u32x2 __attribute__((ext_vector_type(2)));
#define LAS __attribute__((address_space(3)))
#define GAS __attribute__((address_space(1)))
typedef GAS unsigned gu32;
#define RLX_AGENT __ATOMIC_RELAXED, __HIP_MEMORY_SCOPE_AGENT

constexpr size_t MiB = 1u << 20;
constexpr size_t WS_CTL = 0, CTL_ZERO_BYTES = 1 * MiB;
constexpr size_t WS_Z = 1 * MiB;
constexpr size_t WS_XB = 65 * MiB;
constexpr size_t WS_YN = 97 * MiB;
constexpr size_t WS_Y = 129 * MiB;
constexpr size_t WS_U = 193 * MiB;
constexpr size_t WS_VN = WS_U, WS_CV = WS_U + 16 * MiB, WS_PL = WS_U + 32 * MiB, WS_ACT = WS_U + 48 * MiB;
constexpr size_t WS_RT = 257 * MiB;
constexpr size_t WS_END = 258 * MiB;
constexpr int CW_BAR = 4096;

__device__ __forceinline__ float bf2f(bf16 v) { return __uint_as_float(((unsigned)v) << 16); }
__device__ __forceinline__ unsigned f2bf(float f) { unsigned u = __float_as_uint(f); return (u + 0x7fffu + ((u >> 16) & 1u)) >> 16; }
__device__ __forceinline__ unsigned pk2(float lo, float hi) { return f2bf(lo) | (f2bf(hi) << 16); }
__device__ __forceinline__ float sigmoidf_(float x) { return 1.0f / (1.0f + __expf(-x)); }
__device__ __forceinline__ float siluf_(float x) { return x * sigmoidf_(x); }
__device__ __forceinline__ float wave_sum(float v) {
#pragma unroll
    for (int o = 1; o < 64; o <<= 1) v += __shfl_xor(v, o);
    return v;
}

#define XB_TMO      128
#define XB_XCNT(j)  (256  + 64 * (j))
#define XB_XSUB(j)  (1280 + 64 * (j))
#define XB_XGEN(j)  (2304 + 64 * (j))
#define XB_TOP      3328
#define XB_TOPGEN   3392
#define XCD_BAR_WORDS 3456
#define XB_SPIN_CAP (1u << 18)
__device__ __forceinline__ unsigned xb_ld(unsigned* p)              { return __hip_atomic_load(p, __ATOMIC_RELAXED, __HIP_MEMORY_SCOPE_AGENT); }
__device__ __forceinline__ unsigned xb_add(unsigned* p, unsigned v) { return __hip_atomic_fetch_add(p, v, __ATOMIC_RELAXED, __HIP_MEMORY_SCOPE_AGENT); }
__device__ __forceinline__ unsigned xb_xcc_id() { return (unsigned)__builtin_amdgcn_s_getreg((3 << 11) | 20) & 0xFu; }
#define XB_SPIN(cond, bar) do { unsigned _sp = 0; while (cond) { __builtin_amdgcn_s_sleep(1); \
    if ((++_sp & 255u) == 0u) { if (xb_ld(&(bar)[XB_TMO])) break; if (_sp > XB_SPIN_CAP) { atomicAdd(&(bar)[XB_TMO], 1u); break; } } } } while (0)
struct XcdBarrier { unsigned* bar; unsigned x; volatile LAS unsigned* st; };
__device__ __forceinline__ XcdBarrier xcd_barrier_post(unsigned* bar, volatile LAS unsigned* st) {
    XcdBarrier b; b.bar = bar; b.x = xb_xcc_id(); b.st = st;
    if (threadIdx.x == 0) (void)xb_add(&bar[XB_XCNT(b.x)], 1u);
    return b;
}
__device__ __forceinline__ void xcd_barrier_complete(unsigned* bar, unsigned x, unsigned& nloc, unsigned& nx) {
    const unsigned G = gridDim.x * gridDim.y * gridDim.z;
    unsigned sum, cnt, mine, sp = 0u;
    for (;;) {
        sum = 0u; cnt = 0u; mine = 0u;
#pragma unroll
        for (unsigned j = 0; j < 16; ++j) { const unsigned c = xb_ld(&bar[XB_XCNT(j)]); sum += c; cnt += (c > 0u) ? 1u : 0u; mine = (j == x) ? c : mine; }
        if (sum == G) break;
        __builtin_amdgcn_s_sleep(1);
        if ((++sp & 255u) == 0u) { if (xb_ld(&bar[XB_TMO])) break; if (sp > XB_SPIN_CAP) { atomicAdd(&bar[XB_TMO], 1u); break; } }
    }
    nloc = mine > 0u ? mine : 1u; nx = cnt > 0u ? cnt : 1u;
}
__device__ __forceinline__ void xcd_barrier(const XcdBarrier& b) {
    asm volatile("s_waitcnt vmcnt(0)" ::: "memory");
    __syncthreads();
    if (threadIdx.x == 0) {
        unsigned* bar = b.bar;
        __builtin_amdgcn_s_waitcnt(0);
        unsigned nloc = b.st[0], nx = b.st[1];
        if (nloc == 0u) { xcd_barrier_complete(bar, b.x, nloc, nx); b.st[0] = nloc; b.st[1] = nx; }
        const unsigned old = xb_add(&bar[XB_XSUB(b.x)], 1u);
        const unsigned gen = old / nloc;
        if (old + 1u == (gen + 1u) * nloc) {
            __builtin_amdgcn_fence(__ATOMIC_RELEASE, "agent");
            asm volatile("s_waitcnt vmcnt(0)" ::: "memory");
            const unsigned og = xb_add(&bar[XB_TOP], 1u);
            const unsigned tg = og / nx;
            if (og + 1u == (tg + 1u) * nx) xb_add(&bar[XB_TOPGEN], 1u);
            else XB_SPIN(xb_ld(&bar[XB_TOPGEN]) == tg, bar);
            __builtin_amdgcn_fence(__ATOMIC_ACQUIRE, "agent");
            xb_add(&bar[XB_XGEN(b.x)], 1u);
            asm volatile("s_waitcnt vmcnt(0)" ::: "memory");
        } else {
            XB_SPIN(xb_ld(&bar[XB_XGEN(b.x)]) == gen, bar);
            __builtin_amdgcn_fence(__ATOMIC_ACQUIRE, "agent");
            asm volatile("s_waitcnt vmcnt(0)" ::: "memory");
        }
    }
    __syncthreads();
}

struct Args { const float* in[25]; float* out; unsigned char* ws; int ph_lo, ph_hi; };

struct Ctx {
    int tid, lane, wave, gtid, gsize, gw, ngw;
    LAS unsigned char* lds;
};

template <class Epi>
__device__ __forceinline__ void nv_gemm(const Ctx& c, const bf16* A, int lda, const float* W, int ldw, int Mr, int N, int K, const Epi& epi) {
    const int ntn = N / 4; const long total = (long)ntn * (Mr / 4);
    for (long i = c.gtid; i < total; i += c.gsize) {
        const int tn = (int)(i % ntn), tm = (int)(i / ntn);
        float acc[4][4];
#pragma unroll
        for (int r = 0; r < 4; ++r)
#pragma unroll
            for (int q = 0; q < 4; ++q) acc[r][q] = 0.f;
        const bf16* a0 = A + (size_t)(tm * 4) * lda;
        const float* w0 = W + tn * 4;
        for (int k = 0; k < K; k += 8) {
            u32x4 av[4];
#pragma unroll
            for (int r = 0; r < 4; ++r) av[r] = *(const u32x4*)(a0 + (size_t)r * lda + k);
#pragma unroll
            for (int kk = 0; kk < 8; ++kk) {
                const f32x4 w = *(const f32x4*)(w0 + (size_t)(k + kk) * ldw);
#pragma unroll
                for (int r = 0; r < 4; ++r) {
                    const unsigned pr = av[r][kk >> 1];
                    const float a = (kk & 1) ? __uint_as_float(pr & 0xffff0000u) : __uint_as_float(pr << 16);
#pragma unroll
                    for (int q = 0; q < 4; ++q) acc[r][q] += a * w[q];
                }
            }
        }
#pragma unroll
        for (int r = 0; r < 4; ++r) epi(tm * 4 + r, tn * 4, (f32x4){acc[r][0], acc[r][1], acc[r][2], acc[r][3]});
    }
}

__device__ __forceinline__ void ln256(f32x4& v, const float* g, const float* b, int lane) {
    const float mean = wave_sum((v[0] + v[1]) + (v[2] + v[3])) * (1.f / 256.f);
    v = v - mean;
    const float var = wave_sum((v[0] * v[0] + v[1] * v[1]) + (v[2] * v[2] + v[3] * v[3])) * (1.f / 256.f);
    const float rstd = 1.0f / sqrtf(var + LN_EPS);
    const f32x4 gg = *(const f32x4*)(g + lane * 4), bb = *(const f32x4*)(b + lane * 4);
    v = v * rstd * gg + bb;
}
__device__ __forceinline__ f32x4 ld_bf4(const bf16* p) { const u32x2 w = *(const u32x2*)p; return (f32x4){__uint_as_float(w.x << 16), __uint_as_float(w.x & 0xffff0000u), __uint_as_float(w.y << 16), __uint_as_float(w.y & 0xffff0000u)}; }
__device__ __forceinline__ void st_bf4(bf16* p, f32x4 v) { u32x2 w; w.x = pk2(v[0], v[1]); w.y = pk2(v[2], v[3]); *(u32x2*)p = w; }

struct Lw {
    const float *w_in, *gm_ln_g, *gm_ln_b, *gm_w_s, *gm_b_s, *cf_dw_w, *cf_dw_b, *cf_ln_g, *cf_ln_b, *cf_pw, *pool_w, *pool_scale, *sc_w, *mix_norm_g, *w_o, *ln1_g, *ln1_b,
        *router_w, *router_b, *wg, *wu, *wd, *ln2_g, *ln2_b;
};
__device__ __forceinline__ Lw layer_weights(const Args& a, int l) {
    Lw w;
    w.w_in = a.in[1] + (size_t)l * DM * DIN; w.gm_ln_g = a.in[2] + l * DG; w.gm_ln_b = a.in[3] + l * DG; w.gm_w_s = a.in[4] + (size_t)l * 4 * CHUNK * CHUNK; w.gm_b_s = a.in[5] + l * 4 * CHUNK;
    w.cf_dw_w = a.in[6] + l * CONFK * DG; w.cf_dw_b = a.in[7] + l * DG; w.cf_ln_g = a.in[8] + l * DG; w.cf_ln_b = a.in[9] + l * DG; w.cf_pw = a.in[10] + (size_t)l * DG * DG;
    w.pool_w = a.in[11] + l * 4 * 64 * 64; w.pool_scale = a.in[12] + l * DG; w.sc_w = a.in[13] + l * 3 * DG; w.mix_norm_g = a.in[14] + l * DM; w.w_o = a.in[15] + (size_t)l * DM * DM;
    w.ln1_g = a.in[16] + l * DM; w.ln1_b = a.in[17] + l * DM; w.router_w = a.in[18]; w.router_b = a.in[19];
    w.wg = a.in[20] + (size_t)l * NE * DM * DE; w.wu = a.in[21] + (size_t)l * NE * DM * DE; w.wd = a.in[22] + (size_t)l * NE * DE * DM;
    w.ln2_g = a.in[23] + l * DM; w.ln2_b = a.in[24] + l * DM;
    return w;
}

__device__ __forceinline__ void nv_prologue(const Ctx& c, const float* x, bf16* XB) {
    for (size_t i = c.gtid; i < (size_t)M * DM / 4; i += c.gsize) st_bf4(XB + i * 4, *(const f32x4*)(x + i * 4));
}
__device__ __forceinline__ void nv_mix_a(const Ctx& c, const Lw& w, const bf16* Z, float* VN, float* CV, float* PL, float* Y) {
    for (int t = c.gw; t < M; t += c.ngw) {
        f32x4 v = ld_bf4(Z + (size_t)t * DIN + 256 + c.lane * 4);
        ln256(v, w.gm_ln_g, w.gm_ln_b, c.lane);
        *(f32x4*)(VN + (size_t)t * DG + c.lane * 4) = v;
    }
    for (size_t i = c.gtid; i < (size_t)M * DG; i += c.gsize) {
        const int t = (int)(i / DG), ch = (int)(i % DG), pos = t % SEQ;
        {
            float acc = w.cf_dw_b[ch];
            for (int k = 0; k < CONFK; ++k) { const int d = k - (CONFK - 1); if (pos + d >= 0) {
                const float a = bf2f(Z[(size_t)(t + d) * DIN + 512 + ch]), g = bf2f(Z[(size_t)(t + d) * DIN + 768 + ch]);
                acc += w.cf_dw_w[k * DG + ch] * (a * sigmoidf_(g)); } }
            CV[i] = acc;
        }
        {
            const int g = ch >> 6, W = 2 << g, cnt = (pos + 1 < W) ? pos + 1 : W;
            float s = 0.f;
            for (int j = 0; j < cnt; ++j) s += bf2f(Z[(size_t)(t - j) * DIN + 1024 + ch]);
            PL[i] = s / (float)cnt - bf2f(Z[(size_t)t * DIN + 1024 + ch]);
        }
        {
            float acc = 0.f;
            for (int k = 0; k < 3; ++k) { const int d = k - 2; if (pos + d >= 0) {
                const float cg = bf2f(Z[(size_t)(t + d) * DIN + 1536 + ch]), hh = bf2f(Z[(size_t)(t + d) * DIN + 1792 + ch]);
                acc += w.sc_w[k * DG + ch] * (cg * hh); } }
            Y[(size_t)t * DM + 768 + ch] = bf2f(Z[(size_t)t * DIN + 1280 + ch]) * acc;
        }
    }
}
__device__ __forceinline__ void nv_mix_b(const Ctx& c, const Lw& w, const bf16* Z, const float* VN, const float* CV, const float* PL, bf16* ACT, float* Y) {
    for (size_t i = c.gtid; i < (size_t)M * DG; i += c.gsize) {
        const int t = (int)(i / DG), ch = (int)(i % DG);
        {
            const int tl = t % CHUNK, t0 = t - tl, h = ch >> 6;
            float s = w.gm_b_s[h * CHUNK + tl];
            const float* wr = w.gm_w_s + ((size_t)h * CHUNK + tl) * CHUNK;
            for (int sl = 0; sl <= tl; ++sl) s += wr[sl] * VN[(size_t)(t0 + sl) * DG + ch];
            Y[(size_t)t * DM + ch] = bf2f(Z[(size_t)t * DIN + ch]) * s;
        }
        {
            const int g = ch >> 6, e = ch & 63;
            float s = 0.f;
            for (int d = 0; d < 64; ++d) s += PL[(size_t)t * DG + g * 64 + d] * w.pool_w[(g * 64 + d) * 64 + e];
            Y[(size_t)t * DM + 512 + ch] = s * w.pool_scale[ch];
        }
    }
    for (int t = c.gw; t < M; t += c.ngw) {
        f32x4 v = *(const f32x4*)(CV + (size_t)t * DG + c.lane * 4);
        ln256(v, w.cf_ln_g, w.cf_ln_b, c.lane);
        v = (f32x4){siluf_(v[0]), siluf_(v[1]), siluf_(v[2]), siluf_(v[3])};
        st_bf4(ACT + (size_t)t * DG + c.lane * 4, v);
    }
}
struct EpiPw { float* Y; __device__ __forceinline__ void operator()(int r, int cc, f32x4 v) const { *(f32x4*)(Y + (size_t)r * DM + 256 + cc) = v; } };
__device__ __forceinline__ void nv_mix_d(const Ctx& c, const Lw& w, const float* Y, bf16* YN) {
    for (int i = c.gw; i < M * 4; i += c.ngw) {
        const int t = i >> 2, g = i & 3;
        f32x4 v = *(const f32x4*)(Y + (size_t)t * DM + g * DG + c.lane * 4);
        const float ms = wave_sum((v[0] * v[0] + v[1] * v[1]) + (v[2] * v[2] + v[3] * v[3])) * (1.f / 256.f);
        const float r = 1.0f / sqrtf(ms + RMS_EPS);
        v = v * r * *(const f32x4*)(w.mix_norm_g + g * DG + c.lane * 4);
        st_bf4(YN + (size_t)t * DM + g * DG + c.lane * 4, v);
    }
}
struct EpiZ { bf16* Z; __device__ __forceinline__ void operator()(int r, int cc, f32x4 v) const { st_bf4(Z + (size_t)r * DIN + cc, v); } };
struct EpiU { float* U; const float* X; __device__ __forceinline__ void operator()(int r, int cc, f32x4 v) const { *(f32x4*)(U + (size_t)r * DM + cc) = v + ALPHA * *(const f32x4*)(X + (size_t)r * DM + cc); } };

__device__ __forceinline__ void ln1024(f32x4 (&v)[4], const float* g, const float* b, int lane) {
    float s = 0.f;
#pragma unroll
    for (int j = 0; j < 4; ++j) s += (v[j][0] + v[j][1]) + (v[j][2] + v[j][3]);
    const float mean = wave_sum(s) * (1.f / DM);
    float q = 0.f;
#pragma unroll
    for (int j = 0; j < 4; ++j) { v[j] = v[j] - mean; q += (v[j][0] * v[j][0] + v[j][1] * v[j][1]) + (v[j][2] * v[j][2] + v[j][3] * v[j][3]); }
    const float rstd = 1.0f / sqrtf(wave_sum(q) * (1.f / DM) + LN_EPS);
#pragma unroll
    for (int j = 0; j < 4; ++j) v[j] = v[j] * rstd * *(const f32x4*)(g + lane * 4 + 256 * j) + *(const f32x4*)(b + lane * 4 + 256 * j);
}
__device__ __forceinline__ void nv_ln1_router(const Ctx& c, const Lw& w, const float* U, float* X1, unsigned* RTE, float* RTG) {
    for (int t = c.gw; t < M; t += c.ngw) {
        f32x4 v[4];
#pragma unroll
        for (int j = 0; j < 4; ++j) v[j] = *(const f32x4*)(U + (size_t)t * DM + c.lane * 4 + 256 * j);
        ln1024(v, w.ln1_g, w.ln1_b, c.lane);
#pragma unroll
        for (int j = 0; j < 4; ++j) *(f32x4*)(X1 + (size_t)t * DM + c.lane * 4 + 256 * j) = v[j];
        float lg[16];
#pragma unroll
        for (int e = 0; e < 16; ++e) lg[e] = 0.f;
#pragma unroll
        for (int j = 0; j < 4; ++j)
#pragma unroll
            for (int q = 0; q < 4; ++q) {
                const float xv = v[j][q]; const float* wr = w.router_w + (size_t)(c.lane * 4 + 256 * j + q) * NE;
#pragma unroll
                for (int e4 = 0; e4 < 4; ++e4) { const f32x4 ww = *(const f32x4*)(wr + e4 * 4);
                    lg[e4 * 4 + 0] += xv * ww[0]; lg[e4 * 4 + 1] += xv * ww[1]; lg[e4 * 4 + 2] += xv * ww[2]; lg[e4 * 4 + 3] += xv * ww[3]; }
            }
#pragma unroll
        for (int e = 0; e < 16; ++e) lg[e] = wave_sum(lg[e]);
        float best_score = 0.f; int best = -1;
#pragma unroll
        for (int g = 0; g < 4; ++g) {
            float m1 = -INFINITY, m2 = -INFINITY;
#pragma unroll
            for (int j = 0; j < 4; ++j) { const float s = lg[g * 4 + j] + w.router_b[g * 4 + j]; if (s > m1) { m2 = m1; m1 = s; } else if (s > m2) m2 = s; }
            const float sc = m1 + m2;
            if (best < 0 || sc > best_score) { best_score = sc; best = g; }
        }
        float s1 = -INFINITY, s2 = -INFINITY, l1 = 0.f, l2 = 0.f; int i1 = 0, i2 = 0;
#pragma unroll
        for (int e = 0; e < 16; ++e) {
            if ((e >> 2) == best) { const float s = lg[e] + w.router_b[e];
                if (s > s1) { s2 = s1; i2 = i1; l2 = l1; s1 = s; i1 = e; l1 = lg[e]; } else if (s > s2) { s2 = s; i2 = e; l2 = lg[e]; } }
        }
        const float mx = fmaxf(l1, l2), e1 = __expf(l1 - mx), e2 = __expf(l2 - mx), inv = 1.0f / (e1 + e2);
        if (c.lane == 0) { RTE[t] = (unsigned)i1 | ((unsigned)i2 << 8); RTG[2 * t] = e1 * inv; RTG[2 * t + 1] = e2 * inv; }
    }
}
__device__ __forceinline__ void nv_moe(const Ctx& c, const Lw& w, const float* X1, const unsigned* RTE, const float* RTG, float* F) {
    LAS float* xs = (LAS float*)c.lds; LAS float* hs = xs + DM;
    for (int t = blockIdx.x; t < M; t += gridDim.x) {
        __syncthreads();
        xs[c.tid] = X1[(size_t)t * DM + c.tid]; xs[c.tid + 512] = X1[(size_t)t * DM + c.tid + 512];
        __syncthreads();
        const unsigned ee = RTE[t]; float f0 = 0.f, f1 = 0.f;
        for (int k = 0; k < 2; ++k) {
            const int e = (ee >> (8 * k)) & 0xff; const float gk = RTG[2 * t + k];
            const float* wg = w.wg + (size_t)e * DM * DE + c.tid; const float* wu = w.wu + (size_t)e * DM * DE + c.tid;
            float ga = 0.f, ua = 0.f;
            for (int i = 0; i < DM; ++i) { const float xv = xs[i]; ga += xv * wg[(size_t)i * DE]; ua += xv * wu[(size_t)i * DE]; }
            __syncthreads();
            hs[c.tid] = siluf_(ga) * ua;
            __syncthreads();
            const float* wd = w.wd + (size_t)e * DE * DM + c.tid;
            float y0 = 0.f, y1 = 0.f;
            for (int i = 0; i < DE; ++i) { const float hv = hs[i]; y0 += hv * wd[(size_t)i * DM]; y1 += hv * wd[(size_t)i * DM + 512]; }
            f0 += gk * y0; f1 += gk * y1;
        }
        F[(size_t)t * DM + c.tid] = f0; F[(size_t)t * DM + c.tid + 512] = f1;
    }
}
__device__ __forceinline__ void nv_ln2(const Ctx& c, const Lw& w, const float* X1, const float* F, float* X2, bf16* XB) {
    for (int t = c.gw; t < M; t += c.ngw) {
        f32x4 v[4];
#pragma unroll
        for (int j = 0; j < 4; ++j) v[j] = ALPHA * *(const f32x4*)(X1 + (size_t)t * DM + c.lane * 4 + 256 * j) + *(const f32x4*)(F + (size_t)t * DM + c.lane * 4 + 256 * j);
        ln1024(v, w.ln2_g, w.ln2_b, c.lane);
#pragma unroll
        for (int j = 0; j < 4; ++j) { *(f32x4*)(X2 + (size_t)t * DM + c.lane * 4 + 256 * j) = v[j]; st_bf4(XB + (size_t)t * DM + c.lane * 4 + 256 * j, v[j]); }
    }
}

constexpr int PH_PER_LAYER = 9, N_PHASES = 1 + NL * PH_PER_LAYER;
__global__ void __launch_bounds__(NT, 2) fwd_kernel(Args args) {
    extern __shared__ __attribute__((aligned(16))) unsigned char lds_raw[];
    Ctx c;
    c.lds = (LAS unsigned char*)lds_raw;
    c.tid = threadIdx.x; c.lane = c.tid & 63; c.wave = __builtin_amdgcn_readfirstlane(c.tid >> 6);
    c.gtid = blockIdx.x * NT + c.tid; c.gsize = gridDim.x * NT; c.gw = blockIdx.x * NWAVES + c.wave; c.ngw = gridDim.x * NWAVES;
    unsigned char* ws = args.ws;
    volatile LAS unsigned* MISC = (volatile LAS unsigned*)(c.lds + LDS_BYTES - 64);
    if (c.tid < 16) MISC[c.tid] = 0u;
    __syncthreads();
    XcdBarrier bar; bar.bar = (unsigned*)ws + CW_BAR; bar.x = 0; bar.st = nullptr;
    const bool one = (args.ph_hi - args.ph_lo) > 1;
    if (one) bar = xcd_barrier_post((unsigned*)ws + CW_BAR, MISC + 8);
    bf16* Z = (bf16*)(ws + WS_Z); bf16* XB = (bf16*)(ws + WS_XB); bf16* YN = (bf16*)(ws + WS_YN);
    float* Y = (float*)(ws + WS_Y); float* U = (float*)(ws + WS_U);
    float* VN = (float*)(ws + WS_VN); float* CV = (float*)(ws + WS_CV); float* PL = (float*)(ws + WS_PL); bf16* ACT = (bf16*)(ws + WS_ACT);
    unsigned* RTE = (unsigned*)(ws + WS_RT); float* RTG = (float*)(ws + WS_RT + 512 * 1024);
    for (int ph = args.ph_lo; ph < args.ph_hi; ++ph) {
        if (ph == 0) nv_prologue(c, args.in[0], XB);
        else {
            const int l = (ph - 1) / PH_PER_LAYER, p = (ph - 1) % PH_PER_LAYER;
            const Lw w = layer_weights(args, l);
            const float* X = (l == 0) ? args.in[0] : args.out;
            switch (p) {
            case 0: nv_gemm(c, XB, DM, w.w_in, DIN, M, DIN, DM, EpiZ{Z}); break;
            case 1: nv_mix_a(c, w, Z, VN, CV, PL, Y); break;
            case 2: nv_mix_b(c, w, Z, VN, CV, PL, ACT, Y); break;
            case 3: nv_gemm(c, ACT, DG, w.cf_pw, DG, M, DG, DG, EpiPw{Y}); break;
            case 4: nv_mix_d(c, w, Y, YN); break;
            case 5: nv_gemm(c, YN, DM, w.w_o, DM, M, DM, DM, EpiU{U, X}); break;
            case 6: nv_ln1_router(c, w, U, args.out, RTE, RTG); break;
            case 7: nv_moe(c, w, args.out, RTE, RTG, Y); break;
            case 8: nv_ln2(c, w, args.out, Y, args.out, XB); break;
            }
        }
        if (one && ph + 1 < args.ph_hi) xcd_barrier(bar);
    }
}

extern "C" void kernel_launch(void* const* d_in, const int* in_sizes, int n_in, void* d_out, int out_size, void* d_ws, size_t ws_size, hipStream_t stream) {
    static int grid = 0;
    if (grid == 0) {
        if (n_in != 25 || in_sizes[0] != M * DM || out_size != M * DM || ws_size < WS_END) { fprintf(stderr, "kernel_launch: unexpected shapes/ws (n_in %d ws %zu)\n", n_in, ws_size); grid = -1; return; }
        int dev = 0, cus = 0;
        if (hipGetDevice(&dev) != hipSuccess || hipDeviceGetAttribute(&cus, hipDeviceAttributeMultiprocessorCount, dev) != hipSuccess) { grid = -1; return; }
        if (hipFuncSetAttribute((const void*)fwd_kernel, hipFuncAttributeMaxDynamicSharedMemorySize, LDS_BYTES) != hipSuccess) { grid = -1; return; }
        (void)hipGetLastError();
        grid = cus;
    }
    if (grid < 0) return;
    (void)hipMemsetAsync((char*)d_ws + WS_CTL, 0, CTL_ZERO_BYTES, stream);
    Args a{};
    for (int i = 0; i < 25; ++i) a.in[i] = (const float*)d_in[i];
    a.out = (float*)d_out; a.ws = (unsigned char*)d_ws;
#if MK_ONE_LAUNCH
    a.ph_lo = 0; a.ph_hi = N_PHASES;
    hipLaunchKernelGGL(fwd_kernel, dim3(grid), dim3(NT), LDS_BYTES, stream, a);
#else
    for (int ph = 0; ph < N_PHASES; ++ph) { a.ph_lo = ph; a.ph_hi = ph + 1; hipLaunchKernelGGL(fwd_kernel, dim3(grid), dim3(NT), LDS_BYTES, stream, a); }
#endif
}
```

```cpp
#include <hip/hip_runtime.h>
#include <cstdio>
#include <cstdint>

#ifndef MK_ONE_LAUNCH
#define MK_ONE_LAUNCH 1
#endif

constexpr int NB = 4, SEQ = 4096, DM = 1024, M = NB * SEQ, DIN = 2048, NE = 16, DE = 512, NL = 2;
constexpr int DG = 256, CHUNK = 128, CONFK = 31;
constexpr float ALPHA = 1.41421356237309515f;
constexpr float LN_EPS = 1e-5f, RMS_EPS = 1e-6f;
constexpr int NWAVES = 8, NT = NWAVES * 64;
constexpr int LDS_BYTES = 147456;

typedef unsigned short bf16;
typedef float f32x4 __attribute__((ext_vector_type(4)));
typedef unsigned u32x4 __attribute__((ext_vector_type(4)));
typedef unsigned u32x2 __attribute__((ext_vector_type(2)));
#define LAS __attribute__((address_space(3)))
#define GAS __attribute__((address_space(1)))
typedef GAS unsigned gu32;
#define RLX_AGENT __ATOMIC_RELAXED, __HIP_MEMORY_SCOPE_AGENT

constexpr size_t MiB = 1u << 20;
constexpr size_t WS_CTL = 0, CTL_ZERO_BYTES = 1 * MiB;
constexpr size_t WS_Z = 1 * MiB;
constexpr size_t WS_XB = 65 * MiB;
constexpr size_t WS_YN = 97 * MiB;
constexpr size_t WS_Y = 129 * MiB;
constexpr size_t WS_U = 193 * MiB;
constexpr size_t WS_VN = WS_U, WS_CV = WS_U + 16 * MiB, WS_PL = WS_U + 32 * MiB, WS_ACT = WS_U + 48 * MiB;
constexpr size_t WS_RT = 257 * MiB;
constexpr size_t WS_END = 258 * MiB;
constexpr int CW_BAR = 4096;

__device__ __forceinline__ float bf2f(bf16 v) { return __uint_as_float(((unsigned)v) << 16); }
__device__ __forceinline__ unsigned f2bf(float f) { unsigned u = __float_as_uint(f); return (u + 0x7fffu + ((u >> 16) & 1u)) >> 16; }
__device__ __forceinline__ unsigned pk2(float lo, float hi) { return f2bf(lo) | (f2bf(hi) << 16); }
__device__ __forceinline__ float sigmoidf_(float x) { return 1.0f / (1.0f + __expf(-x)); }
__device__ __forceinline__ float siluf_(float x) { return x * sigmoidf_(x); }
__device__ __forceinline__ float wave_sum(float v) {
#pragma unroll
    for (int o = 1; o < 64; o <<= 1) v += __shfl_xor(v, o);
    return v;
}

#define XB_TMO      128
#define XB_XCNT(j)  (256  + 64 * (j))
#define XB_XSUB(j)  (1280 + 64 * (j))
#define XB_XGEN(j)  (2304 + 64 * (j))
#define XB_TOP      3328
#define XB_TOPGEN   3392
#define XCD_BAR_WORDS 3456
#define XB_SPIN_CAP (1u << 18)
__device__ __forceinline__ unsigned xb_ld(unsigned* p)              { return __hip_atomic_load(p, __ATOMIC_RELAXED, __HIP_MEMORY_SCOPE_AGENT); }
__device__ __forceinline__ unsigned xb_add(unsigned* p, unsigned v) { return __hip_atomic_fetch_add(p, v, __ATOMIC_RELAXED, __HIP_MEMORY_SCOPE_AGENT); }
__device__ __forceinline__ unsigned xb_xcc_id() { return (unsigned)__builtin_amdgcn_s_getreg((3 << 11) | 20) & 0xFu; }
#define XB_SPIN(cond, bar) do { unsigned _sp = 0; while (cond) { __builtin_amdgcn_s_sleep(1); \
    if ((++_sp & 255u) == 0u) { if (xb_ld(&(bar)[XB_TMO])) break; if (_sp > XB_SPIN_CAP) { atomicAdd(&(bar)[XB_TMO], 1u); break; } } } } while (0)
struct XcdBarrier { unsigned* bar; unsigned x; volatile LAS unsigned* st; };
__device__ __forceinline__ XcdBarrier xcd_barrier_post(unsigned* bar, volatile LAS unsigned* st) {
    XcdBarrier b; b.bar = bar; b.x = xb_xcc_id(); b.st = st;
    if (threadIdx.x == 0) (void)xb_add(&bar[XB_XCNT(b.x)], 1u);
    return b;
}
__device__ __forceinline__ void xcd_barrier_complete(unsigned* bar, unsigned x, unsigned& nloc, unsigned& nx) {
    const unsigned G = gridDim.x * gridDim.y * gridDim.z;
    unsigned sum, cnt, mine, sp = 0u;
    for (;;) {
        sum = 0u; cnt = 0u; mine = 0u;
#pragma unroll
        for (unsigned j = 0; j < 16; ++j) { const unsigned c = xb_ld(&bar[XB_XCNT(j)]); sum += c; cnt += (c > 0u) ? 1u : 0u; mine = (j == x) ? c : mine; }
        if (sum == G) break;
        __builtin_amdgcn_s_sleep(1);
        if ((++sp & 255u) == 0u) { if (xb_ld(&bar[XB_TMO])) break; if (sp > XB_SPIN_CAP) { atomicAdd(&bar[XB_TMO], 1u); break; } }
    }
    nloc = mine > 0u ? mine : 1u; nx = cnt > 0u ? cnt : 1u;
}
__device__ __forceinline__ void xcd_barrier(const XcdBarrier& b) {
    asm volatile("s_waitcnt vmcnt(0)" ::: "memory");
    __syncthreads();
    if (threadIdx.x == 0) {
        unsigned* bar = b.bar;
        __builtin_amdgcn_s_waitcnt(0);
        unsigned nloc = b.st[0], nx = b.st[1];
        if (nloc == 0u) { xcd_barrier_complete(bar, b.x, nloc, nx); b.st[0] = nloc; b.st[1] = nx; }
        const unsigned old = xb_add(&bar[XB_XSUB(b.x)], 1u);
        const unsigned gen = old / nloc;
        if (old + 1u == (gen + 1u) * nloc) {
            __builtin_amdgcn_fence(__ATOMIC_RELEASE, "agent");
            asm volatile("s_waitcnt vmcnt(0)" ::: "memory");
            const unsigned og = xb_add(&bar[XB_TOP], 1u);
            const unsigned tg = og / nx;
            if (og + 1u == (tg + 1u) * nx) xb_add(&bar[XB_TOPGEN], 1u);
            else XB_SPIN(xb_ld(&bar[XB_TOPGEN]) == tg, bar);
            __builtin_amdgcn_fence(__ATOMIC_ACQUIRE, "agent");
            xb_add(&bar[XB_XGEN(b.x)], 1u);
            asm volatile("s_waitcnt vmcnt(0)" ::: "memory");
        } else {
            XB_SPIN(xb_ld(&bar[XB_XGEN(b.x)]) == gen, bar);
            __builtin_amdgcn_fence(__ATOMIC_ACQUIRE, "agent");
            asm volatile("s_waitcnt vmcnt(0)" ::: "memory");
        }
    }
    __syncthreads();
}

struct Args { const float* in[25]; float* out; unsigned char* ws; int ph_lo, ph_hi; };

struct Ctx {
    int tid, lane, wave, gtid, gsize, gw, ngw;
    LAS unsigned char* lds;
};

template <class Epi>
__device__ __forceinline__ void nv_gemm(const Ctx& c, const bf16* A, int lda, const float* W, int ldw, int Mr, int N, int K, const Epi& epi) {
    const int ntn = N / 4; const long total = (long)ntn * (Mr / 4);
    for (long i = c.gtid; i < total; i += c.gsize) {
        const int tn = (int)(i % ntn), tm = (int)(i / ntn);
        float acc[4][4];
#pragma unroll
        for (int r = 0; r < 4; ++r)
#pragma unroll
            for (int q = 0; q < 4; ++q) acc[r][q] = 0.f;
        const bf16* a0 = A + (size_t)(tm * 4) * lda;
        const float* w0 = W + tn * 4;
        for (int k = 0; k < K; k += 8) {
            u32x4 av[4];
#pragma unroll
            for (int r = 0; r < 4; ++r) av[r] = *(const u32x4*)(a0 + (size_t)r * lda + k);
#pragma unroll
            for (int kk = 0; kk < 8; ++kk) {
                const f32x4 w = *(const f32x4*)(w0 + (size_t)(k + kk) * ldw);
#pragma unroll
                for (int r = 0; r < 4; ++r) {
                    const unsigned pr = av[r][kk >> 1];
                    const float a = (kk & 1) ? __uint_as_float(pr & 0xffff0000u) : __uint_as_float(pr << 16);
#pragma unroll
                    for (int q = 0; q < 4; ++q) acc[r][q] += a * w[q];
                }
            }
        }
#pragma unroll
        for (int r = 0; r < 4; ++r) epi(tm * 4 + r, tn * 4, (f32x4){acc[r][0], acc[r][1], acc[r][2], acc[r][3]});
    }
}

__device__ __forceinline__ void ln256(f32x4& v, const float* g, const float* b, int lane) {
    const float mean = wave_sum((v[0] + v[1]) + (v[2] + v[3])) * (1.f / 256.f);
    v = v - mean;
    const float var = wave_sum((v[0] * v[0] + v[1] * v[1]) + (v[2] * v[2] + v[3] * v[3])) * (1.f / 256.f);
    const float rstd = 1.0f / sqrtf(var + LN_EPS);
    const f32x4 gg = *(const f32x4*)(g + lane * 4), bb = *(const f32x4*)(b + lane * 4);
    v = v * rstd * gg + bb;
}
__device__ __forceinline__ f32x4 ld_bf4(const bf16* p) { const u32x2 w = *(const u32x2*)p; return (f32x4){__uint_as_float(w.x << 16), __uint_as_float(w.x & 0xffff0000u), __uint_as_float(w.y << 16), __uint_as_float(w.y & 0xffff0000u)}; }
__device__ __forceinline__ void st_bf4(bf16* p, f32x4 v) { u32x2 w; w.x = pk2(v[0], v[1]); w.y = pk2(v[2], v[3]); *(u32x2*)p = w; }

struct Lw {
    const float *w_in, *gm_ln_g, *gm_ln_b, *gm_w_s, *gm_b_s, *cf_dw_w, *cf_dw_b, *cf_ln_g, *cf_ln_b, *cf_pw, *pool_w, *pool_scale, *sc_w, *mix_norm_g, *w_o, *ln1_g, *ln1_b,
        *router_w, *router_b, *wg, *wu, *wd, *ln2_g, *ln2_b;
};
__device__ __forceinline__ Lw layer_weights(const Args& a, int l) {
    Lw w;
    w.w_in = a.in[1] + (size_t)l * DM * DIN; w.gm_ln_g = a.in[2] + l * DG; w.gm_ln_b = a.in[3] + l * DG; w.gm_w_s = a.in[4] + (size_t)l * 4 * CHUNK * CHUNK; w.gm_b_s = a.in[5] + l * 4 * CHUNK;
    w.cf_dw_w = a.in[6] + l * CONFK * DG; w.cf_dw_b = a.in[7] + l * DG; w.cf_ln_g = a.in[8] + l * DG; w.cf_ln_b = a.in[9] + l * DG; w.cf_pw = a.in[10] + (size_t)l * DG * DG;
    w.pool_w = a.in[11] + l * 4 * 64 * 64; w.pool_scale = a.in[12] + l * DG; w.sc_w = a.in[13] + l * 3 * DG; w.mix_norm_g = a.in[14] + l * DM; w.w_o = a.in[15] + (size_t)l * DM * DM;
    w.ln1_g = a.in[16] + l * DM; w.ln1_b = a.in[17] + l * DM; w.router_w = a.in[18]; w.router_b = a.in[19];
    w.wg = a.in[20] + (size_t)l * NE * DM * DE; w.wu = a.in[21] + (size_t)l * NE * DM * DE; w.wd = a.in[22] + (size_t)l * NE * DE * DM;
    w.ln2_g = a.in[23] + l * DM; w.ln2_b = a.in[24] + l * DM;
    return w;
}

__device__ __forceinline__ void nv_prologue(const Ctx& c, const float* x, bf16* XB) {
    for (size_t i = c.gtid; i < (size_t)M * DM / 4; i += c.gsize) st_bf4(XB + i * 4, *(const f32x4*)(x + i * 4));
}
__device__ __forceinline__ void nv_mix_a(const Ctx& c, const Lw& w, const bf16* Z, float* VN, float* CV, float* PL, float* Y) {
    for (int t = c.gw; t < M; t += c.ngw) {
        f32x4 v = ld_bf4(Z + (size_t)t * DIN + 256 + c.lane * 4);
        ln256(v, w.gm_ln_g, w.gm_ln_b, c.lane);
        *(f32x4*)(VN + (size_t)t * DG + c.lane * 4) = v;
    }
    for (size_t i = c.gtid; i < (size_t)M * DG; i += c.gsize) {
        const int t = (int)(i / DG), ch = (int)(i % DG), pos = t % SEQ;
        {
            float acc = w.cf_dw_b[ch];
            for (int k = 0; k < CONFK; ++k) { const int d = k - (CONFK - 1); if (pos + d >= 0) {
                const float a = bf2f(Z[(size_t)(t + d) * DIN + 512 + ch]), g = bf2f(Z[(size_t)(t + d) * DIN + 768 + ch]);
                acc += w.cf_dw_w[k * DG + ch] * (a * sigmoidf_(g)); } }
            CV[i] = acc;
        }
        {
            const int g = ch >> 6, W = 2 << g, cnt = (pos + 1 < W) ? pos + 1 : W;
            float s = 0.f;
            for (int j = 0; j < cnt; ++j) s += bf2f(Z[(size_t)(t - j) * DIN + 1024 + ch]);
            PL[i] = s / (float)cnt - bf2f(Z[(size_t)t * DIN + 1024 + ch]);
        }
        {
            float acc = 0.f;
            for (int k = 0; k < 3; ++k) { const int d = k - 2; if (pos + d >= 0) {
                const float cg = bf2f(Z[(size_t)(t + d) * DIN + 1536 + ch]), hh = bf2f(Z[(size_t)(t + d) * DIN + 1792 + ch]);
                acc += w.sc_w[k * DG + ch] * (cg * hh); } }
            Y[(size_t)t * DM + 768 + ch] = bf2f(Z[(size_t)t * DIN + 1280 + ch]) * acc;
        }
    }
}
__device__ __forceinline__ void nv_mix_b(const Ctx& c, const Lw& w, const bf16* Z, const float* VN, const float* CV, const float* PL, bf16* ACT, float* Y) {
    for (size_t i = c.gtid; i < (size_t)M * DG; i += c.gsize) {
        const int t = (int)(i / DG), ch = (int)(i % DG);
        {
            const int tl = t % CHUNK, t0 = t - tl, h = ch >> 6;
            float s = w.gm_b_s[h * CHUNK + tl];
            const float* wr = w.gm_w_s + ((size_t)h * CHUNK + tl) * CHUNK;
            for (int sl = 0; sl <= tl; ++sl) s += wr[sl] * VN[(size_t)(t0 + sl) * DG + ch];
            Y[(size_t)t * DM + ch] = bf2f(Z[(size_t)t * DIN + ch]) * s;
        }
        {
            const int g = ch >> 6, e = ch & 63;
            float s = 0.f;
            for (int d = 0; d < 64; ++d) s += PL[(size_t)t * DG + g * 64 + d] * w.pool_w[(g * 64 + d) * 64 + e];
            Y[(size_t)t * DM + 512 + ch] = s * w.pool_scale[ch];
        }
    }
    for (int t = c.gw; t < M; t += c.ngw) {
        f32x4 v = *(const f32x4*)(CV + (size_t)t * DG + c.lane * 4);
        ln256(v, w.cf_ln_g, w.cf_ln_b, c.lane);
        v = (f32x4){siluf_(v[0]), siluf_(v[1]), siluf_(v[2]), siluf_(v[3])};
        st_bf4(ACT + (size_t)t * DG + c.lane * 4, v);
    }
}
struct EpiPw { float* Y; __device__ __forceinline__ void operator()(int r, int cc, f32x4 v) const { *(f32x4*)(Y + (size_t)r * DM + 256 + cc) = v; } };
__device__ __forceinline__ void nv_mix_d(const Ctx& c, const Lw& w, const float* Y, bf16* YN) {
    for (int i = c.gw; i < M * 4; i += c.ngw) {
        const int t = i >> 2, g = i & 3;
        f32x4 v = *(const f32x4*)(Y + (size_t)t * DM + g * DG + c.lane * 4);
        const float ms = wave_sum((v[0] * v[0] + v[1] * v[1]) + (v[2] * v[2] + v[3] * v[3])) * (1.f / 256.f);
        const float r = 1.0f / sqrtf(ms + RMS_EPS);
        v = v * r * *(const f32x4*)(w.mix_norm_g + g * DG + c.lane * 4);
        st_bf4(YN + (size_t)t * DM + g * DG + c.lane * 4, v);
    }
}
struct EpiZ { bf16* Z; __device__ __forceinline__ void operator()(int r, int cc, f32x4 v) const { st_bf4(Z + (size_t)r * DIN + cc, v); } };
struct EpiU { float* U; const float* X; __device__ __forceinline__ void operator()(int r, int cc, f32x4 v) const { *(f32x4*)(U + (size_t)r * DM + cc) = v + ALPHA * *(const f32x4*)(X + (size_t)r * DM + cc); } };

__device__ __forceinline__ void ln1024(f32x4 (&v)[4], const float* g, const float* b, int lane) {
    float s = 0.f;
#pragma unroll
    for (int j = 0; j < 4; ++j) s += (v[j][0] + v[j][1]) + (v[j][2] + v[j][3]);
    const float mean = wave_sum(s) * (1.f / DM);
    float q = 0.f;
#pragma unroll
    for (int j = 0; j < 4; ++j) { v[j] = v[j] - mean; q += (v[j][0] * v[j][0] + v[j][1] * v[j][1]) + (v[j][2] * v[j][2] + v[j][3] * v[j][3]); }
    const float rstd = 1.0f / sqrtf(wave_sum(q) * (1.f / DM) + LN_EPS);
#pragma unroll
    for (int j = 0; j < 4; ++j) v[j] = v[j] * rstd * *(const f32x4*)(g + lane * 4 + 256 * j) + *(const f32x4*)(b + lane * 4 + 256 * j);
}
__device__ __forceinline__ void nv_ln1_router(const Ctx& c, const Lw& w, const float* U, float* X1, unsigned* RTE, float* RTG) {
    for (int t = c.gw; t < M; t += c.ngw) {
        f32x4 v[4];
#pragma unroll
        for (int j = 0; j < 4; ++j) v[j] = *(const f32x4*)(U + (size_t)t * DM + c.lane * 4 + 256 * j);
        ln1024(v, w.ln1_g, w.ln1_b, c.lane);
#pragma unroll
        for (int j = 0; j < 4; ++j) *(f32x4*)(X1 + (size_t)t * DM + c.lane * 4 + 256 * j) = v[j];
        float lg[16];
#pragma unroll
        for (int e = 0; e < 16; ++e) lg[e] = 0.f;
#pragma unroll
        for (int j = 0; j < 4; ++j)
#pragma unroll
            for (int q = 0; q < 4; ++q) {
                const float xv = v[j][q]; const float* wr = w.router_w + (size_t)(c.lane * 4 + 256 * j + q) * NE;
#pragma unroll
                for (int e4 = 0; e4 < 4; ++e4) { const f32x4 ww = *(const f32x4*)(wr + e4 * 4);
                    lg[e4 * 4 + 0] += xv * ww[0]; lg[e4 * 4 + 1] += xv * ww[1]; lg[e4 * 4 + 2] += xv * ww[2]; lg[e4 * 4 + 3] += xv * ww[3]; }
            }
#pragma unroll
        for (int e = 0; e < 16; ++e) lg[e] = wave_sum(lg[e]);
        float best_score = 0.f; int best = -1;
#pragma unroll
        for (int g = 0; g < 4; ++g) {
            float m1 = -INFINITY, m2 = -INFINITY;
#pragma unroll
            for (int j = 0; j < 4; ++j) { const float s = lg[g * 4 + j] + w.router_b[g * 4 + j]; if (s > m1) { m2 = m1; m1 = s; } else if (s > m2) m2 = s; }
            const float sc = m1 + m2;
            if (best < 0 || sc > best_score) { best_score = sc; best = g; }
        }
        float s1 = -INFINITY, s2 = -INFINITY, l1 = 0.f, l2 = 0.f; int i1 = 0, i2 = 0;
#pragma unroll
        for (int e = 0; e < 16; ++e) {
            if ((e >> 2) == best) { const float s = lg[e] + w.router_b[e];
                if (s > s1) { s2 = s1; i2 = i1; l2 = l1; s1 = s; i1 = e; l1 = lg[e]; } else if (s > s2) { s2 = s; i2 = e; l2 = lg[e]; } }
        }
        const float mx = fmaxf(l1, l2), e1 = __expf(l1 - mx), e2 = __expf(l2 - mx), inv = 1.0f / (e1 + e2);
        if (c.lane == 0) { RTE[t] = (unsigned)i1 | ((unsigned)i2 << 8); RTG[2 * t] = e1 * inv; RTG[2 * t + 1] = e2 * inv; }
    }
}
__device__ __forceinline__ void nv_moe(const Ctx& c, const Lw& w, const float* X1, const unsigned* RTE, const float* RTG, float* F) {
    LAS float* xs = (LAS float*)c.lds; LAS float* hs = xs + DM;
    for (int t = blockIdx.x; t < M; t += gridDim.x) {
        __syncthreads();
        xs[c.tid] = X1[(size_t)t * DM + c.tid]; xs[c.tid + 512] = X1[(size_t)t * DM + c.tid + 512];
        __syncthreads();
        const unsigned ee = RTE[t]; float f0 = 0.f, f1 = 0.f;
        for (int k = 0; k < 2; ++k) {
            const int e = (ee >> (8 * k)) & 0xff; const float gk = RTG[2 * t + k];
            const float* wg = w.wg + (size_t)e * DM * DE + c.tid; const float* wu = w.wu + (size_t)e * DM * DE + c.tid;
            float ga = 0.f, ua = 0.f;
            for (int i = 0; i < DM; ++i) { const float xv = xs[i]; ga += xv * wg[(size_t)i * DE]; ua += xv * wu[(size_t)i * DE]; }
            __syncthreads();
            hs[c.tid] = siluf_(ga) * ua;
            __syncthreads();
            const float* wd = w.wd + (size_t)e * DE * DM + c.tid;
            float y0 = 0.f, y1 = 0.f;
            for (int i = 0; i < DE; ++i) { const float hv = hs[i]; y0 += hv * wd[(size_t)i * DM]; y1 += hv * wd[(size_t)i * DM + 512]; }
            f0 += gk * y0; f1 += gk * y1;
        }
        F[(size_t)t * DM + c.tid] = f0; F[(size_t)t * DM + c.tid + 512] = f1;
    }
}
__device__ __forceinline__ void nv_ln2(const Ctx& c, const Lw& w, const float* X1, const float* F, float* X2, bf16* XB) {
    for (int t = c.gw; t < M; t += c.ngw) {
        f32x4 v[4];
#pragma unroll
        for (int j = 0; j < 4; ++j) v[j] = ALPHA * *(const f32x4*)(X1 + (size_t)t * DM + c.lane * 4 + 256 * j) + *(const f32x4*)(F + (size_t)t * DM + c.lane * 4 + 256 * j);
        ln1024(v, w.ln2_g, w.ln2_b, c.lane);
#pragma unroll
        for (int j = 0; j < 4; ++j) { *(f32x4*)(X2 + (size_t)t * DM + c.lane * 4 + 256 * j) = v[j]; st_bf4(XB + (size_t)t * DM + c.lane * 4 + 256 * j, v[j]); }
    }
}

constexpr int PH_PER_LAYER = 9, N_PHASES = 1 + NL * PH_PER_LAYER;
__global__ void __launch_bounds__(NT, 2) fwd_kernel(Args args) {
    extern __shared__ __attribute__((aligned(16))) unsigned char lds_raw[];
    Ctx c;
    c.lds = (LAS unsigned char*)lds_raw;
    c.tid = threadIdx.x; c.lane = c.tid & 63; c.wave = __builtin_amdgcn_readfirstlane(c.tid >> 6);
    c.gtid = blockIdx.x * NT + c.tid; c.gsize = gridDim.x * NT; c.gw = blockIdx.x * NWAVES + c.wave; c.ngw = gridDim.x * NWAVES;
    unsigned char* ws = args.ws;
    volatile LAS unsigned* MISC = (volatile LAS unsigned*)(c.lds + LDS_BYTES - 64);
    if (c.tid < 16) MISC[c.tid] = 0u;
    __syncthreads();
    XcdBarrier bar; bar.bar = (unsigned*)ws + CW_BAR; bar.x = 0; bar.st = nullptr;
    const bool one = (args.ph_hi - args.ph_lo) > 1;
    if (one) bar = xcd_barrier_post((unsigned*)ws + CW_BAR, MISC + 8);
    bf16* Z = (bf16*)(ws + WS_Z); bf16* XB = (bf16*)(ws + WS_XB); bf16* YN = (bf16*)(ws + WS_YN);
    float* Y = (float*)(ws + WS_Y); float* U = (float*)(ws + WS_U);
    float* VN = (float*)(ws + WS_VN); float* CV = (float*)(ws + WS_CV); float* PL = (float*)(ws + WS_PL); bf16* ACT = (bf16*)(ws + WS_ACT);
    unsigned* RTE = (unsigned*)(ws + WS_RT); float* RTG = (float*)(ws + WS_RT + 512 * 1024);
    for (int ph = args.ph_lo; ph < args.ph_hi; ++ph) {
        if (ph == 0) nv_prologue(c, args.in[0], XB);
        else {
            const int l = (ph - 1) / PH_PER_LAYER, p = (ph - 1) % PH_PER_LAYER;
            const Lw w = layer_weights(args, l);
            const float* X = (l == 0) ? args.in[0] : args.out;
            switch (p) {
            case 0: nv_gemm(c, XB, DM, w.w_in, DIN, M, DIN, DM, EpiZ{Z}); break;
            case 1: nv_mix_a(c, w, Z, VN, CV, PL, Y); break;
            case 2: nv_mix_b(c, w, Z, VN, CV, PL, ACT, Y); break;
            case 3: nv_gemm(c, ACT, DG, w.cf_pw, DG, M, DG, DG, EpiPw{Y}); break;
            case 4: nv_mix_d(c, w, Y, YN); break;
            case 5: nv_gemm(c, YN, DM, w.w_o, DM, M, DM, DM, EpiU{U, X}); break;
            case 6: nv_ln1_router(c, w, U, args.out, RTE, RTG); break;
            case 7: nv_moe(c, w, args.out, RTE, RTG, Y); break;
            case 8: nv_ln2(c, w, args.out, Y, args.out, XB); break;
            }
        }
        if (one && ph + 1 < args.ph_hi) xcd_barrier(bar);
    }
}

extern "C" void kernel_launch(void* const* d_in, const int* in_sizes, int n_in, void* d_out, int out_size, void* d_ws, size_t ws_size, hipStream_t stream) {
    static int grid = 0;
    if (grid == 0) {
        if (n_in != 25 || in_sizes[0] != M * DM || out_size != M * DM || ws_size < WS_END) { fprintf(stderr, "kernel_launch: unexpected shapes/ws (n_in %d ws %zu)\n", n_in, ws_size); grid = -1; return; }
        int dev = 0, cus = 0;
        if (hipGetDevice(&dev) != hipSuccess || hipDeviceGetAttribute(&cus, hipDeviceAttributeMultiprocessorCount, dev) != hipSuccess) { grid = -1; return; }
        if (hipFuncSetAttribute((const void*)fwd_kernel, hipFuncAttributeMaxDynamicSharedMemorySize, LDS_BYTES) != hipSuccess) { grid = -1; return; }
        (void)hipGetLastError();
        grid = cus;
    }
    if (grid < 0) return;
    (void)hipMemsetAsync((char*)d_ws + WS_CTL, 0, CTL_ZERO_BYTES, stream);
    Args a{};
    for (int i = 0; i < 25; ++i) a.in[i] = (const float*)d_in[i];
    a.out = (float*)d_out; a.ws = (unsigned char*)d_ws;
#if MK_ONE_LAUNCH
    a.ph_lo = 0; a.ph_hi = N_PHASES;
    hipLaunchKernelGGL(fwd_kernel, dim3(grid), dim3(NT), LDS_BYTES, stream, a);
#else
    for (int ph = 0; ph < N_PHASES; ++ph) { a.ph_lo = ph; a.ph_hi = ph + 1; hipLaunchKernelGGL(fwd_kernel, dim3(grid), dim3(NT), LDS_BYTES, stream, a); }
#endif
}
```

```cpp
#include <hip/hip_runtime.h>
#include <cstdio>
#include <cstdint>

#ifndef MK_ONE_LAUNCH
#define MK_ONE_LAUNCH 1
#endif

constexpr int NB = 4, SEQ = 4096, DM = 1024, M = NB * SEQ, DIN = 2048, NE = 16, DE = 512, NL = 2;
constexpr int DG = 256, CHUNK = 128, CONFK = 31;
constexpr float ALPHA = 1.41421356237309515f;
constexpr float LN_EPS = 1e-5f, RMS_EPS = 1e-6f;
constexpr int NWAVES = 8, NT = NWAVES * 64;
constexpr int LDS_BYTES = 147456;

typedef unsigned short bf16;
typedef float f32x4 __attribute__((ext_vector_type(4)));
typedef unsigned u32x4 __attribute__((ext_vector_type(4)));
typedef unsigned u32x2 __attribute__((ext_vector_type(2)));
#define LAS __attribute__((address_space(3)))
#define GAS __attribute__((address_space(1)))
typedef GAS unsigned gu32;
#define RLX_AGENT __ATOMIC_RELAXED, __HIP_MEMORY_SCOPE_AGENT

constexpr size_t MiB = 1u << 20;
constexpr size_t WS_CTL = 0, CTL_ZERO_BYTES = 1 * MiB;
constexpr size_t WS_WIN = 1 * MiB;
constexpr size_t WS_WO = 9 * MiB;
constexpr size_t WS_WGU = 13 * MiB;
constexpr size_t WS_WD = 77 * MiB;
constexpr size_t WS_SMALL = 109 * MiB;
constexpr size_t WS_GMW = WS_SMALL, WS_PWT = WS_SMALL + 256 * 1024, WS_POOLT = WS_SMALL + 512 * 1024;
constexpr size_t WS_A = 110 * MiB;
constexpr size_t WS_Z = WS_A, WS_U = WS_A, WS_F = WS_A;
constexpr size_t WS_D = 182 * MiB;
constexpr size_t WS_XB = WS_D, WS_YN = WS_D, WS_H = WS_D;
constexpr size_t WS_RT = 218 * MiB;
constexpr size_t WS_END = 219 * MiB;
constexpr int CW_BAR = 4096;

__device__ __forceinline__ float bf2f(bf16 v) { return __uint_as_float(((unsigned)v) << 16); }
__device__ __forceinline__ unsigned f2bf(float f) { unsigned u = __float_as_uint(f); return (u + 0x7fffu + ((u >> 16) & 1u)) >> 16; }
__device__ __forceinline__ unsigned pk2(float lo, float hi) { return f2bf(lo) | (f2bf(hi) << 16); }
__device__ __forceinline__ float sigmoidf_(float x) { return 1.0f / (1.0f + __expf(-x)); }
__device__ __forceinline__ float siluf_(float x) { return x * sigmoidf_(x); }
__device__ __forceinline__ float wave_sum(float v) {
#pragma unroll
    for (int o = 1; o < 64; o <<= 1) v += __shfl_xor(v, o);
    return v;
}

#define XB_TMO      128
#define XB_XCNT(j)  (256  + 64 * (j))
#define XB_XSUB(j)  (1280 + 64 * (j))
#define XB_XGEN(j)  (2304 + 64 * (j))
#define XB_TOP      3328
#define XB_TOPGEN   3392
#define XCD_BAR_WORDS 3456
#define XB_SPIN_CAP (1u << 18)
__device__ __forceinline__ unsigned xb_ld(unsigned* p)              { return __hip_atomic_load(p, __ATOMIC_RELAXED, __HIP_MEMORY_SCOPE_AGENT); }
__device__ __forceinline__ unsigned xb_add(unsigned* p, unsigned v) { return __hip_atomic_fetch_add(p, v, __ATOMIC_RELAXED, __HIP_MEMORY_SCOPE_AGENT); }
__device__ __forceinline__ unsigned xb_xcc_id() { return (unsigned)__builtin_amdgcn_s_getreg((3 << 11) | 20) & 0xFu; }
#define XB_SPIN(cond, bar) do { unsigned _sp = 0; while (cond) { __builtin_amdgcn_s_sleep(1); \
    if ((++_sp & 255u) == 0u) { if (xb_ld(&(bar)[XB_TMO])) break; if (_sp > XB_SPIN_CAP) { atomicAdd(&(bar)[XB_TMO], 1u); break; } } } } while (0)
struct XcdBarrier { unsigned* bar; unsigned x; volatile LAS unsigned* st; };
__device__ __forceinline__ XcdBarrier xcd_barrier_post(unsigned* bar, volatile LAS unsigned* st) {
    XcdBarrier b; b.bar = bar; b.x = xb_xcc_id(); b.st = st;
    if (threadIdx.x == 0) (void)xb_add(&bar[XB_XCNT(b.x)], 1u);
    return b;
}
__device__ __forceinline__ void xcd_barrier_complete(unsigned* bar, unsigned x, unsigned& nloc, unsigned& nx) {
    const unsigned G = gridDim.x * gridDim.y * gridDim.z;
    unsigned sum, cnt, mine, sp = 0u;
    for (;;) {
        sum = 0u; cnt = 0u; mine = 0u;
#pragma unroll
        for (unsigned j = 0; j < 16; ++j) { const unsigned c = xb_ld(&bar[XB_XCNT(j)]); sum += c; cnt += (c > 0u) ? 1u : 0u; mine = (j == x) ? c : mine; }
        if (sum == G) break;
        __builtin_amdgcn_s_sleep(1);
        if ((++sp & 255u) == 0u) { if (xb_ld(&bar[XB_TMO])) break; if (sp > XB_SPIN_CAP) { atomicAdd(&bar[XB_TMO], 1u); break; } }
    }
    nloc = mine > 0u ? mine : 1u; nx = cnt > 0u ? cnt : 1u;
}
__device__ __forceinline__ void xcd_barrier(const XcdBarrier& b) {
    asm volatile("s_waitcnt vmcnt(0)" ::: "memory");
    __syncthreads();
    if (threadIdx.x == 0) {
        unsigned* bar = b.bar;
        __builtin_amdgcn_s_waitcnt(0);
        unsigned nloc = b.st[0], nx = b.st[1];
        if (nloc == 0u) { xcd_barrier_complete(bar, b.x, nloc, nx); b.st[0] = nloc; b.st[1] = nx; }
        const unsigned old = xb_add(&bar[XB_XSUB(b.x)], 1u);
        const unsigned gen = old / nloc;
        if (old + 1u == (gen + 1u) * nloc) {
            __builtin_amdgcn_fence(__ATOMIC_RELEASE, "agent");
            asm volatile("s_waitcnt vmcnt(0)" ::: "memory");
            const unsigned og = xb_add(&bar[XB_TOP], 1u);
            const unsigned tg = og / nx;
            if (og + 1u == (tg + 1u) * nx) xb_add(&bar[XB_TOPGEN], 1u);
            else XB_SPIN(xb_ld(&bar[XB_TOPGEN]) == tg, bar);
            __builtin_amdgcn_fence(__ATOMIC_ACQUIRE, "agent");
            xb_add(&bar[XB_XGEN(b.x)], 1u);
            asm volatile("s_waitcnt vmcnt(0)" ::: "memory");
        } else {
            XB_SPIN(xb_ld(&bar[XB_XGEN(b.x)]) == gen, bar);
            __builtin_amdgcn_fence(__ATOMIC_ACQUIRE, "agent");
            asm volatile("s_waitcnt vmcnt(0)" ::: "memory");
        }
    }
    __syncthreads();
}

struct Args { const float* in[25]; float* out; unsigned char* ws; int ph_lo, ph_hi; };

struct Ctx {
    int tid, lane, wave, gtid, gsize, gw, ngw;
    LAS unsigned char* lds;
};

template <class Epi>
__device__ __forceinline__ void nv_gemm(const Ctx& c, const bf16* A, int lda, const float* W, int ldw, int Mr, int N, int K, const Epi& epi) {
    const int ntn = N / 4; const long total = (long)ntn * (Mr / 4);
    for (long i = c.gtid; i < total; i += c.gsize) {
        const int tn = (int)(i % ntn), tm = (int)(i / ntn);
        float acc[4][4];
#pragma unroll
        for (int r = 0; r < 4; ++r)
#pragma unroll
            for (int q = 0; q < 4; ++q) acc[r][q] = 0.f;
        const bf16* a0 = A + (size_t)(tm * 4) * lda;
        const float* w0 = W + tn * 4;
        for (int k = 0; k < K; k += 8) {
            u32x4 av[4];
#pragma unroll
            for (int r = 0; r < 4; ++r) av[r] = *(const u32x4*)(a0 + (size_t)r * lda + k);
#pragma unroll
            for (int kk = 0; kk < 8; ++kk) {
                const f32x4 w = *(const f32x4*)(w0 + (size_t)(k + kk) * ldw);
#pragma unroll
                for (int r = 0; r < 4; ++r) {
                    const unsigned pr = av[r][kk >> 1];
                    const float a = (kk & 1) ? __uint_as_float(pr & 0xffff0000u) : __uint_as_float(pr << 16);
#pragma unroll
                    for (int q = 0; q < 4; ++q) acc[r][q] += a * w[q];
                }
            }
        }
#pragma unroll
        for (int r = 0; r < 4; ++r) epi(tm * 4 + r, tn * 4, (f32x4){acc[r][0], acc[r][1], acc[r][2], acc[r][3]});
    }
}

__device__ __forceinline__ void ln256(f32x4& v, const float* g, const float* b, int lane) {
    const float mean = wave_sum((v[0] + v[1]) + (v[2] + v[3])) * (1.f / 256.f);
    v = v - mean;
    const float var = wave_sum((v[0] * v[0] + v[1] * v[1]) + (v[2] * v[2] + v[3] * v[3])) * (1.f / 256.f);
    const float rstd = 1.0f / sqrtf(var + LN_EPS);
    const f32x4 gg = *(const f32x4*)(g + lane * 4), bb = *(const f32x4*)(b + lane * 4);
    v = v * rstd * gg + bb;
}
__device__ __forceinline__ f32x4 ld_bf4(const bf16* p) { const u32x2 w = *(const u32x2*)p; return (f32x4){__uint_as_float(w.x << 16), __uint_as_float(w.x & 0xffff0000u), __uint_as_float(w.y << 16), __uint_as_float(w.y & 0xffff0000u)}; }
__device__ __forceinline__ void st_bf4(bf16* p, f32x4 v) { u32x2 w; w.x = pk2(v[0], v[1]); w.y = pk2(v[2], v[3]); *(u32x2*)p = w; }

struct Lw {
    const float *w_in, *gm_ln_g, *gm_ln_b, *gm_w_s, *gm_b_s, *cf_dw_w, *cf_dw_b, *cf_ln_g, *cf_ln_b, *cf_pw, *pool_w, *pool_scale, *sc_w, *mix_norm_g, *w_o, *ln1_g, *ln1_b,
        *router_w, *router_b, *wg, *wu, *wd, *ln2_g, *ln2_b;
};
__device__ __forceinline__ Lw layer_weights(const Args& a, int l) {
    Lw w;
    w.w_in = a.in[1] + (size_t)l * DM * DIN; w.gm_ln_g = a.in[2] + l * DG; w.gm_ln_b = a.in[3] + l * DG; w.gm_w_s = a.in[4] + (size_t)l * 4 * CHUNK * CHUNK; w.gm_b_s = a.in[5] + l * 4 * CHUNK;
    w.cf_dw_w = a.in[6] + l * CONFK * DG; w.cf_dw_b = a.in[7] + l * DG; w.cf_ln_g = a.in[8] + l * DG; w.cf_ln_b = a.in[9] + l * DG; w.cf_pw = a.in[10] + (size_t)l * DG * DG;
    w.pool_w = a.in[11] + l * 4 * 64 * 64; w.pool_scale = a.in[12] + l * DG; w.sc_w = a.in[13] + l * 3 * DG; w.mix_norm_g = a.in[14] + l * DM; w.w_o = a.in[15] + (size_t)l * DM * DM;
    w.ln1_g = a.in[16] + l * DM; w.ln1_b = a.in[17] + l * DM; w.router_w = a.in[18]; w.router_b = a.in[19];
    w.wg = a.in[20] + (size_t)l * NE * DM * DE; w.wu = a.in[21] + (size_t)l * NE * DM * DE; w.wd = a.in[22] + (size_t)l * NE * DE * DM;
    w.ln2_g = a.in[23] + l * DM; w.ln2_b = a.in[24] + l * DM;
    return w;
}

__device__ __forceinline__ void nv_prologue(const Ctx& c, const float* x, bf16* XB) {
    for (size_t i = c.gtid; i < (size_t)M * DM / 4; i += c.gsize) st_bf4(XB + i * 4, *(const f32x4*)(x + i * 4));
}
typedef short bf16x8 __attribute__((ext_vector_type(8)));
__device__ __forceinline__ bf16x8 as_bf16x8(u32x4 v) { return __builtin_bit_cast(bf16x8, v); }
#define MFMA16(a, b, c) __builtin_amdgcn_mfma_f32_16x16x32_bf16((a), (b), (c), 0, 0, 0)
constexpr int YT_LD = 260;
constexpr int AT_LD = 264;
constexpr int VT_RS = 260;

__device__ __forceinline__ void small_weights(const Ctx& c, const Args& a, bf16* GMW, bf16* PWT, bf16* POOLT) {
    for (int i = c.gtid; i < NL * 4 * CHUNK * CHUNK; i += c.gsize) { const int s = i & 127, t = (i >> 7) & 127; GMW[i] = (bf16)((s <= t) ? f2bf(a.in[4][i]) : 0u); }
    for (int i = c.gtid; i < NL * DG * DG; i += c.gsize) { const int cc = i & 255, n = (i >> 8) & 255, l = i >> 16; PWT[i] = (bf16)f2bf(a.in[10][((size_t)l * DG + cc) * DG + n]); }
    for (int i = c.gtid; i < NL * 4 * 64 * 64; i += c.gsize) { const int d = i & 63, e = (i >> 6) & 63, lg = i >> 12; POOLT[i] = (bf16)f2bf(a.in[11][((size_t)lg * 64 + d) * 64 + e]); }
}

__device__ __forceinline__ void mix_final(const Ctx& c, const Lw& w, int t0, int grp, bf16* YN) {
    const LAS float* YT = (const LAS float*)c.lds;
    const f32x4 g = *(const f32x4*)(w.mix_norm_g + grp * DG + c.lane * 4);
#pragma unroll 4
    for (int i = 0; i < 16; ++i) {
        const int t = c.wave * 16 + i;
        f32x4 v = *(const LAS f32x4*)(YT + t * YT_LD + c.lane * 4);
        const float ms = wave_sum((v[0] * v[0] + v[1] * v[1]) + (v[2] * v[2] + v[3] * v[3])) * (1.f / 256.f);
        const float r = 1.0f / sqrtf(ms + RMS_EPS);
        st_bf4(YN + (size_t)(t0 + t) * DM + grp * DG + c.lane * 4, v * r * g);
    }
}

__device__ __forceinline__ void mix_conformer(const Ctx& c, const Lw& w, const bf16* Z, const bf16* PWT, int t0, bf16* YN) {
    LAS unsigned char* lds = c.lds;
    const int pos0 = t0 % SEQ;
    for (int r = c.tid >> 5; r < 158; r += 16) {
        const int c8 = (c.tid & 31) * 8; u32x4 o = (u32x4){0u, 0u, 0u, 0u};
        if (pos0 + r - 30 >= 0) {
            const size_t zr = (size_t)(t0 + r - 30) * DIN;
            const u32x4 av = *(const u32x4*)(Z + zr + 512 + c8), gv = *(const u32x4*)(Z + zr + 768 + c8);
#pragma unroll
            for (int j = 0; j < 4; ++j) {
                const float a0 = __uint_as_float(av[j] << 16), a1 = __uint_as_float(av[j] & 0xffff0000u), g0 = __uint_as_float(gv[j] << 16), g1 = __uint_as_float(gv[j] & 0xffff0000u);
                o[j] = pk2(a0 * sigmoidf_(g0), a1 * sigmoidf_(g1));
            }
        }
        *(LAS u32x4*)(lds + r * 512 + c8 * 2) = o;
    }
    __syncthreads();
    constexpr int CT_OFF = 80896;
    {
        const int ch = c.tid & 255, tg = c.tid >> 8;
        float wk[CONFK];
#pragma unroll
        for (int k = 0; k < CONFK; ++k) wk[k] = w.cf_dw_w[k * DG + ch];
        const float b0 = w.cf_dw_b[ch];
#pragma unroll 1
        for (int sb = 0; sb < 8; ++sb) {
            float acc[8];
#pragma unroll
            for (int j = 0; j < 8; ++j) acc[j] = b0;
            const int rb = tg * 64 + sb * 8;
#pragma unroll
            for (int r = 0; r < 38; ++r) {
                const float h0 = bf2f(*(const LAS bf16*)(lds + (rb + r) * 512 + ch * 2));
#pragma unroll
                for (int j = 0; j < 8; ++j) { const int k = r - j; if (k >= 0 && k < CONFK) acc[j] += wk[k] * h0; }
            }
#pragma unroll
            for (int j = 0; j < 8; ++j) *(LAS bf16*)(lds + CT_OFF + (rb + j) * 512 + ch * 2) = (bf16)f2bf(acc[j]);
        }
    }
    __syncthreads();
    {
        const f32x4 g = *(const f32x4*)(w.cf_ln_g + c.lane * 4), b = *(const f32x4*)(w.cf_ln_b + c.lane * 4);
#pragma unroll 4
        for (int i = 0; i < 16; ++i) {
            const int t = c.wave * 16 + i;
            const u32x2 pv = *(const LAS u32x2*)(lds + CT_OFF + t * 512 + c.lane * 8);
            f32x4 v = (f32x4){__uint_as_float(pv.x << 16), __uint_as_float(pv.x & 0xffff0000u), __uint_as_float(pv.y << 16), __uint_as_float(pv.y & 0xffff0000u)};
            const float mean = wave_sum((v[0] + v[1]) + (v[2] + v[3])) * (1.f / 256.f);
            v = v - mean;
            const float var = wave_sum((v[0] * v[0] + v[1] * v[1]) + (v[2] * v[2] + v[3] * v[3])) * (1.f / 256.f);
            v = v * (1.0f / sqrtf(var + LN_EPS)) * g + b;
            u32x2 o; o.x = pk2(siluf_(v[0]), siluf_(v[1])); o.y = pk2(siluf_(v[2]), siluf_(v[3]));
            *(LAS u32x2*)(lds + t * (AT_LD * 2) + c.lane * 8) = o;
        }
    }
    __syncthreads();
    {
        const int fr = c.lane & 15, fq = c.lane >> 4;
        f32x4 C[8][2];
#pragma unroll
        for (int rt = 0; rt < 8; ++rt) { C[rt][0] = (f32x4){0.f, 0.f, 0.f, 0.f}; C[rt][1] = (f32x4){0.f, 0.f, 0.f, 0.f}; }
        bf16x8 Bf[2][8];
#pragma unroll
        for (int ct = 0; ct < 2; ++ct)
#pragma unroll
            for (int ks = 0; ks < 8; ++ks) Bf[ct][ks] = as_bf16x8(*(const u32x4*)(PWT + (size_t)(c.wave * 32 + ct * 16 + fr) * DG + ks * 32 + fq * 8));
#pragma unroll
        for (int rt = 0; rt < 8; ++rt)
#pragma unroll
            for (int ks = 0; ks < 8; ++ks) {
                const bf16x8 Af = as_bf16x8(*(const LAS u32x4*)(lds + (rt * 16 + fr) * (AT_LD * 2) + (ks * 32 + fq * 8) * 2));
                C[rt][0] = MFMA16(Af, Bf[0][ks], C[rt][0]); C[rt][1] = MFMA16(Af, Bf[1][ks], C[rt][1]);
            }
        __syncthreads();
        LAS float* YT = (LAS float*)lds;
#pragma unroll
        for (int rt = 0; rt < 8; ++rt)
#pragma unroll
            for (int ct = 0; ct < 2; ++ct)
#pragma unroll
                for (int j = 0; j < 4; ++j) YT[(rt * 16 + fq * 4 + j) * YT_LD + c.wave * 32 + ct * 16 + fr] = C[rt][ct][j];
    }
    __syncthreads();
    mix_final(c, w, t0, 1, YN);
}

__device__ __forceinline__ void mix_gmlp(const Ctx& c, const Lw& w, const bf16* Z, const bf16* GMW, int t0, bf16* YN) {
    LAS unsigned char* lds = c.lds;
    {
        float g[4], b[4];
#pragma unroll
        for (int q = 0; q < 4; ++q) { g[q] = w.gm_ln_g[c.lane + 64 * q]; b[q] = w.gm_ln_b[c.lane + 64 * q]; }
#pragma unroll 2
        for (int i = 0; i < 8; ++i) {
            const int s = c.wave * 16 + 2 * i;
            float v[2][4];
#pragma unroll
            for (int p = 0; p < 2; ++p) {
#pragma unroll
                for (int q = 0; q < 4; ++q) v[p][q] = bf2f(Z[(size_t)(t0 + s + p) * DIN + 256 + c.lane + 64 * q]);
                const float mean = wave_sum((v[p][0] + v[p][1]) + (v[p][2] + v[p][3])) * (1.f / 256.f);
#pragma unroll
                for (int q = 0; q < 4; ++q) v[p][q] -= mean;
                const float var = wave_sum((v[p][0] * v[p][0] + v[p][1] * v[p][1]) + (v[p][2] * v[p][2] + v[p][3] * v[p][3])) * (1.f / 256.f);
                const float rstd = 1.0f / sqrtf(var + LN_EPS);
#pragma unroll
                for (int q = 0; q < 4; ++q) v[p][q] = v[p][q] * rstd * g[q] + b[q];
            }
#pragma unroll
            for (int q = 0; q < 4; ++q) *(LAS unsigned*)(lds + (c.lane + 64 * q) * VT_RS + s * 2) = pk2(v[0][q], v[1][q]);
        }
    }
    __syncthreads();
    const int fr = c.lane & 15, fq = c.lane >> 4, h = c.wave >> 1, par = c.wave & 1;
    bf16x8 Bf[4][4];
#pragma unroll
    for (int ct = 0; ct < 4; ++ct)
#pragma unroll
        for (int ks = 0; ks < 4; ++ks) {
            u32x4 t;
#pragma unroll
            for (int i = 0; i < 4; ++i) t[i] = *(const LAS unsigned*)(lds + (h * 64 + ct * 16 + fr) * VT_RS + (ks * 32 + fq * 8 + 2 * i) * 2);
            Bf[ct][ks] = as_bf16x8(t);
        }
    __syncthreads();
    LAS float* YT = (LAS float*)lds;
#pragma unroll 1
    for (int i = 0; i < 4; ++i) {
        const int R = par + 2 * i;
        f32x4 C[4];
#pragma unroll
        for (int ct = 0; ct < 4; ++ct) C[ct] = (f32x4){0.f, 0.f, 0.f, 0.f};
#pragma unroll
        for (int ks = 0; ks < 4; ++ks) {
            if (32 * ks <= 16 * R + 15) {
                const bf16x8 Af = as_bf16x8(*(const u32x4*)(GMW + ((size_t)(h * CHUNK + 16 * R + fr)) * CHUNK + ks * 32 + fq * 8));
#pragma unroll
                for (int ct = 0; ct < 4; ++ct) C[ct] = MFMA16(Af, Bf[ct][ks], C[ct]);
            }
        }
#pragma unroll
        for (int j = 0; j < 4; ++j) {
            const int t = 16 * R + fq * 4 + j; const float bs = w.gm_b_s[h * CHUNK + t];
#pragma unroll
            for (int ct = 0; ct < 4; ++ct) {
                const int ch = h * 64 + ct * 16 + fr;
                YT[t * YT_LD + ch] = bf2f(Z[(size_t)(t0 + t) * DIN + ch]) * (C[ct][j] + bs);
            }
        }
    }
    __syncthreads();
    mix_final(c, w, t0, 0, YN);
}

__device__ __forceinline__ void mix_pool(const Ctx& c, const Lw& w, const bf16* Z, const bf16* POOLT, int t0, bf16* YN) {
    LAS unsigned char* lds = c.lds;
    const int pos0 = t0 % SEQ;
    constexpr int PA_OFF = 73728;
    for (int r = c.tid >> 5; r < 143; r += 16) {
        const int c8 = (c.tid & 31) * 8; u32x4 o = (u32x4){0u, 0u, 0u, 0u};
        if (pos0 + r - 15 >= 0) o = *(const u32x4*)(Z + (size_t)(t0 + r - 15) * DIN + 1024 + c8);
        *(LAS u32x4*)(lds + r * 512 + c8 * 2) = o;
    }
    __syncthreads();
    {
        const int cp = c.tid & 127, tg = c.tid >> 7, W = 2 << (cp >> 5);
        float s0 = 0.f, s1 = 0.f;
        for (int i = 1; i < W; ++i) { const unsigned zv = *(const LAS unsigned*)(lds + (tg * 32 + 15 - i) * 512 + cp * 4); s0 += __uint_as_float(zv << 16); s1 += __uint_as_float(zv & 0xffff0000u); }
        for (int j = 0; j < 32; ++j) {
            const int tl = tg * 32 + j, pos = pos0 + tl;
            const unsigned zv = *(const LAS unsigned*)(lds + (tl + 15) * 512 + cp * 4);
            const float z0 = __uint_as_float(zv << 16), z1 = __uint_as_float(zv & 0xffff0000u);
            s0 += z0; s1 += z1;
            const float inv = 1.0f / (float)((pos + 1 < W) ? pos + 1 : W);
            *(LAS unsigned*)(lds + PA_OFF + tl * (AT_LD * 2) + cp * 4) = pk2(s0 * inv - z0, s1 * inv - z1);
            const unsigned zo = *(const LAS unsigned*)(lds + (tl + 15 - (W - 1)) * 512 + cp * 4);
            s0 -= __uint_as_float(zo << 16); s1 -= __uint_as_float(zo & 0xffff0000u);
        }
    }
    __syncthreads();
    {
        const int fr = c.lane & 15, fq = c.lane >> 4, g = c.wave >> 1, cb = (c.wave & 1) * 2;
        f32x4 C[8][2];
#pragma unroll
        for (int rt = 0; rt < 8; ++rt) { C[rt][0] = (f32x4){0.f, 0.f, 0.f, 0.f}; C[rt][1] = (f32x4){0.f, 0.f, 0.f, 0.f}; }
        bf16x8 Bf[2][2];
#pragma unroll
        for (int ct = 0; ct < 2; ++ct)
#pragma unroll
            for (int ks = 0; ks < 2; ++ks) Bf[ct][ks] = as_bf16x8(*(const u32x4*)(POOLT + (size_t)(g * 64 + (cb + ct) * 16 + fr) * 64 + ks * 32 + fq * 8));
#pragma unroll
        for (int rt = 0; rt < 8; ++rt)
#pragma unroll
            for (int ks = 0; ks < 2; ++ks) {
                const bf16x8 Af = as_bf16x8(*(const LAS u32x4*)(lds + PA_OFF + (rt * 16 + fr) * (AT_LD * 2) + (g * 64 + ks * 32 + fq * 8) * 2));
                C[rt][0] = MFMA16(Af, Bf[0][ks], C[rt][0]); C[rt][1] = MFMA16(Af, Bf[1][ks], C[rt][1]);
            }
        __syncthreads();
        LAS float* YT = (LAS float*)lds;
#pragma unroll
        for (int ct = 0; ct < 2; ++ct) {
            const int ch = g * 64 + (cb + ct) * 16 + fr; const float sc = w.pool_scale[ch];
#pragma unroll
            for (int rt = 0; rt < 8; ++rt)
#pragma unroll
                for (int j = 0; j < 4; ++j) YT[(rt * 16 + fq * 4 + j) * YT_LD + ch] = C[rt][ct][j] * sc;
        }
    }
    __syncthreads();
    mix_final(c, w, t0, 2, YN);
}

__device__ __forceinline__ void mix_sconv(const Ctx& c, const Lw& w, const bf16* Z, int t0, bf16* YN) {
    LAS float* YT = (LAS float*)c.lds;
    const int pos0 = t0 % SEQ;
    for (int r = c.tid >> 5; r < 128; r += 16) {
        const int c8 = (c.tid & 31) * 8;
        float acc[8];
#pragma unroll
        for (int j = 0; j < 8; ++j) acc[j] = 0.f;
#pragma unroll
        for (int k = 0; k < 3; ++k) {
            const int d = k - 2;
            if (pos0 + r + d >= 0) {
                const size_t zr = (size_t)(t0 + r + d) * DIN;
                const u32x4 cv = *(const u32x4*)(Z + zr + 1536 + c8), hv = *(const u32x4*)(Z + zr + 1792 + c8);
                const f32x4 w0 = *(const f32x4*)(w.sc_w + k * DG + c8), w1 = *(const f32x4*)(w.sc_w + k * DG + c8 + 4);
#pragma unroll
                for (int j = 0; j < 4; ++j) {
                    acc[2 * j] += (j < 2 ? w0[2 * j] : w1[2 * j - 4]) * (__uint_as_float(cv[j] << 16) * __uint_as_float(hv[j] << 16));
                    acc[2 * j + 1] += (j < 2 ? w0[2 * j + 1] : w1[2 * j - 3]) * (__uint_as_float(cv[j] & 0xffff0000u) * __uint_as_float(hv[j] & 0xffff0000u));
                }
            }
        }
        const u32x4 bv = *(const u32x4*)(Z + (size_t)(t0 + r) * DIN + 1280 + c8);
        f32x4 o0, o1;
        o0[0] = __uint_as_float(bv[0] << 16) * acc[0]; o0[1] = __uint_as_float(bv[0] & 0xffff0000u) * acc[1]; o0[2] = __uint_as_float(bv[1] << 16) * acc[2]; o0[3] = __uint_as_float(bv[1] & 0xffff0000u) * acc[3];
        o1[0] = __uint_as_float(bv[2] << 16) * acc[4]; o1[1] = __uint_as_float(bv[2] & 0xffff0000u) * acc[5]; o1[2] = __uint_as_float(bv[3] << 16) * acc[6]; o1[3] = __uint_as_float(bv[3] & 0xffff0000u) * acc[7];
        *(LAS f32x4*)(YT + r * YT_LD + c8) = o0; *(LAS f32x4*)(YT + r * YT_LD + c8 + 4) = o1;
    }
    __syncthreads();
    mix_final(c, w, t0, 3, YN);
}

__device__ __forceinline__ void mixer_phase(const Ctx& c0, const Lw& w, int l, const bf16* Z, const bf16* GMW, const bf16* PWT, const bf16* POOLT, bf16* YN) {
    for (int it = blockIdx.x; it < 512; it += gridDim.x) {
        Ctx c = c0; asm volatile("" : "+v"(c.tid)); c.lane = c.tid & 63;
        const int mx = it >> 7, t0 = (it & 127) * CHUNK;
        if (mx == 0) mix_conformer(c, w, Z, PWT + (size_t)l * DG * DG, t0, YN);
        else if (mx == 1) mix_gmlp(c, w, Z, GMW + (size_t)l * 4 * CHUNK * CHUNK, t0, YN);
        else if (mx == 2) mix_pool(c, w, Z, POOLT + (size_t)l * 4 * 64 * 64, t0, YN);
        else mix_sconv(c, w, Z, t0, YN);
        __syncthreads();
    }
}

struct EpiZ { bf16* Z; __device__ __forceinline__ void operator()(int r, int cc, f32x4 v) const { st_bf4(Z + (size_t)r * DIN + cc, v); } };
struct EpiU { float* U; const float* X; __device__ __forceinline__ void operator()(int r, int cc, f32x4 v) const { *(f32x4*)(U + (size_t)r * DM + cc) = v + ALPHA * *(const f32x4*)(X + (size_t)r * DM + cc); } };

__device__ __forceinline__ void ln1024(f32x4 (&v)[4], const float* g, const float* b, int lane) {
    float s = 0.f;
#pragma unroll
    for (int j = 0; j < 4; ++j) s += (v[j][0] + v[j][1]) + (v[j][2] + v[j][3]);
    const float mean = wave_sum(s) * (1.f / DM);
    float q = 0.f;
#pragma unroll
    for (int j = 0; j < 4; ++j) { v[j] = v[j] - mean; q += (v[j][0] * v[j][0] + v[j][1] * v[j][1]) + (v[j][2] * v[j][2] + v[j][3] * v[j][3]); }
    const float rstd = 1.0f / sqrtf(wave_sum(q) * (1.f / DM) + LN_EPS);
#pragma unroll
    for (int j = 0; j < 4; ++j) v[j] = v[j] * rstd * *(const f32x4*)(g + lane * 4 + 256 * j) + *(const f32x4*)(b + lane * 4 + 256 * j);
}
__device__ __forceinline__ void nv_ln1_router(const Ctx& c, const Lw& w, const float* U, float* X1, unsigned* RTE, float* RTG) {
    for (int t = c.gw; t < M; t += c.ngw) {
        f32x4 v[4];
#pragma unroll
        for (int j = 0; j < 4; ++j) v[j] = *(const f32x4*)(U + (size_t)t * DM + c.lane * 4 + 256 * j);
        ln1024(v, w.ln1_g, w.ln1_b, c.lane);
#pragma unroll
        for (int j = 0; j < 4; ++j) *(f32x4*)(X1 + (size_t)t * DM + c.lane * 4 + 256 * j) = v[j];
        float lg[16];
#pragma unroll
        for (int e = 0; e < 16; ++e) lg[e] = 0.f;
#pragma unroll
        for (int j = 0; j < 4; ++j)
#pragma unroll
            for (int q = 0; q < 4; ++q) {
                const float xv = v[j][q]; const float* wr = w.router_w + (size_t)(c.lane * 4 + 256 * j + q) * NE;
#pragma unroll
                for (int e4 = 0; e4 < 4; ++e4) { const f32x4 ww = *(const f32x4*)(wr + e4 * 4);
                    lg[e4 * 4 + 0] += xv * ww[0]; lg[e4 * 4 + 1] += xv * ww[1]; lg[e4 * 4 + 2] += xv * ww[2]; lg[e4 * 4 + 3] += xv * ww[3]; }
            }
#pragma unroll
        for (int e = 0; e < 16; ++e) lg[e] = wave_sum(lg[e]);
        float best_score = 0.f; int best = -1;
#pragma unroll
        for (int g = 0; g < 4; ++g) {
            float m1 = -INFINITY, m2 = -INFINITY;
#pragma unroll
            for (int j = 0; j < 4; ++j) { const float s = lg[g * 4 + j] + w.router_b[g * 4 + j]; if (s > m1) { m2 = m1; m1 = s; } else if (s > m2) m2 = s; }
            const float sc = m1 + m2;
            if (best < 0 || sc > best_score) { best_score = sc; best = g; }
        }
        float s1 = -INFINITY, s2 = -INFINITY, l1 = 0.f, l2 = 0.f; int i1 = 0, i2 = 0;
#pragma unroll
        for (int e = 0; e < 16; ++e) {
            if ((e >> 2) == best) { const float s = lg[e] + w.router_b[e];
                if (s > s1) { s2 = s1; i2 = i1; l2 = l1; s1 = s; i1 = e; l1 = lg[e]; } else if (s > s2) { s2 = s; i2 = e; l2 = lg[e]; } }
        }
        const float mx = fmaxf(l1, l2), e1 = __expf(l1 - mx), e2 = __expf(l2 - mx), inv = 1.0f / (e1 + e2);
        if (c.lane == 0) { RTE[t] = (unsigned)i1 | ((unsigned)i2 << 8); RTG[2 * t] = e1 * inv; RTG[2 * t + 1] = e2 * inv; }
    }
}
__device__ __forceinline__ void nv_moe(const Ctx& c, const Lw& w, const float* X1, const unsigned* RTE, const float* RTG, float* F) {
    LAS float* xs = (LAS float*)c.lds; LAS float* hs = xs + DM;
    for (int t = blockIdx.x; t < M; t += gridDim.x) {
        __syncthreads();
        xs[c.tid] = X1[(size_t)t * DM + c.tid]; xs[c.tid + 512] = X1[(size_t)t * DM + c.tid + 512];
        __syncthreads();
        const unsigned ee = RTE[t]; float f0 = 0.f, f1 = 0.f;
        for (int k = 0; k < 2; ++k) {
            const int e = (ee >> (8 * k)) & 0xff; const float gk = RTG[2 * t + k];
            const float* wg = w.wg + (size_t)e * DM * DE + c.tid; const float* wu = w.wu + (size_t)e * DM * DE + c.tid;
            float ga = 0.f, ua = 0.f;
            for (int i = 0; i < DM; ++i) { const float xv = xs[i]; ga += xv * wg[(size_t)i * DE]; ua += xv * wu[(size_t)i * DE]; }
            __syncthreads();
            hs[c.tid] = siluf_(ga) * ua;
            __syncthreads();
            const float* wd = w.wd + (size_t)e * DE * DM + c.tid;
            float y0 = 0.f, y1 = 0.f;
            for (int i = 0; i < DE; ++i) { const float hv = hs[i]; y0 += hv * wd[(size_t)i * DM]; y1 += hv * wd[(size_t)i * DM + 512]; }
            f0 += gk * y0; f1 += gk * y1;
        }
        F[(size_t)t * DM + c.tid] = f0; F[(size_t)t * DM + c.tid + 512] = f1;
    }
}
__device__ __forceinline__ void nv_ln2(const Ctx& c, const Lw& w, const float* X1, const float* F, float* X2, bf16* XB) {
    for (int t = c.gw; t < M; t += c.ngw) {
        f32x4 v[4];
#pragma unroll
        for (int j = 0; j < 4; ++j) v[j] = ALPHA * *(const f32x4*)(X1 + (size_t)t * DM + c.lane * 4 + 256 * j) + *(const f32x4*)(F + (size_t)t * DM + c.lane * 4 + 256 * j);
        ln1024(v, w.ln2_g, w.ln2_b, c.lane);
#pragma unroll
        for (int j = 0; j < 4; ++j) { *(f32x4*)(X2 + (size_t)t * DM + c.lane * 4 + 256 * j) = v[j]; st_bf4(XB + (size_t)t * DM + c.lane * 4 + 256 * j, v[j]); }
    }
}

constexpr int PH_PER_LAYER = 6, N_PHASES = 1 + NL * PH_PER_LAYER;
__global__ void __launch_bounds__(NT, 2) fwd_kernel(Args args) {
    extern __shared__ __attribute__((aligned(16))) unsigned char lds_raw[];
    Ctx c;
    c.lds = (LAS unsigned char*)lds_raw;
    c.tid = threadIdx.x; c.lane = c.tid & 63; c.wave = __builtin_amdgcn_readfirstlane(c.tid >> 6);
    c.gtid = blockIdx.x * NT + c.tid; c.gsize = gridDim.x * NT; c.gw = blockIdx.x * NWAVES + c.wave; c.ngw = gridDim.x * NWAVES;
    unsigned char* ws = args.ws;
    volatile LAS unsigned* MISC = (volatile LAS unsigned*)(c.lds + LDS_BYTES - 64);
    if (c.tid < 16) MISC[c.tid] = 0u;
    __syncthreads();
    XcdBarrier bar; bar.bar = (unsigned*)ws + CW_BAR; bar.x = 0; bar.st = nullptr;
    const bool one = (args.ph_hi - args.ph_lo) > 1;
    if (one) bar = xcd_barrier_post((unsigned*)ws + CW_BAR, MISC + 8);
    bf16* Z = (bf16*)(ws + WS_Z); bf16* XB = (bf16*)(ws + WS_XB); bf16* YN = (bf16*)(ws + WS_YN);
    float* U = (float*)(ws + WS_U); float* F = (float*)(ws + WS_F);
    bf16* GMW = (bf16*)(ws + WS_GMW); bf16* PWT = (bf16*)(ws + WS_PWT); bf16* POOLT = (bf16*)(ws + WS_POOLT);
    unsigned* RTE = (unsigned*)(ws + WS_RT); float* RTG = (float*)(ws + WS_RT + 512 * 1024);
    const Ctx c0 = c;
    for (int ph = args.ph_lo; ph < args.ph_hi; ++ph) {
        c = c0; asm volatile("" : "+v"(c.tid)); c.lane = c.tid & 63; c.gtid = blockIdx.x * NT + c.tid;
        if (ph == 0) { nv_prologue(c, args.in[0], XB); small_weights(c, args, GMW, PWT, POOLT); }
        else {
            const int l = (ph - 1) / PH_PER_LAYER, p = (ph - 1) % PH_PER_LAYER;
            const Lw w = layer_weights(args, l);
            const float* X = (l == 0) ? args.in[0] : args.out;
            switch (p) {
            case 0: nv_gemm(c, XB, DM, w.w_in, DIN, M, DIN, DM, EpiZ{Z}); break;
            case 1: mixer_phase(c, w, l, Z, GMW, PWT, POOLT, YN); break;
            case 2: nv_gemm(c, YN, DM, w.w_o, DM, M, DM, DM, EpiU{U, X}); break;
            case 3: nv_ln1_router(c, w, U, args.out, RTE, RTG); break;
            case 4: nv_moe(c, w, args.out, RTE, RTG, F); break;
            case 5: nv_ln2(c, w, args.out, F, args.out, XB); break;
            }
        }
        if (one && ph + 1 < args.ph_hi) xcd_barrier(bar);
    }
}

extern "C" void kernel_launch(void* const* d_in, const int* in_sizes, int n_in, void* d_out, int out_size, void* d_ws, size_t ws_size, hipStream_t stream) {
    static int grid = 0;
    if (grid == 0) {
        if (n_in != 25 || in_sizes[0] != M * DM || out_size != M * DM || ws_size < WS_END) { fprintf(stderr, "kernel_launch: unexpected shapes/ws (n_in %d ws %zu)\n", n_in, ws_size); grid = -1; return; }
        int dev = 0, cus = 0;
        if (hipGetDevice(&dev) != hipSuccess || hipDeviceGetAttribute(&cus, hipDeviceAttributeMultiprocessorCount, dev) != hipSuccess) { grid = -1; return; }
        if (hipFuncSetAttribute((const void*)fwd_kernel, hipFuncAttributeMaxDynamicSharedMemorySize, LDS_BYTES) != hipSuccess) { grid = -1; return; }
        (void)hipGetLastError();
        grid = cus;
    }
    if (grid < 0) return;
    (void)hipMemsetAsync((char*)d_ws + WS_CTL, 0, CTL_ZERO_BYTES, stream);
    Args a{};
    for (int i = 0; i < 25; ++i) a.in[i] = (const float*)d_in[i];
    a.out = (float*)d_out; a.ws = (unsigned char*)d_ws;
#if MK_ONE_LAUNCH
    a.ph_lo = 0; a.ph_hi = N_PHASES;
    hipLaunchKernelGGL(fwd_kernel, dim3(grid), dim3(NT), LDS_BYTES, stream, a);
#else
    for (int ph = 0; ph < N_PHASES; ++ph) { a.ph_lo = ph; a.ph_hi = ph + 1; hipLaunchKernelGGL(fwd_kernel, dim3(grid), dim3(NT), LDS_BYTES, stream, a); }
#endif
}
```

```cpp
#include <hip/hip_runtime.h>
#include <cstdio>
#include <cstdint>

#ifndef MK_ONE_LAUNCH
#define MK_ONE_LAUNCH 1
#endif

constexpr int NB = 4, SEQ = 4096, DM = 1024, M = NB * SEQ, DIN = 2048, NE = 16, DE = 512, NL = 2;
constexpr int DG = 256, CHUNK = 128, CONFK = 31;
constexpr float ALPHA = 1.41421356237309515f;
constexpr float LN_EPS = 1e-5f, RMS_EPS = 1e-6f;
constexpr int NWAVES = 8, NT = NWAVES * 64;
constexpr int LDS_BYTES = 147456;

typedef unsigned short bf16;
typedef float f32x4 __attribute__((ext_vector_type(4)));
typedef unsigned u32x4 __attribute__((ext_vector_type(4)));
typedef unsigned u32x2 __attribute__((ext_vector_type(2)));
#define LAS __attribute__((address_space(3)))
#define GAS __attribute__((address_space(1)))
typedef GAS unsigned gu32;
#define RLX_AGENT __ATOMIC_RELAXED, __HIP_MEMORY_SCOPE_AGENT

constexpr size_t MiB = 1u << 20;
constexpr size_t WS_CTL = 0, CTL_ZERO_BYTES = 1 * MiB;
constexpr size_t WS_WIN = 1 * MiB;
constexpr size_t WS_WO = 9 * MiB;
constexpr size_t WS_WGU = 13 * MiB;
constexpr size_t WS_WD = 77 * MiB;
constexpr size_t WS_SMALL = 109 * MiB;
constexpr size_t WS_GMW = WS_SMALL, WS_PWT = WS_SMALL + 256 * 1024, WS_POOLT = WS_SMALL + 512 * 1024;
constexpr size_t WS_A = 110 * MiB;
constexpr size_t WS_Z = WS_A, WS_U = WS_A, WS_F = WS_A;
constexpr size_t WS_D = 182 * MiB;
constexpr size_t WS_XB = WS_D, WS_YN = WS_D, WS_H = WS_D;
constexpr size_t WS_RT = 218 * MiB;
constexpr size_t WS_END = 219 * MiB;
constexpr int CW_BAR = 4096;

__device__ __forceinline__ float bf2f(bf16 v) { return __uint_as_float(((unsigned)v) << 16); }
__device__ __forceinline__ unsigned f2bf(float f) { unsigned u = __float_as_uint(f); return (u + 0x7fffu + ((u >> 16) & 1u)) >> 16; }
__device__ __forceinline__ unsigned pk2(float lo, float hi) { return f2bf(lo) | (f2bf(hi) << 16); }
__device__ __forceinline__ float sigmoidf_(float x) { return 1.0f / (1.0f + __expf(-x)); }
__device__ __forceinline__ float siluf_(float x) { return x * sigmoidf_(x); }
__device__ __forceinline__ float wave_sum(float v) {
#pragma unroll
    for (int o = 1; o < 64; o <<= 1) v += __shfl_xor(v, o);
    return v;
}

#define XB_TMO      128
#define XB_XCNT(j)  (256  + 64 * (j))
#define XB_XSUB(j)  (1280 + 64 * (j))
#define XB_XGEN(j)  (2304 + 64 * (j))
#define XB_TOP      3328
#define XB_TOPGEN   3392
#define XCD_BAR_WORDS 3456
#define XB_SPIN_CAP (1u << 18)
__device__ __forceinline__ unsigned xb_ld(unsigned* p)              { return __hip_atomic_load(p, __ATOMIC_RELAXED, __HIP_MEMORY_SCOPE_AGENT); }
__device__ __forceinline__ unsigned xb_add(unsigned* p, unsigned v) { return __hip_atomic_fetch_add(p, v, __ATOMIC_RELAXED, __HIP_MEMORY_SCOPE_AGENT); }
__device__ __forceinline__ unsigned xb_xcc_id() { return (unsigned)__builtin_amdgcn_s_getreg((3 << 11) | 20) & 0xFu; }
#define XB_SPIN(cond, bar) do { unsigned _sp = 0; while (cond) { __builtin_amdgcn_s_sleep(1); \
    if ((++_sp & 255u) == 0u) { if (xb_ld(&(bar)[XB_TMO])) break; if (_sp > XB_SPIN_CAP) { atomicAdd(&(bar)[XB_TMO], 1u); break; } } } } while (0)
struct XcdBarrier { unsigned* bar; unsigned x; volatile LAS unsigned* st; };
__device__ __forceinline__ XcdBarrier xcd_barrier_post(unsigned* bar, volatile LAS unsigned* st) {
    XcdBarrier b; b.bar = bar; b.x = xb_xcc_id(); b.st = st;
    if (threadIdx.x == 0) (void)xb_add(&bar[XB_XCNT(b.x)], 1u);
    return b;
}
__device__ __forceinline__ void xcd_barrier_complete(unsigned* bar, unsigned x, unsigned& nloc, unsigned& nx) {
    const unsigned G = gridDim.x * gridDim.y * gridDim.z;
    unsigned sum, cnt, mine, sp = 0u;
    for (;;) {
        sum = 0u; cnt = 0u; mine = 0u;
#pragma unroll
        for (unsigned j = 0; j < 16; ++j) { const unsigned c = xb_ld(&bar[XB_XCNT(j)]); sum += c; cnt += (c > 0u) ? 1u : 0u; mine = (j == x) ? c : mine; }
        if (sum == G) break;
        __builtin_amdgcn_s_sleep(1);
        if ((++sp & 255u) == 0u) { if (xb_ld(&bar[XB_TMO])) break; if (sp > XB_SPIN_CAP) { atomicAdd(&bar[XB_TMO], 1u); break; } }
    }
    nloc = mine > 0u ? mine : 1u; nx = cnt > 0u ? cnt : 1u;
}
__device__ __forceinline__ void xcd_barrier(const XcdBarrier& b) {
    asm volatile("s_waitcnt vmcnt(0)" ::: "memory");
    __syncthreads();
    if (threadIdx.x == 0) {
        unsigned* bar = b.bar;
        __builtin_amdgcn_s_waitcnt(0);
        unsigned nloc = b.st[0], nx = b.st[1];
        if (nloc == 0u) { xcd_barrier_complete(bar, b.x, nloc, nx); b.st[0] = nloc; b.st[1] = nx; }
        const unsigned old = xb_add(&bar[XB_XSUB(b.x)], 1u);
        const unsigned gen = old / nloc;
        if (old + 1u == (gen + 1u) * nloc) {
            __builtin_amdgcn_fence(__ATOMIC_RELEASE, "agent");
            asm volatile("s_waitcnt vmcnt(0)" ::: "memory");
            const unsigned og = xb_add(&bar[XB_TOP], 1u);
            const unsigned tg = og / nx;
            if (og + 1u == (tg + 1u) * nx) xb_add(&bar[XB_TOPGEN], 1u);
            else XB_SPIN(xb_ld(&bar[XB_TOPGEN]) == tg, bar);
            __builtin_amdgcn_fence(__ATOMIC_ACQUIRE, "agent");
            xb_add(&bar[XB_XGEN(b.x)], 1u);
            asm volatile("s_waitcnt vmcnt(0)" ::: "memory");
        } else {
            XB_SPIN(xb_ld(&bar[XB_XGEN(b.x)]) == gen, bar);
            __builtin_amdgcn_fence(__ATOMIC_ACQUIRE, "agent");
            asm volatile("s_waitcnt vmcnt(0)" ::: "memory");
        }
    }
    __syncthreads();
}

struct Args { const float* in[25]; float* out; unsigned char* ws; int ph_lo, ph_hi; };

struct Ctx {
    int tid, lane, wave, gtid, gsize, gw, ngw;
    LAS unsigned char* lds;
};

template <class Epi>
__device__ __forceinline__ void nv_gemm(const Ctx& c, const bf16* A, int lda, const float* W, int ldw, int Mr, int N, int K, const Epi& epi) {
    const int ntn = N / 4; const long total = (long)ntn * (Mr / 4);
    for (long i = c.gtid; i < total; i += c.gsize) {
        const int tn = (int)(i % ntn), tm = (int)(i / ntn);
        float acc[4][4];
#pragma unroll
        for (int r = 0; r < 4; ++r)
#pragma unroll
            for (int q = 0; q < 4; ++q) acc[r][q] = 0.f;
        const bf16* a0 = A + (size_t)(tm * 4) * lda;
        const float* w0 = W + tn * 4;
        for (int k = 0; k < K; k += 8) {
            u32x4 av[4];
#pragma unroll
            for (int r = 0; r < 4; ++r) av[r] = *(const u32x4*)(a0 + (size_t)r * lda + k);
#pragma unroll
            for (int kk = 0; kk < 8; ++kk) {
                const f32x4 w = *(const f32x4*)(w0 + (size_t)(k + kk) * ldw);
#pragma unroll
                for (int r = 0; r < 4; ++r) {
                    const unsigned pr = av[r][kk >> 1];
                    const float a = (kk & 1) ? __uint_as_float(pr & 0xffff0000u) : __uint_as_float(pr << 16);
#pragma unroll
                    for (int q = 0; q < 4; ++q) acc[r][q] += a * w[q];
                }
            }
        }
#pragma unroll
        for (int r = 0; r < 4; ++r) epi(tm * 4 + r, tn * 4, (f32x4){acc[r][0], acc[r][1], acc[r][2], acc[r][3]});
    }
}

__device__ __forceinline__ void ln256(f32x4& v, const float* g, const float* b, int lane) {
    const float mean = wave_sum((v[0] + v[1]) + (v[2] + v[3])) * (1.f / 256.f);
    v = v - mean;
    const float var = wave_sum((v[0] * v[0] + v[1] * v[1]) + (v[2] * v[2] + v[3] * v[3])) * (1.f / 256.f);
    const float rstd = 1.0f / sqrtf(var + LN_EPS);
    const f32x4 gg = *(const f32x4*)(g + lane * 4), bb = *(const f32x4*)(b + lane * 4);
    v = v * rstd * gg + bb;
}
__device__ __forceinline__ f32x4 ld_bf4(const bf16* p) { const u32x2 w = *(const u32x2*)p; return (f32x4){__uint_as_float(w.x << 16), __uint_as_float(w.x & 0xffff0000u), __uint_as_float(w.y << 16), __uint_as_float(w.y & 0xffff0000u)}; }
__device__ __forceinline__ void st_bf4(bf16* p, f32x4 v) { u32x2 w; w.x = pk2(v[0], v[1]); w.y = pk2(v[2], v[3]); *(u32x2*)p = w; }

struct Lw {
    const float *w_in, *gm_ln_g, *gm_ln_b, *gm_w_s, *gm_b_s, *cf_dw_w, *cf_dw_b, *cf_ln_g, *cf_ln_b, *cf_pw, *pool_w, *pool_scale, *sc_w, *mix_norm_g, *w_o, *ln1_g, *ln1_b,
        *router_w, *router_b, *wg, *wu, *wd, *ln2_g, *ln2_b;
};
__device__ __forceinline__ Lw layer_weights(const Args& a, int l) {
    Lw w;
    w.w_in = a.in[1] + (size_t)l * DM * DIN; w.gm_ln_g = a.in[2] + l * DG; w.gm_ln_b = a.in[3] + l * DG; w.gm_w_s = a.in[4] + (size_t)l * 4 * CHUNK * CHUNK; w.gm_b_s = a.in[5] + l * 4 * CHUNK;
    w.cf_dw_w = a.in[6] + l * CONFK * DG; w.cf_dw_b = a.in[7] + l * DG; w.cf_ln_g = a.in[8] + l * DG; w.cf_ln_b = a.in[9] + l * DG; w.cf_pw = a.in[10] + (size_t)l * DG * DG;
    w.pool_w = a.in[11] + l * 4 * 64 * 64; w.pool_scale = a.in[12] + l * DG; w.sc_w = a.in[13] + l * 3 * DG; w.mix_norm_g = a.in[14] + l * DM; w.w_o = a.in[15] + (size_t)l * DM * DM;
    w.ln1_g = a.in[16] + l * DM; w.ln1_b = a.in[17] + l * DM; w.router_w = a.in[18]; w.router_b = a.in[19];
    w.wg = a.in[20] + (size_t)l * NE * DM * DE; w.wu = a.in[21] + (size_t)l * NE * DM * DE; w.wd = a.in[22] + (size_t)l * NE * DE * DM;
    w.ln2_g = a.in[23] + l * DM; w.ln2_b = a.in[24] + l * DM;
    return w;
}

__device__ __forceinline__ void nv_prologue(const Ctx& c, const float* x, bf16* XB) {
    for (size_t i = c.gtid; i < (size_t)M * DM / 4; i += c.gsize) st_bf4(XB + i * 4, *(const f32x4*)(x + i * 4));
}
typedef short bf16x8 __attribute__((ext_vector_type(8)));
__device__ __forceinline__ bf16x8 as_bf16x8(u32x4 v) { return __builtin_bit_cast(bf16x8, v); }
#define MFMA16(a, b, c) __builtin_amdgcn_mfma_f32_16x16x32_bf16((a), (b), (c), 0, 0, 0)
constexpr int YT_LD = 260;
constexpr int AT_LD = 264;
constexpr int VT_RS = 260;

__device__ __forceinline__ void small_weights(const Ctx& c, const Args& a, bf16* GMW, bf16* PWT, bf16* POOLT) {
    for (int i = c.gtid; i < NL * 4 * CHUNK * CHUNK; i += c.gsize) { const int s = i & 127, t = (i >> 7) & 127; GMW[i] = (bf16)((s <= t) ? f2bf(a.in[4][i]) : 0u); }
    for (int i = c.gtid; i < NL * DG * DG; i += c.gsize) { const int cc = i & 255, n = (i >> 8) & 255, l = i >> 16; PWT[i] = (bf16)f2bf(a.in[10][((size_t)l * DG + cc) * DG + n]); }
    for (int i = c.gtid; i < NL * 4 * 64 * 64; i += c.gsize) { const int d = i & 63, e = (i >> 6) & 63, lg = i >> 12; POOLT[i] = (bf16)f2bf(a.in[11][((size_t)lg * 64 + d) * 64 + e]); }
}

__device__ __forceinline__ void mix_final(const Ctx& c, const Lw& w, int t0, int grp, bf16* YN) {
    const LAS float* YT = (const LAS float*)c.lds;
    const f32x4 g = *(const f32x4*)(w.mix_norm_g + grp * DG + c.lane * 4);
#pragma unroll 4
    for (int i = 0; i < 16; ++i) {
        const int t = c.wave * 16 + i;
        f32x4 v = *(const LAS f32x4*)(YT + t * YT_LD + c.lane * 4);
        const float ms = wave_sum((v[0] * v[0] + v[1] * v[1]) + (v[2] * v[2] + v[3] * v[3])) * (1.f / 256.f);
        const float r = 1.0f / sqrtf(ms + RMS_EPS);
        st_bf4(YN + (size_t)(t0 + t) * DM + grp * DG + c.lane * 4, v * r * g);
    }
}

__device__ __forceinline__ void mix_conformer(const Ctx& c, const Lw& w, const bf16* Z, const bf16* PWT, int t0, bf16* YN) {
    LAS unsigned char* lds = c.lds;
    const int pos0 = t0 % SEQ;
    for (int r = c.tid >> 5; r < 158; r += 16) {
        const int c8 = (c.tid & 31) * 8; u32x4 o = (u32x4){0u, 0u, 0u, 0u};
        if (pos0 + r - 30 >= 0) {
            const size_t zr = (size_t)(t0 + r - 30) * DIN;
            const u32x4 av = *(const u32x4*)(Z + zr + 512 + c8), gv = *(const u32x4*)(Z + zr + 768 + c8);
#pragma unroll
            for (int j = 0; j < 4; ++j) {
                const float a0 = __uint_as_float(av[j] << 16), a1 = __uint_as_float(av[j] & 0xffff0000u), g0 = __uint_as_float(gv[j] << 16), g1 = __uint_as_float(gv[j] & 0xffff0000u);
                o[j] = pk2(a0 * sigmoidf_(g0), a1 * sigmoidf_(g1));
            }
        }
        *(LAS u32x4*)(lds + r * 512 + c8 * 2) = o;
    }
    __syncthreads();
    constexpr int CT_OFF = 80896;
    {
        const int ch = c.tid & 255, tg = c.tid >> 8;
        float wk[CONFK];
#pragma unroll
        for (int k = 0; k < CONFK; ++k) wk[k] = w.cf_dw_w[k * DG + ch];
        const float b0 = w.cf_dw_b[ch];
#pragma unroll 1
        for (int sb = 0; sb < 8; ++sb) {
            float acc[8];
#pragma unroll
            for (int j = 0; j < 8; ++j) acc[j] = b0;
            const int rb = tg * 64 + sb * 8;
#pragma unroll
            for (int r = 0; r < 38; ++r) {
                const float h0 = bf2f(*(const LAS bf16*)(lds + (rb + r) * 512 + ch * 2));
#pragma unroll
                for (int j = 0; j < 8; ++j) { const int k = r - j; if (k >= 0 && k < CONFK) acc[j] += wk[k] * h0; }
            }
#pragma unroll
            for (int j = 0; j < 8; ++j) *(LAS bf16*)(lds + CT_OFF + (rb + j) * 512 + ch * 2) = (bf16)f2bf(acc[j]);
        }
    }
    __syncthreads();
    {
        const f32x4 g = *(const f32x4*)(w.cf_ln_g + c.lane * 4), b = *(const f32x4*)(w.cf_ln_b + c.lane * 4);
#pragma unroll 4
        for (int i = 0; i < 16; ++i) {
            const int t = c.wave * 16 + i;
            const u32x2 pv = *(const LAS u32x2*)(lds + CT_OFF + t * 512 + c.lane * 8);
            f32x4 v = (f32x4){__uint_as_float(pv.x << 16), __uint_as_float(pv.x & 0xffff0000u), __uint_as_float(pv.y << 16), __uint_as_float(pv.y & 0xffff0000u)};
            const float mean = wave_sum((v[0] + v[1]) + (v[2] + v[3])) * (1.f / 256.f);
            v = v - mean;
            const float var = wave_sum((v[0] * v[0] + v[1] * v[1]) + (v[2] * v[2] + v[3] * v[3])) * (1.f / 256.f);
            v = v * (1.0f / sqrtf(var + LN_EPS)) * g + b;
            u32x2 o; o.x = pk2(siluf_(v[0]), siluf_(v[1])); o.y = pk2(siluf_(v[2]), siluf_(v[3]));
            *(LAS u32x2*)(lds + t * (AT_LD * 2) + c.lane * 8) = o;
        }
    }
    __syncthreads();
    {
        const int fr = c.lane & 15, fq = c.lane >> 4;
        f32x4 C[8][2];
#pragma unroll
        for (int rt = 0; rt < 8; ++rt) { C[rt][0] = (f32x4){0.f, 0.f, 0.f, 0.f}; C[rt][1] = (f32x4){0.f, 0.f, 0.f, 0.f}; }
        bf16x8 Bf[2][8];
#pragma unroll
        for (int ct = 0; ct < 2; ++ct)
#pragma unroll
            for (int ks = 0; ks < 8; ++ks) Bf[ct][ks] = as_bf16x8(*(const u32x4*)(PWT + (size_t)(c.wave * 32 + ct * 16 + fr) * DG + ks * 32 + fq * 8));
#pragma unroll
        for (int rt = 0; rt < 8; ++rt)
#pragma unroll
            for (int ks = 0; ks < 8; ++ks) {
                const bf16x8 Af = as_bf16x8(*(const LAS u32x4*)(lds + (rt * 16 + fr) * (AT_LD * 2) + (ks * 32 + fq * 8) * 2));
                C[rt][0] = MFMA16(Af, Bf[0][ks], C[rt][0]); C[rt][1] = MFMA16(Af, Bf[1][ks], C[rt][1]);
            }
        __syncthreads();
        LAS float* YT = (LAS float*)lds;
#pragma unroll
        for (int rt = 0; rt < 8; ++rt)
#pragma unroll
            for (int ct = 0; ct < 2; ++ct)
#pragma unroll
                for (int j = 0; j < 4; ++j) YT[(rt * 16 + fq * 4 + j) * YT_LD + c.wave * 32 + ct * 16 + fr] = C[rt][ct][j];
    }
    __syncthreads();
    mix_final(c, w, t0, 1, YN);
}

__device__ __forceinline__ void mix_gmlp(const Ctx& c, const Lw& w, const bf16* Z, const bf16* GMW, int t0, bf16* YN) {
    LAS unsigned char* lds = c.lds;
    {
        float g[4], b[4];
#pragma unroll
        for (int q = 0; q < 4; ++q) { g[q] = w.gm_ln_g[c.lane + 64 * q]; b[q] = w.gm_ln_b[c.lane + 64 * q]; }
#pragma unroll 2
        for (int i = 0; i < 8; ++i) {
            const int s = c.wave * 16 + 2 * i;
            float v[2][4];
#pragma unroll
            for (int p = 0; p < 2; ++p) {
#pragma unroll
                for (int q = 0; q < 4; ++q) v[p][q] = bf2f(Z[(size_t)(t0 + s + p) * DIN + 256 + c.lane + 64 * q]);
                const float mean = wave_sum((v[p][0] + v[p][1]) + (v[p][2] + v[p][3])) * (1.f / 256.f);
#pragma unroll
                for (int q = 0; q < 4; ++q) v[p][q] -= mean;
                const float var = wave_sum((v[p][0] * v[p][0] + v[p][1] * v[p][1]) + (v[p][2] * v[p][2] + v[p][3] * v[p][3])) * (1.f / 256.f);
                const float rstd = 1.0f / sqrtf(var + LN_EPS);
#pragma unroll
                for (int q = 0; q < 4; ++q) v[p][q] = v[p][q] * rstd * g[q] + b[q];
            }
#pragma unroll
            for (int q = 0; q < 4; ++q) *(LAS unsigned*)(lds + (c.lane + 64 * q) * VT_RS + s * 2) = pk2(v[0][q], v[1][q]);
        }
    }
    __syncthreads();
    const int fr = c.lane & 15, fq = c.lane >> 4, h = c.wave >> 1, par = c.wave & 1;
    bf16x8 Bf[4][4];
#pragma unroll
    for (int ct = 0; ct < 4; ++ct)
#pragma unroll
        for (int ks = 0; ks < 4; ++ks) {
            u32x4 t;
#pragma unroll
            for (int i = 0; i < 4; ++i) t[i] = *(const LAS unsigned*)(lds + (h * 64 + ct * 16 + fr) * VT_RS + (ks * 32 + fq * 8 + 2 * i) * 2);
            Bf[ct][ks] = as_bf16x8(t);
        }
    __syncthreads();
    LAS float* YT = (LAS float*)lds;
#pragma unroll 1
    for (int i = 0; i < 4; ++i) {
        const int R = par + 2 * i;
        f32x4 C[4];
#pragma unroll
        for (int ct = 0; ct < 4; ++ct) C[ct] = (f32x4){0.f, 0.f, 0.f, 0.f};
#pragma unroll
        for (int ks = 0; ks < 4; ++ks) {
            if (32 * ks <= 16 * R + 15) {
                const bf16x8 Af = as_bf16x8(*(const u32x4*)(GMW + ((size_t)(h * CHUNK + 16 * R + fr)) * CHUNK + ks * 32 + fq * 8));
#pragma unroll
                for (int ct = 0; ct < 4; ++ct) C[ct] = MFMA16(Af, Bf[ct][ks], C[ct]);
            }
        }
#pragma unroll
        for (int j = 0; j < 4; ++j) {
            const int t = 16 * R + fq * 4 + j; const float bs = w.gm_b_s[h * CHUNK + t];
#pragma unroll
            for (int ct = 0; ct < 4; ++ct) {
                const int ch = h * 64 + ct * 16 + fr;
                YT[t * YT_LD + ch] = bf2f(Z[(size_t)(t0 + t) * DIN + ch]) * (C[ct][j] + bs);
            }
        }
    }
    __syncthreads();
    mix_final(c, w, t0, 0, YN);
}

__device__ __forceinline__ void mix_pool(const Ctx& c, const Lw& w, const bf16* Z, const bf16* POOLT, int t0, bf16* YN) {
    LAS unsigned char* lds = c.lds;
    const int pos0 = t0 % SEQ;
    constexpr int PA_OFF = 73728;
    for (int r = c.tid >> 5; r < 143; r += 16) {
        const int c8 = (c.tid & 31) * 8; u32x4 o = (u32x4){0u, 0u, 0u, 0u};
        if (pos0 + r - 15 >= 0) o = *(const u32x4*)(Z + (size_t)(t0 + r - 15) * DIN + 1024 + c8);
        *(LAS u32x4*)(lds + r * 512 + c8 * 2) = o;
    }
    __syncthreads();
    {
        const int cp = c.tid & 127, tg = c.tid >> 7, W = 2 << (cp >> 5);
        float s0 = 0.f, s1 = 0.f;
        for (int i = 1; i < W; ++i) { const unsigned zv = *(const LAS unsigned*)(lds + (tg * 32 + 15 - i) * 512 + cp * 4); s0 += __uint_as_float(zv << 16); s1 += __uint_as_float(zv & 0xffff0000u); }
        for (int j = 0; j < 32; ++j) {
            const int tl = tg * 32 + j, pos = pos0 + tl;
            const unsigned zv = *(const LAS unsigned*)(lds + (tl + 15) * 512 + cp * 4);
            const float z0 = __uint_as_float(zv << 16), z1 = __uint_as_float(zv & 0xffff0000u);
            s0 += z0; s1 += z1;
            const float inv = 1.0f / (float)((pos + 1 < W) ? pos + 1 : W);
            *(LAS unsigned*)(lds + PA_OFF + tl * (AT_LD * 2) + cp * 4) = pk2(s0 * inv - z0, s1 * inv - z1);
            const unsigned zo = *(const LAS unsigned*)(lds + (tl + 15 - (W - 1)) * 512 + cp * 4);
            s0 -= __uint_as_float(zo << 16); s1 -= __uint_as_float(zo & 0xffff0000u);
        }
    }
    __syncthreads();
    {
        const int fr = c.lane & 15, fq = c.lane >> 4, g = c.wave >> 1, cb = (c.wave & 1) * 2;
        f32x4 C[8][2];
#pragma unroll
        for (int rt = 0; rt < 8; ++rt) { C[rt][0] = (f32x4){0.f, 0.f, 0.f, 0.f}; C[rt][1] = (f32x4){0.f, 0.f, 0.f, 0.f}; }
        bf16x8 Bf[2][2];
#pragma unroll
        for (int ct = 0; ct < 2; ++ct)
#pragma unroll
            for (int ks = 0; ks < 2; ++ks) Bf[ct][ks] = as_bf16x8(*(const u32x4*)(POOLT + (size_t)(g * 64 + (cb + ct) * 16 + fr) * 64 + ks * 32 + fq * 8));
#pragma unroll
        for (int rt = 0; rt < 8; ++rt)
#pragma unroll
            for (int ks = 0; ks < 2; ++ks) {
                const bf16x8 Af = as_bf16x8(*(const LAS u32x4*)(lds + PA_OFF + (rt * 16 + fr) * (AT_LD * 2) + (g * 64 + ks * 32 + fq * 8) * 2));
                C[rt][0] = MFMA16(Af, Bf[0][ks], C[rt][0]); C[rt][1] = MFMA16(Af, Bf[1][ks], C[rt][1]);
            }
        __syncthreads();
        LAS float* YT = (LAS float*)lds;
#pragma unroll
        for (int ct = 0; ct < 2; ++ct) {
            const int ch = g * 64 + (cb + ct) * 16 + fr; const float sc = w.pool_scale[ch];
#pragma unroll
            for (int rt = 0; rt < 8; ++rt)
#pragma unroll
                for (int j = 0; j < 4; ++j) YT[(rt * 16 + fq * 4 + j) * YT_LD + ch] = C[rt][ct][j] * sc;
        }
    }
    __syncthreads();
    mix_final(c, w, t0, 2, YN);
}

__device__ __forceinline__ void mix_sconv(const Ctx& c, const Lw& w, const bf16* Z, int t0, bf16* YN) {
    LAS float* YT = (LAS float*)c.lds;
    const int pos0 = t0 % SEQ;
    for (int r = c.tid >> 5; r < 128; r += 16) {
        const int c8 = (c.tid & 31) * 8;
        float acc[8];
#pragma unroll
        for (int j = 0; j < 8; ++j) acc[j] = 0.f;
#pragma unroll
        for (int k = 0; k < 3; ++k) {
            const int d = k - 2;
            if (pos0 + r + d >= 0) {
                const size_t zr = (size_t)(t0 + r + d) * DIN;
                const u32x4 cv = *(const u32x4*)(Z + zr + 1536 + c8), hv = *(const u32x4*)(Z + zr + 1792 + c8);
                const f32x4 w0 = *(const f32x4*)(w.sc_w + k * DG + c8), w1 = *(const f32x4*)(w.sc_w + k * DG + c8 + 4);
#pragma unroll
                for (int j = 0; j < 4; ++j) {
                    acc[2 * j] += (j < 2 ? w0[2 * j] : w1[2 * j - 4]) * (__uint_as_float(cv[j] << 16) * __uint_as_float(hv[j] << 16));
                    acc[2 * j + 1] += (j < 2 ? w0[2 * j + 1] : w1[2 * j - 3]) * (__uint_as_float(cv[j] & 0xffff0000u) * __uint_as_float(hv[j] & 0xffff0000u));
                }
            }
        }
        const u32x4 bv = *(const u32x4*)(Z + (size_t)(t0 + r) * DIN + 1280 + c8);
        f32x4 o0, o1;
        o0[0] = __uint_as_float(bv[0] << 16) * acc[0]; o0[1] = __uint_as_float(bv[0] & 0xffff0000u) * acc[1]; o0[2] = __uint_as_float(bv[1] << 16) * acc[2]; o0[3] = __uint_as_float(bv[1] & 0xffff0000u) * acc[3];
        o1[0] = __uint_as_float(bv[2] << 16) * acc[4]; o1[1] = __uint_as_float(bv[2] & 0xffff0000u) * acc[5]; o1[2] = __uint_as_float(bv[3] << 16) * acc[6]; o1[3] = __uint_as_float(bv[3] & 0xffff0000u) * acc[7];
        *(LAS f32x4*)(YT + r * YT_LD + c8) = o0; *(LAS f32x4*)(YT + r * YT_LD + c8 + 4) = o1;
    }
    __syncthreads();
    mix_final(c, w, t0, 3, YN);
}

__device__ __forceinline__ void mixer_phase(const Ctx& c0, const Lw& w, int l, const bf16* Z, const bf16* GMW, const bf16* PWT, const bf16* POOLT, bf16* YN) {
    for (int it = blockIdx.x; it < 512; it += gridDim.x) {
        Ctx c = c0; asm volatile("" : "+v"(c.tid)); c.lane = c.tid & 63;
        const int mx = it >> 7, t0 = (it & 127) * CHUNK;
        if (mx == 0) mix_conformer(c, w, Z, PWT + (size_t)l * DG * DG, t0, YN);
        else if (mx == 1) mix_gmlp(c, w, Z, GMW + (size_t)l * 4 * CHUNK * CHUNK, t0, YN);
        else if (mx == 2) mix_pool(c, w, Z, POOLT + (size_t)l * 4 * 64 * 64, t0, YN);
        else mix_sconv(c, w, Z, t0, YN);
        __syncthreads();
    }
}

struct EpiZ { bf16* Z; __device__ __forceinline__ void operator()(int r, int cc, f32x4 v) const { st_bf4(Z + (size_t)r * DIN + cc, v); } };
struct EpiU { float* U; const float* X; __device__ __forceinline__ void operator()(int r, int cc, f32x4 v) const { *(f32x4*)(U + (size_t)r * DM + cc) = v + ALPHA * *(const f32x4*)(X + (size_t)r * DM + cc); } };

__device__ __forceinline__ void ln1024(f32x4 (&v)[4], const float* g, const float* b, int lane) {
    float s = 0.f;
#pragma unroll
    for (int j = 0; j < 4; ++j) s += (v[j][0] + v[j][1]) + (v[j][2] + v[j][3]);
    const float mean = wave_sum(s) * (1.f / DM);
    float q = 0.f;
#pragma unroll
    for (int j = 0; j < 4; ++j) { v[j] = v[j] - mean; q += (v[j][0] * v[j][0] + v[j][1] * v[j][1]) + (v[j][2] * v[j][2] + v[j][3] * v[j][3]); }
    const float rstd = 1.0f / sqrtf(wave_sum(q) * (1.f / DM) + LN_EPS);
#pragma unroll
    for (int j = 0; j < 4; ++j) v[j] = v[j] * rstd * *(const f32x4*)(g + lane * 4 + 256 * j) + *(const f32x4*)(b + lane * 4 + 256 * j);
}
__device__ __forceinline__ void nv_ln1_router(const Ctx& c, const Lw& w, const float* U, float* X1, unsigned* RTE, float* RTG) {
    for (int t = c.gw; t < M; t += c.ngw) {
        f32x4 v[4];
#pragma unroll
        for (int j = 0; j < 4; ++j) v[j] = *(const f32x4*)(U + (size_t)t * DM + c.lane * 4 + 256 * j);
        ln1024(v, w.ln1_g, w.ln1_b, c.lane);
#pragma unroll
        for (int j = 0; j < 4; ++j) *(f32x4*)(X1 + (size_t)t * DM + c.lane * 4 + 256 * j) = v[j];
        float lg[16];
#pragma unroll
        for (int e = 0; e < 16; ++e) lg[e] = 0.f;
#pragma unroll
        for (int j = 0; j < 4; ++j)
#pragma unroll
            for (int q = 0; q < 4; ++q) {
                const float xv = v[j][q]; const float* wr = w.router_w + (size_t)(c.lane * 4 + 256 * j + q) * NE;
#pragma unroll
                for (int e4 = 0; e4 < 4; ++e4) { const f32x4 ww = *(const f32x4*)(wr + e4 * 4);
                    lg[e4 * 4 + 0] += xv * ww[0]; lg[e4 * 4 + 1] += xv * ww[1]; lg[e4 * 4 + 2] += xv * ww[2]; lg[e4 * 4 + 3] += xv * ww[3]; }
            }
#pragma unroll
        for (int e = 0; e < 16; ++e) lg[e] = wave_sum(lg[e]);
        float best_score = 0.f; int best = -1;
#pragma unroll
        for (int g = 0; g < 4; ++g) {
            float m1 = -INFINITY, m2 = -INFINITY;
#pragma unroll
            for (int j = 0; j < 4; ++j) { const float s = lg[g * 4 + j] + w.router_b[g * 4 + j]; if (s > m1) { m2 = m1; m1 = s; } else if (s > m2) m2 = s; }
            const float sc = m1 + m2;
            if (best < 0 || sc > best_score) { best_score = sc; best = g; }
        }
        float s1 = -INFINITY, s2 = -INFINITY, l1 = 0.f, l2 = 0.f; int i1 = 0, i2 = 0;
#pragma unroll
        for (int e = 0; e < 16; ++e) {
            if ((e >> 2) == best) { const float s = lg[e] + w.router_b[e];
                if (s > s1) { s2 = s1; i2 = i1; l2 = l1; s1 = s; i1 = e; l1 = lg[e]; } else if (s > s2) { s2 = s; i2 = e; l2 = lg[e]; } }
        }
        const float mx = fmaxf(l1, l2), e1 = __expf(l1 - mx), e2 = __expf(l2 - mx), inv = 1.0f / (e1 + e2);
        if (c.lane == 0) { RTE[t] = (unsigned)i1 | ((unsigned)i2 << 8); RTG[2 * t] = e1 * inv; RTG[2 * t + 1] = e2 * inv; }
    }
}
__device__ __forceinline__ void nv_moe(const Ctx& c, const Lw& w, const float* X1, const unsigned* RTE, const float* RTG, float* F) {
    LAS float* xs = (LAS float*)c.lds; LAS float* hs = xs + DM;
    for (int t = blockIdx.x; t < M; t += gridDim.x) {
        __syncthreads();
        xs[c.tid] = X1[(size_t)t * DM + c.tid]; xs[c.tid + 512] = X1[(size_t)t * DM + c.tid + 512];
        __syncthreads();
        const unsigned ee = RTE[t]; float f0 = 0.f, f1 = 0.f;
        for (int k = 0; k < 2; ++k) {
            const int e = (ee >> (8 * k)) & 0xff; const float gk = RTG[2 * t + k];
            const float* wg = w.wg + (size_t)e * DM * DE + c.tid; const float* wu = w.wu + (size_t)e * DM * DE + c.tid;
            float ga = 0.f, ua = 0.f;
            for (int i = 0; i < DM; ++i) { const float xv = xs[i]; ga += xv * wg[(size_t)i * DE]; ua += xv * wu[(size_t)i * DE]; }
            __syncthreads();
            hs[c.tid] = siluf_(ga) * ua;
            __syncthreads();
            const float* wd = w.wd + (size_t)e * DE * DM + c.tid;
            float y0 = 0.f, y1 = 0.f;
            for (int i = 0; i < DE; ++i) { const float hv = hs[i]; y0 += hv * wd[(size_t)i * DM]; y1 += hv * wd[(size_t)i * DM + 512]; }
            f0 += gk * y0; f1 += gk * y1;
        }
        F[(size_t)t * DM + c.tid] = f0; F[(size_t)t * DM + c.tid + 512] = f1;
    }
}
__device__ __forceinline__ void nv_ln2(const Ctx& c, const Lw& w, const float* X1, const float* F, float* X2, bf16* XB) {
    for (int t = c.gw; t < M; t += c.ngw) {
        f32x4 v[4];
#pragma unroll
        for (int j = 0; j < 4; ++j) v[j] = ALPHA * *(const f32x4*)(X1 + (size_t)t * DM + c.lane * 4 + 256 * j) + *(const f32x4*)(F + (size_t)t * DM + c.lane * 4 + 256 * j);
        ln1024(v, w.ln2_g, w.ln2_b, c.lane);
#pragma unroll
        for (int j = 0; j < 4; ++j) { *(f32x4*)(X2 + (size_t)t * DM + c.lane * 4 + 256 * j) = v[j]; st_bf4(XB + (size_t)t * DM + c.lane * 4 + 256 * j, v[j]); }
    }
}

namespace pg8 {
#define PG8_LAS __attribute__((address_space(3)))
typedef unsigned short bf16_t;
typedef short bf16x8 __attribute__((ext_vector_type(8)));
typedef float f32x4 __attribute__((ext_vector_type(4)));
typedef unsigned u32x4 __attribute__((ext_vector_type(4)));
constexpr int BM = 256, BK = 64, HALF = 128, HTB = HALF * BK * 2  , STAGE_BYTES = 8 * HTB, NXCD = 8, WGM = 8;

__host__ __device__ __forceinline__ int lds_byte(int r, int c) { const int st = (r >> 4) * 2 + (c >> 5), rr = r & 15, cc = c & 31, ob = rr * 64 + cc * 2; return st * 1024 + (ob ^ (((ob >> 9) & 1) << 5)); }
__host__ __device__ __forceinline__ void stage_rc(int b, int& R, int& C) { const int st = b / 1024, sb = b % 1024, swz = sb ^ (((sb >> 9) & 1) << 5); R = (st >> 1) * 16 + swz / 64; C = (st & 1) * 32 + (swz % 64) / 2; }
__host__ __device__ __forceinline__ int perm32(int rho) { const int n = rho >> 4, i = rho & 15; return 8 * (i >> 2) + 4 * n + (i & 3); }

struct Unit { int pm, pn; };
struct Gemm { const bf16_t* A; const bf16_t* Bt; int M, N, K; };

struct StaticOrder {
    int nM, nN, nwg, G, c;
    __host__ __device__ void init(int M, int N, int G_, int c_) { nM = M / BM; nN = N / BM; nwg = nM * nN; G = G_; c = c_; }
    __host__ __device__ bool next(int i, Unit& u) const {
        const long L = (long)i * G + c; if (L >= nwg) return false;
        int wgid = (int)L; { const int q = nwg / NXCD, r = nwg % NXCD, xcd = wgid % NXCD, off = wgid / NXCD; wgid = (xcd < r ? xcd * (q + 1) : r * (q + 1) + (xcd - r) * q) + off; }
        const int nig = WGM * nN, gid = wgid / nig, fm = gid * WGM, gsz = (nM - fm) < WGM ? (nM - fm) : WGM;
        u.pm = fm + ((wgid % nig) % gsz); u.pn = (wgid % nig) / gsz; return true;
    }
    __device__ __forceinline__ void a_ready(const Unit&) const {}
    __device__ __forceinline__ void done(const Unit&) const {}
};

__device__ __forceinline__ unsigned cvt_pk_bf16(float lo, float hi) { unsigned r; asm volatile("v_cvt_pk_bf16_f32 %0, %1, %2" : "=v"(r) : "v"(lo), "v"(hi)); return r; }
typedef float f32x2 __attribute__((ext_vector_type(2)));
__device__ __forceinline__ f32x2 gelu_pk(f32x2 v) {
    const f32x2 av = __builtin_elementwise_abs(v), d = av * 0.2316418882f + 1.0f;
    f32x2 t; t.x = __builtin_amdgcn_rcpf(d.x); t.y = __builtin_amdgcn_rcpf(d.y);
    f32x2 q = t * 0.5307027145f + (-0.7265760135f); q = q * t + 0.7107068705f; q = q * t + (-0.142248368f); q = q * t + 0.127414796f; q = q * t;
    const f32x2 s = (v * v) * (-0.72134752044f);
    f32x2 e; e.x = __builtin_amdgcn_exp2f(s.x); e.y = __builtin_amdgcn_exp2f(s.y);
    const f32x2 m = v * (q * e), r = v - m;
    f32x2 o; o.x = v.x < 0.f ? m.x : r.x; o.y = v.y < 0.f ? m.y : r.y; return o;
}

template <int ACT  > struct EpiBf16 {
    static constexpr bool PERM = true, AFTER_DRAIN = false; static_assert(ACT == 0 || ACT == 1, "EpiBf16: ACT is 0 (none) or 1 (gelu_pk)");
    bf16_t* O; int ldc; const float* bias; int split_cols; size_t split_stride; float scale0; int pn_mask;
    __device__ __forceinline__ void operator()(const f32x4 (&acc)[2][2][4][2], const Unit& u, int wr, int wc, int fr, int fq) const {
        const int row0 = u.pm * BM + wr * 64 + fr; int colt = (u.pn & pn_mask) * BM; bf16_t* base = O;
        float sc = 1.f; if (split_cols) { const int t = colt / split_cols; base += (size_t)t * split_stride; colt -= t * split_cols; if (t == 0) sc = scale0; }
        const int col0 = colt + wc * 32 + 8 * fq, bcol0 = (u.pn & pn_mask) * BM + wc * 32 + 8 * fq;
        f32x4 bv[2][2];
#pragma unroll
        for (int bj = 0; bj < 2; ++bj)
#pragma unroll
            for (int n = 0; n < 2; ++n) bv[bj][n] = bias ? *(const f32x4*)(bias + bcol0 + bj * HALF + 4 * n) : (f32x4){0.f, 0.f, 0.f, 0.f};
#pragma unroll
        for (int ai = 0; ai < 2; ++ai)
#pragma unroll
            for (int m = 0; m < 4; ++m) { bf16_t* rowp = base + (size_t)(row0 + ai * HALF + m * 16) * ldc + col0;
#pragma unroll
                for (int bj = 0; bj < 2; ++bj) { f32x4 v0 = acc[ai][bj][m][0] + bv[bj][0], v1 = acc[ai][bj][m][1] + bv[bj][1];
                    if (ACT == 1) { f32x2 a = gelu_pk((f32x2){v0[0], v0[1]}), b = gelu_pk((f32x2){v0[2], v0[3]}), c = gelu_pk((f32x2){v1[0], v1[1]}), d = gelu_pk((f32x2){v1[2], v1[3]});
                        v0 = (f32x4){a.x, a.y, b.x, b.y}; v1 = (f32x4){c.x, c.y, d.x, d.y}; }
                    v0 = v0 * sc; v1 = v1 * sc; u32x4 w; w.x = cvt_pk_bf16(v0[0], v0[1]); w.y = cvt_pk_bf16(v0[2], v0[3]); w.z = cvt_pk_bf16(v1[0], v1[1]); w.w = cvt_pk_bf16(v1[2], v1[3]);
                    *(u32x4*)(rowp + bj * HALF) = w; } }
    }
};


struct EpiResF32 {
    static constexpr bool PERM = false, AFTER_DRAIN = false;
    const float* X; float* U; float alpha;
    __device__ __forceinline__ void operator()(const f32x4 (&acc)[2][2][4][2], const Unit& u, int wr, int wc, int fr, int fq) const {
        const int col0 = u.pn * BM + wc * 32 + 4 * fq;
#pragma unroll
        for (int ai = 0; ai < 2; ++ai)
#pragma unroll
            for (int m = 0; m < 4; ++m) { const size_t off = (size_t)(u.pm * BM + ai * HALF + wr * 64 + m * 16 + fr) * 1024 + col0;
#pragma unroll
                for (int bj = 0; bj < 2; ++bj)
#pragma unroll
                    for (int n = 0; n < 2; ++n) *(f32x4*)(U + off + bj * HALF + n * 16) = acc[ai][bj][m][n] + alpha * *(const f32x4*)(X + off + bj * HALF + n * 16); }
    }
};
template <class Epi, class Sched, bool ALIGN_EPI = false, bool SP2 = false>
__device__ __forceinline__ void gemm_phase(PG8_LAS unsigned char* lds, const Gemm g, const Sched& S, const Epi& E, const int tid) {
    const int wid = __builtin_amdgcn_readfirstlane(tid >> 6), lane = tid & 63, wr = wid >> 2, wc = wid & 3, fr = lane & 15, fq = lane >> 4;
    const int K = g.K, nt = K / BK;
    unsigned voffA[2], voffB[2];
#pragma unroll
    for (int i = 0; i < 2; ++i) { int R, C; stage_rc(tid * 16 + i * 8192, R, C); const int Rb = Epi::PERM ? ((R & ~31) + perm32(R & 31)) : R;
        voffA[i] = (unsigned)(R * K + C) * 2u; voffB[i] = (unsigned)(Rb * K + C) * 2u; }
    const size_t kstep = (size_t)(BK * 2);
    const size_t hstep = (size_t)HALF * K * 2;
    const size_t tstep = 2 * hstep;
    const unsigned ldsw = (unsigned)wid * 1024u;
    const int aoff = lds_byte(wr * 64 + fr, fq * 8), boff = lds_byte(wc * 32 + fr, fq * 8);
#define PG8_SA(b, h) (((b) * 2 + (h)) * HTB)
#define PG8_SB(b, h) ((4 + (b) * 2 + (h)) * HTB)
#define PG8_STAGE(bufoff, gbase, voff) do { _Pragma("unroll") for (int _i = 0; _i < 2; ++_i) \
        __builtin_amdgcn_global_load_lds((const unsigned*)((const char*)(gbase) + (voff)[_i]), (PG8_LAS unsigned*)(lds + (bufoff) + ldsw + _i * 8192), 16, 0, 0); } while (0)
#define PG8_LDA(dst, b, h) do { _Pragma("unroll") for (int m = 0; m < 4; ++m) _Pragma("unroll") for (int k = 0; k < 2; ++k) dst[m][k] = *(const PG8_LAS bf16x8*)(lds + PG8_SA(b, h) + aoff + m * 2048 + k * 1024); } while (0)
#define PG8_LDB(dst, b, h) do { _Pragma("unroll") for (int n = 0; n < 2; ++n) _Pragma("unroll") for (int k = 0; k < 2; ++k) dst[n][k] = *(const PG8_LAS bf16x8*)(lds + PG8_SB(b, h) + boff + n * 2048 + k * 1024); } while (0)
#define PG8_MMA(ai, bj, At, Bt) do { __builtin_amdgcn_s_setprio(1); _Pragma("unroll") for (int m = 0; m < 4; ++m) _Pragma("unroll") for (int n = 0; n < 2; ++n) _Pragma("unroll") for (int k = 0; k < 2; ++k) \
        acc[ai][bj][m][n] = __builtin_amdgcn_mfma_f32_16x16x32_bf16(Bt[n][k], At[m][k], acc[ai][bj][m][n], 0, 0, 0); __builtin_amdgcn_s_setprio(0); } while (0)
#define PG8_WAIT_V(n) asm volatile("s_waitcnt vmcnt(" #n ")" ::: "memory")
#define PG8_WAIT_L(n) asm volatile("s_waitcnt lgkmcnt(" #n ")" ::: "memory")
#define PG8_BAR __builtin_amdgcn_s_barrier()
#define PG8_SCHED __builtin_amdgcn_sched_barrier(0)
    Unit cur, nxt; int ui = 0;
    if (!S.next(0, cur)) return;
    f32x4 acc[2][2][4][2];
#pragma unroll
    for (int a = 0; a < 2; ++a)
#pragma unroll
        for (int b = 0; b < 2; ++b)
#pragma unroll
            for (int m = 0; m < 4; ++m)
#pragma unroll
                for (int n = 0; n < 2; ++n) acc[a][b][m][n] = (f32x4){0.f, 0.f, 0.f, 0.f};
    bf16x8 At[4][2], B0[2][2], B1[2][2];
    const char* cA = (const char*)g.A + (size_t)cur.pm * tstep; const char* cB = (const char*)g.Bt + (size_t)cur.pn * tstep;
    S.a_ready(cur);
    if constexpr (SP2) {
        PG8_STAGE(PG8_SB(0, 0), cB, voffB); PG8_STAGE(PG8_SB(0, 1), cB + hstep, voffB); PG8_STAGE(PG8_SA(0, 0), cA, voffA); PG8_STAGE(PG8_SA(0, 1), cA + hstep, voffA);
        if (wr == 1) PG8_BAR;
        PG8_WAIT_V(2); PG8_BAR;
        PG8_STAGE(PG8_SB(1, 0), cB + kstep, voffB); PG8_STAGE(PG8_SA(1, 0), cA + kstep, voffA); PG8_STAGE(PG8_SB(1, 1), cB + hstep + kstep, voffB);
        PG8_WAIT_V(6); PG8_BAR;
    } else {
        PG8_STAGE(PG8_SB(0, 0), cB, voffB); PG8_STAGE(PG8_SA(0, 0), cA, voffA); PG8_STAGE(PG8_SB(0, 1), cB + hstep, voffB); PG8_STAGE(PG8_SA(0, 1), cA + hstep, voffA);
        if (wr == 1) PG8_BAR;
        PG8_WAIT_V(4); PG8_BAR;
        PG8_STAGE(PG8_SB(1, 0), cB + kstep, voffB); PG8_STAGE(PG8_SA(1, 0), cA + kstep, voffA); PG8_STAGE(PG8_SB(1, 1), cB + hstep + kstep, voffB);
        PG8_WAIT_V(6); PG8_BAR;
    }
    for (;;) {
        const bool has_next = S.next(ui + 1, nxt);
        const char* nA = has_next ? (const char*)g.A + (size_t)nxt.pm * tstep : cA; const char* nB = has_next ? (const char*)g.Bt + (size_t)nxt.pn * tstep : cB;
        for (int t = 0; t < nt; t += 2) {
            const bool last = (t == nt - 2);
            const char* a1 = cA + (size_t)(t + 1) * kstep;
            const char* a2 = last ? nA : cA + (size_t)(t + 2) * kstep; const char* b2 = last ? nB : cB + (size_t)(t + 2) * kstep;
            const char* a3 = a2 + kstep; const char* b3 = b2 + kstep;
            if (last && has_next) S.a_ready(nxt);
            if constexpr (SP2) {
            PG8_LDB(B0, 0, 0); PG8_LDB(B1, 0, 1); PG8_SCHED; PG8_LDA(At, 0, 0); PG8_STAGE(PG8_SA(1, 1), a1 + hstep, voffA);
            PG8_WAIT_V(8); PG8_WAIT_L(0); PG8_BAR; PG8_MMA(0, 0, At, B0); PG8_MMA(0, 1, At, B1); PG8_BAR; PG8_SCHED;
            PG8_LDA(At, 0, 1); PG8_STAGE(PG8_SB(0, 0), b2, voffB); PG8_STAGE(PG8_SB(0, 1), b2 + hstep, voffB); PG8_STAGE(PG8_SA(0, 0), a2, voffA);
            PG8_WAIT_V(8); PG8_WAIT_L(0); PG8_BAR; PG8_MMA(1, 0, At, B0); PG8_MMA(1, 1, At, B1); PG8_BAR; PG8_SCHED;
            PG8_LDB(B0, 1, 0); PG8_LDB(B1, 1, 1); PG8_SCHED; PG8_LDA(At, 1, 0); PG8_STAGE(PG8_SA(0, 1), a2 + hstep, voffA);
            PG8_WAIT_V(8); PG8_WAIT_L(0); PG8_BAR; PG8_MMA(0, 0, At, B0); PG8_MMA(0, 1, At, B1); PG8_BAR; PG8_SCHED;
            PG8_LDA(At, 1, 1); PG8_STAGE(PG8_SB(1, 0), b3, voffB); PG8_STAGE(PG8_SB(1, 1), b3 + hstep, voffB); PG8_STAGE(PG8_SA(1, 0), a3, voffA);
            PG8_WAIT_V(8); PG8_WAIT_L(0); PG8_BAR; PG8_MMA(1, 0, At, B0); PG8_MMA(1, 1, At, B1); PG8_BAR; PG8_SCHED;
            } else {
            PG8_LDB(B0, 0, 0); PG8_SCHED; PG8_LDA(At, 0, 0); PG8_STAGE(PG8_SA(1, 1), a1 + hstep, voffA);
            PG8_WAIT_L(8); PG8_BAR; PG8_WAIT_L(0); PG8_MMA(0, 0, At, B0); PG8_BAR; PG8_SCHED;
            PG8_LDB(B1, 0, 1); PG8_STAGE(PG8_SB(0, 0), b2, voffB);
            PG8_BAR; PG8_WAIT_L(0); PG8_MMA(0, 1, At, B1); PG8_BAR;
            PG8_LDA(At, 0, 1); PG8_STAGE(PG8_SA(0, 0), a2, voffA);
            PG8_BAR; PG8_WAIT_L(0); PG8_MMA(1, 0, At, B0); PG8_BAR; PG8_SCHED;
            PG8_STAGE(PG8_SB(0, 1), b2 + hstep, voffB);
            PG8_WAIT_V(6); PG8_BAR; PG8_MMA(1, 1, At, B1); PG8_BAR;
            PG8_LDB(B0, 1, 0); PG8_SCHED; PG8_LDA(At, 1, 0); PG8_STAGE(PG8_SA(0, 1), a2 + hstep, voffA);
            PG8_WAIT_L(8); PG8_BAR; PG8_WAIT_L(0); PG8_MMA(0, 0, At, B0); PG8_BAR; PG8_SCHED;
            PG8_LDB(B1, 1, 1); PG8_STAGE(PG8_SB(1, 0), b3, voffB);
            PG8_BAR; PG8_WAIT_L(0); PG8_MMA(0, 1, At, B1); PG8_BAR;
            PG8_LDA(At, 1, 1); PG8_STAGE(PG8_SA(1, 0), a3, voffA);
            PG8_BAR; PG8_WAIT_L(0); PG8_MMA(1, 0, At, B0); PG8_BAR; PG8_SCHED;
            PG8_STAGE(PG8_SB(1, 1), b3 + hstep, voffB);
            PG8_WAIT_V(6); PG8_BAR; PG8_MMA(1, 1, At, B1); PG8_BAR;
            }
        }
        if constexpr (ALIGN_EPI) { if (wr == 0) PG8_BAR; }
        if constexpr (!Epi::AFTER_DRAIN) { E(acc, cur, wr, wc, fr, fq); S.done(cur); }
        if (!has_next) break;
#pragma unroll
        for (int a = 0; a < 2; ++a)
#pragma unroll
            for (int b = 0; b < 2; ++b)
#pragma unroll
                for (int m = 0; m < 4; ++m)
#pragma unroll
                    for (int n = 0; n < 2; ++n) acc[a][b][m][n] = (f32x4){0.f, 0.f, 0.f, 0.f};
        cur = nxt; cA = nA; cB = nB; ++ui;
        if constexpr (ALIGN_EPI) { if (wr == 1) PG8_BAR; }
    }
    PG8_WAIT_V(0);
    if constexpr (!ALIGN_EPI) { if (wr == 0) PG8_BAR; }
    PG8_BAR;
    if constexpr (Epi::AFTER_DRAIN) { E.fused(acc, cur, wr, wc, fr, fq, lds, wid, lane); S.done(cur); }
#undef PG8_SA
#undef PG8_SB
#undef PG8_STAGE
#undef PG8_LDA
#undef PG8_LDB
#undef PG8_MMA
#undef PG8_WAIT_V
#undef PG8_WAIT_L
#undef PG8_BAR
#undef PG8_SCHED
}
}


__device__ __forceinline__ void transpose_item(const float* W, int K, int N, bf16* WT, int dst_row0, LAS float* scr, int k0, int n0, int lane) {
#pragma unroll 8
    for (int i = 0; i < 32; ++i) { const int kk = 2 * i + (lane >> 5); scr[kk * 33 + (lane & 31)] = W[(size_t)(k0 + kk) * N + n0 + (lane & 31)]; }
    asm volatile("s_waitcnt lgkmcnt(0)" ::: "memory");
    const int cc = lane & 7;
#pragma unroll
    for (int j = 0; j < 4; ++j) { const int n = (lane >> 3) + 8 * j; const LAS float* s = scr + (8 * cc) * 33 + n;
        u32x4 o; o.x = pk2(s[0 * 33], s[1 * 33]); o.y = pk2(s[2 * 33], s[3 * 33]); o.z = pk2(s[4 * 33], s[5 * 33]); o.w = pk2(s[6 * 33], s[7 * 33]);
        *(u32x4*)(WT + (size_t)(dst_row0 + n) * K + k0 + 8 * cc) = o; }
    asm volatile("s_waitcnt lgkmcnt(0)" ::: "memory");
}
__device__ __forceinline__ void weights_prologue(const Ctx& c, const Args& a, unsigned char* ws) {
    LAS float* scr = (LAS float*)(c.lds + c.wave * 16384);
    bf16* WIN = (bf16*)(ws + WS_WIN); bf16* WO = (bf16*)(ws + WS_WO); bf16* WGU = (bf16*)(ws + WS_WGU); bf16* WD = (bf16*)(ws + WS_WD);
    constexpr int I_IN = NL * 16 * 64, I_O = NL * 16 * 32, I_G = NL * NE * 16 * 16, I_D = NL * NE * 8 * 32;
    constexpr int NITEMS = I_IN + I_O + 2 * I_G + I_D;
    for (int it = c.gw; it < NITEMS; it += c.ngw) {
        int r = it;
        if (r < I_IN) { const int l = r >> 10, kb = (r >> 6) & 15, nb = r & 63; transpose_item(a.in[1] + (size_t)l * DM * DIN, DM, DIN, WIN, l * DIN + nb * 32, scr, kb * 64, nb * 32, c.lane); continue; } r -= I_IN;
        if (r < I_O) { const int l = r >> 9, kb = (r >> 5) & 15, nb = r & 31; transpose_item(a.in[15] + (size_t)l * DM * DM, DM, DM, WO, l * DM + nb * 32, scr, kb * 64, nb * 32, c.lane); continue; } r -= I_O;
        if (r < 2 * I_G) { const int up = r >= I_G; if (up) r -= I_G; const int le = r >> 8, kb = (r >> 4) & 15, nb = r & 15, n0 = nb * 32;
            transpose_item(a.in[up ? 21 : 20] + (size_t)le * DM * DE, DM, DE, WGU, le * 1024 + (n0 >> 7) * 256 + (n0 & 127) + up * 128, scr, kb * 64, n0, c.lane); continue; } r -= 2 * I_G;
        { const int le = r >> 8, kb = (r >> 5) & 7, nb = r & 31; transpose_item(a.in[22] + (size_t)le * DE * DM, DE, DM, WD, le * 1024 + nb * 32, scr, kb * 64, nb * 32, c.lane); }
    }
}

constexpr int PH_PER_LAYER = 6, N_PHASES = 1 + NL * PH_PER_LAYER;
__global__ void __launch_bounds__(NT, 2) fwd_kernel(Args args) {
    extern __shared__ __attribute__((aligned(16))) unsigned char lds_raw[];
    Ctx c;
    c.lds = (LAS unsigned char*)lds_raw;
    c.tid = threadIdx.x; c.lane = c.tid & 63; c.wave = __builtin_amdgcn_readfirstlane(c.tid >> 6);
    c.gtid = blockIdx.x * NT + c.tid; c.gsize = gridDim.x * NT; c.gw = blockIdx.x * NWAVES + c.wave; c.ngw = gridDim.x * NWAVES;
    unsigned char* ws = args.ws;
    volatile LAS unsigned* MISC = (volatile LAS unsigned*)(c.lds + LDS_BYTES - 64);
    if (c.tid < 16) MISC[c.tid] = 0u;
    __syncthreads();
    XcdBarrier bar; bar.bar = (unsigned*)ws + CW_BAR; bar.x = 0; bar.st = nullptr;
    const bool one = (args.ph_hi - args.ph_lo) > 1;
    if (one) bar = xcd_barrier_post((unsigned*)ws + CW_BAR, MISC + 8);
    bf16* Z = (bf16*)(ws + WS_Z); bf16* XB = (bf16*)(ws + WS_XB); bf16* YN = (bf16*)(ws + WS_YN);
    float* U = (float*)(ws + WS_U); float* F = (float*)(ws + WS_F);
    bf16* GMW = (bf16*)(ws + WS_GMW); bf16* PWT = (bf16*)(ws + WS_PWT); bf16* POOLT = (bf16*)(ws + WS_POOLT);
    unsigned* RTE = (unsigned*)(ws + WS_RT); float* RTG = (float*)(ws + WS_RT + 512 * 1024);
    const Ctx c0 = c;
    for (int ph = args.ph_lo; ph < args.ph_hi; ++ph) {
        c = c0; asm volatile("" : "+v"(c.tid)); c.lane = c.tid & 63; c.gtid = blockIdx.x * NT + c.tid;
        if (ph == 0) { nv_prologue(c, args.in[0], XB); small_weights(c, args, GMW, PWT, POOLT); weights_prologue(c, args, ws); }
        else {
            const int l = (ph - 1) / PH_PER_LAYER, p = (ph - 1) % PH_PER_LAYER;
            const Lw w = layer_weights(args, l);
            const float* X = (l == 0) ? args.in[0] : args.out;
            switch (p) {
            case 0: { pg8::Gemm g{XB, (const bf16*)(ws + WS_WIN) + (size_t)l * DIN * DM, M, DIN, DM}; pg8::StaticOrder S; S.init(M, DIN, (int)gridDim.x, (int)blockIdx.x);
                pg8::EpiBf16<0> E{Z, DIN, nullptr, 0, 0, 1.f, 0xffff};
                pg8::gemm_phase<pg8::EpiBf16<0>, pg8::StaticOrder, true, true>(c.lds, g, S, E, c.tid); } break;
            case 1: mixer_phase(c, w, l, Z, GMW, PWT, POOLT, YN); break;
            case 2: { pg8::Gemm g{YN, (const bf16*)(ws + WS_WO) + (size_t)l * DM * DM, M, DM, DM}; pg8::StaticOrder S; S.init(M, DM, (int)gridDim.x, (int)blockIdx.x);
                pg8::EpiResF32 E{X, U, ALPHA};
                pg8::gemm_phase<pg8::EpiResF32, pg8::StaticOrder, true, true>(c.lds, g, S, E, c.tid); } break;
            case 3: nv_ln1_router(c, w, U, args.out, RTE, RTG); break;
            case 4: nv_moe(c, w, args.out, RTE, RTG, F); break;
            case 5: nv_ln2(c, w, args.out, F, args.out, XB); break;
            }
        }
        if (one && ph + 1 < args.ph_hi) xcd_barrier(bar);
    }
}

extern "C" void kernel_launch(void* const* d_in, const int* in_sizes, int n_in, void* d_out, int out_size, void* d_ws, size_t ws_size, hipStream_t stream) {
    static int grid = 0;
    if (grid == 0) {
        if (n_in != 25 || in_sizes[0] != M * DM || out_size != M * DM || ws_size < WS_END) { fprintf(stderr, "kernel_launch: unexpected shapes/ws (n_in %d ws %zu)\n", n_in, ws_size); grid = -1; return; }
        int dev = 0, cus = 0;
        if (hipGetDevice(&dev) != hipSuccess || hipDeviceGetAttribute(&cus, hipDeviceAttributeMultiprocessorCount, dev) != hipSuccess) { grid = -1; return; }
        if (hipFuncSetAttribute((const void*)fwd_kernel, hipFuncAttributeMaxDynamicSharedMemorySize, LDS_BYTES) != hipSuccess) { grid = -1; return; }
        (void)hipGetLastError();
        grid = cus;
    }
    if (grid < 0) return;
    (void)hipMemsetAsync((char*)d_ws + WS_CTL, 0, CTL_ZERO_BYTES, stream);
    Args a{};
    for (int i = 0; i < 25; ++i) a.in[i] = (const float*)d_in[i];
    a.out = (float*)d_out; a.ws = (unsigned char*)d_ws;
#if MK_ONE_LAUNCH
    a.ph_lo = 0; a.ph_hi = N_PHASES;
    hipLaunchKernelGGL(fwd_kernel, dim3(grid), dim3(NT), LDS_BYTES, stream, a);
#else
    for (int ph = 0; ph < N_PHASES; ++ph) { a.ph_lo = ph; a.ph_hi = ph + 1; hipLaunchKernelGGL(fwd_kernel, dim3(grid), dim3(NT), LDS_BYTES, stream, a); }
#endif
}
```

```cpp
#include <hip/hip_runtime.h>
#include <cstdio>
#include <cstdint>

#ifndef MK_ONE_LAUNCH
#define MK_ONE_LAUNCH 1
#endif

constexpr int NB = 4, SEQ = 4096, DM = 1024, M = NB * SEQ, DIN = 2048, NE = 16, DE = 512, NL = 2;
constexpr int DG = 256, CHUNK = 128, CONFK = 31;
constexpr float ALPHA = 1.41421356237309515f;
constexpr float LN_EPS = 1e-5f, RMS_EPS = 1e-6f;
constexpr int NWAVES = 8, NT = NWAVES * 64;
constexpr int LDS_BYTES = 147456;

typedef unsigned short bf16;
typedef float f32x4 __attribute__((ext_vector_type(4)));
typedef unsigned u32x4 __attribute__((ext_vector_type(4)));
typedef unsigned u32x2 __attribute__((ext_vector_type(2)));
#define LAS __attribute__((address_space(3)))
#define GAS __attribute__((address_space(1)))
typedef GAS unsigned gu32;
#define RLX_AGENT __ATOMIC_RELAXED, __HIP_MEMORY_SCOPE_AGENT

constexpr size_t MiB = 1u << 20;
constexpr size_t WS_CTL = 0, CTL_ZERO_BYTES = 1 * MiB;
constexpr size_t WS_WIN = 1 * MiB;
constexpr size_t WS_WO = 9 * MiB;
constexpr size_t WS_WGU = 13 * MiB;
constexpr size_t WS_WD = 77 * MiB;
constexpr size_t WS_SMALL = 109 * MiB;
constexpr size_t WS_GMW = WS_SMALL, WS_PWT = WS_SMALL + 256 * 1024, WS_POOLT = WS_SMALL + 512 * 1024;
constexpr size_t WS_A = 110 * MiB;
constexpr size_t WS_Z = WS_A, WS_U = WS_A, WS_F = WS_A;
constexpr size_t WS_D = 182 * MiB;
constexpr size_t WS_XB = WS_D, WS_YN = WS_D, WS_H = WS_D;
constexpr size_t WS_RT = 218 * MiB;
constexpr size_t WS_END = 219 * MiB;
constexpr int CW_BAR = 4096;

__device__ __forceinline__ float bf2f(bf16 v) { return __uint_as_float(((unsigned)v) << 16); }
__device__ __forceinline__ unsigned f2bf(float f) { unsigned u = __float_as_uint(f); return (u + 0x7fffu + ((u >> 16) & 1u)) >> 16; }
__device__ __forceinline__ unsigned pk2(float lo, float hi) { return f2bf(lo) | (f2bf(hi) << 16); }
__device__ __forceinline__ float sigmoidf_(float x) { return 1.0f / (1.0f + __expf(-x)); }
__device__ __forceinline__ float siluf_(float x) { return x * sigmoidf_(x); }
__device__ __forceinline__ float wave_sum(float v) {
#pragma unroll
    for (int o = 1; o < 64; o <<= 1) v += __shfl_xor(v, o);
    return v;
}

#define XB_TMO      128
#define XB_XCNT(j)  (256  + 64 * (j))
#define XB_XSUB(j)  (1280 + 64 * (j))
#define XB_XGEN(j)  (2304 + 64 * (j))
#define XB_TOP      3328
#define XB_TOPGEN   3392
#define XCD_BAR_WORDS 3456
#define XB_SPIN_CAP (1u << 18)
__device__ __forceinline__ unsigned xb_ld(unsigned* p)              { return __hip_atomic_load(p, __ATOMIC_RELAXED, __HIP_MEMORY_SCOPE_AGENT); }
__device__ __forceinline__ unsigned xb_add(unsigned* p, unsigned v) { return __hip_atomic_fetch_add(p, v, __ATOMIC_RELAXED, __HIP_MEMORY_SCOPE_AGENT); }
__device__ __forceinline__ unsigned xb_xcc_id() { return (unsigned)__builtin_amdgcn_s_getreg((3 << 11) | 20) & 0xFu; }
#define XB_SPIN(cond, bar) do { unsigned _sp = 0; while (cond) { __builtin_amdgcn_s_sleep(1); \
    if ((++_sp & 255u) == 0u) { if (xb_ld(&(bar)[XB_TMO])) break; if (_sp > XB_SPIN_CAP) { atomicAdd(&(bar)[XB_TMO], 1u); break; } } } } while (0)
struct XcdBarrier { unsigned* bar; unsigned x; volatile LAS unsigned* st; };
__device__ __forceinline__ XcdBarrier xcd_barrier_post(unsigned* bar, volatile LAS unsigned* st) {
    XcdBarrier b; b.bar = bar; b.x = xb_xcc_id(); b.st = st;
    if (threadIdx.x == 0) (void)xb_add(&bar[XB_XCNT(b.x)], 1u);
    return b;
}
__device__ __forceinline__ void xcd_barrier_complete(unsigned* bar, unsigned x, unsigned& nloc, unsigned& nx) {
    const unsigned G = gridDim.x * gridDim.y * gridDim.z;
    unsigned sum, cnt, mine, sp = 0u;
    for (;;) {
        sum = 0u; cnt = 0u; mine = 0u;
#pragma unroll
        for (unsigned j = 0; j < 16; ++j) { const unsigned c = xb_ld(&bar[XB_XCNT(j)]); sum += c; cnt += (c > 0u) ? 1u : 0u; mine = (j == x) ? c : mine; }
        if (sum == G) break;
        __builtin_amdgcn_s_sleep(1);
        if ((++sp & 255u) == 0u) { if (xb_ld(&bar[XB_TMO])) break; if (sp > XB_SPIN_CAP) { atomicAdd(&bar[XB_TMO], 1u); break; } }
    }
    nloc = mine > 0u ? mine : 1u; nx = cnt > 0u ? cnt : 1u;
}
__device__ __forceinline__ void xcd_barrier(const XcdBarrier& b) {
    asm volatile("s_waitcnt vmcnt(0)" ::: "memory");
    __syncthreads();
    if (threadIdx.x == 0) {
        unsigned* bar = b.bar;
        __builtin_amdgcn_s_waitcnt(0);
        unsigned nloc = b.st[0], nx = b.st[1];
        if (nloc == 0u) { xcd_barrier_complete(bar, b.x, nloc, nx); b.st[0] = nloc; b.st[1] = nx; }
        const unsigned old = xb_add(&bar[XB_XSUB(b.x)], 1u);
        const unsigned gen = old / nloc;
        if (old + 1u == (gen + 1u) * nloc) {
            __builtin_amdgcn_fence(__ATOMIC_RELEASE, "agent");
            asm volatile("s_waitcnt vmcnt(0)" ::: "memory");
            const unsigned og = xb_add(&bar[XB_TOP], 1u);
            const unsigned tg = og / nx;
            if (og + 1u == (tg + 1u) * nx) xb_add(&bar[XB_TOPGEN], 1u);
            else XB_SPIN(xb_ld(&bar[XB_TOPGEN]) == tg, bar);
            __builtin_amdgcn_fence(__ATOMIC_ACQUIRE, "agent");
            xb_add(&bar[XB_XGEN(b.x)], 1u);
            asm volatile("s_waitcnt vmcnt(0)" ::: "memory");
        } else {
            XB_SPIN(xb_ld(&bar[XB_XGEN(b.x)]) == gen, bar);
            __builtin_amdgcn_fence(__ATOMIC_ACQUIRE, "agent");
            asm volatile("s_waitcnt vmcnt(0)" ::: "memory");
        }
    }
    __syncthreads();
}

struct Args { const float* in[25]; float* out; unsigned char* ws; int ph_lo, ph_hi; };

struct Ctx {
    int tid, lane, wave, gtid, gsize, gw, ngw;
    LAS unsigned char* lds;
};

template <class Epi>
__device__ __forceinline__ void nv_gemm(const Ctx& c, const bf16* A, int lda, const float* W, int ldw, int Mr, int N, int K, const Epi& epi) {
    const int ntn = N / 4; const long total = (long)ntn * (Mr / 4);
    for (long i = c.gtid; i < total; i += c.gsize) {
        const int tn = (int)(i % ntn), tm = (int)(i / ntn);
        float acc[4][4];
#pragma unroll
        for (int r = 0; r < 4; ++r)
#pragma unroll
            for (int q = 0; q < 4; ++q) acc[r][q] = 0.f;
        const bf16* a0 = A + (size_t)(tm * 4) * lda;
        const float* w0 = W + tn * 4;
        for (int k = 0; k < K; k += 8) {
            u32x4 av[4];
#pragma unroll
            for (int r = 0; r < 4; ++r) av[r] = *(const u32x4*)(a0 + (size_t)r * lda + k);
#pragma unroll
            for (int kk = 0; kk < 8; ++kk) {
                const f32x4 w = *(const f32x4*)(w0 + (size_t)(k + kk) * ldw);
#pragma unroll
                for (int r = 0; r < 4; ++r) {
                    const unsigned pr = av[r][kk >> 1];
                    const float a = (kk & 1) ? __uint_as_float(pr & 0xffff0000u) : __uint_as_float(pr << 16);
#pragma unroll
                    for (int q = 0; q < 4; ++q) acc[r][q] += a * w[q];
                }
            }
        }
#pragma unroll
        for (int r = 0; r < 4; ++r) epi(tm * 4 + r, tn * 4, (f32x4){acc[r][0], acc[r][1], acc[r][2], acc[r][3]});
    }
}

__device__ __forceinline__ void ln256(f32x4& v, const float* g, const float* b, int lane) {
    const float mean = wave_sum((v[0] + v[1]) + (v[2] + v[3])) * (1.f / 256.f);
    v = v - mean;
    const float var = wave_sum((v[0] * v[0] + v[1] * v[1]) + (v[2] * v[2] + v[3] * v[3])) * (1.f / 256.f);
    const float rstd = 1.0f / sqrtf(var + LN_EPS);
    const f32x4 gg = *(const f32x4*)(g + lane * 4), bb = *(const f32x4*)(b + lane * 4);
    v = v * rstd * gg + bb;
}
__device__ __forceinline__ f32x4 ld_bf4(const bf16* p) { const u32x2 w = *(const u32x2*)p; return (f32x4){__uint_as_float(w.x << 16), __uint_as_float(w.x & 0xffff0000u), __uint_as_float(w.y << 16), __uint_as_float(w.y & 0xffff0000u)}; }
__device__ __forceinline__ void st_bf4(bf16* p, f32x4 v) { u32x2 w; w.x = pk2(v[0], v[1]); w.y = pk2(v[2], v[3]); *(u32x2*)p = w; }

struct Lw {
    const float *w_in, *gm_ln_g, *gm_ln_b, *gm_w_s, *gm_b_s, *cf_dw_w, *cf_dw_b, *cf_ln_g, *cf_ln_b, *cf_pw, *pool_w, *pool_scale, *sc_w, *mix_norm_g, *w_o, *ln1_g, *ln1_b,
        *router_w, *router_b, *wg, *wu, *wd, *ln2_g, *ln2_b;
};
__device__ __forceinline__ Lw layer_weights(const Args& a, int l) {
    Lw w;
    w.w_in = a.in[1] + (size_t)l * DM * DIN; w.gm_ln_g = a.in[2] + l * DG; w.gm_ln_b = a.in[3] + l * DG; w.gm_w_s = a.in[4] + (size_t)l * 4 * CHUNK * CHUNK; w.gm_b_s = a.in[5] + l * 4 * CHUNK;
    w.cf_dw_w = a.in[6] + l * CONFK * DG; w.cf_dw_b = a.in[7] + l * DG; w.cf_ln_g = a.in[8] + l * DG; w.cf_ln_b = a.in[9] + l * DG; w.cf_pw = a.in[10] + (size_t)l * DG * DG;
    w.pool_w = a.in[11] + l * 4 * 64 * 64; w.pool_scale = a.in[12] + l * DG; w.sc_w = a.in[13] + l * 3 * DG; w.mix_norm_g = a.in[14] + l * DM; w.w_o = a.in[15] + (size_t)l * DM * DM;
    w.ln1_g = a.in[16] + l * DM; w.ln1_b = a.in[17] + l * DM; w.router_w = a.in[18]; w.router_b = a.in[19];
    w.wg = a.in[20] + (size_t)l * NE * DM * DE; w.wu = a.in[21] + (size_t)l * NE * DM * DE; w.wd = a.in[22] + (size_t)l * NE * DE * DM;
    w.ln2_g = a.in[23] + l * DM; w.ln2_b = a.in[24] + l * DM;
    return w;
}

__device__ __forceinline__ void nv_prologue(const Ctx& c, const float* x, bf16* XB) {
    for (size_t i = c.gtid; i < (size_t)M * DM / 4; i += c.gsize) st_bf4(XB + i * 4, *(const f32x4*)(x + i * 4));
}
typedef short bf16x8 __attribute__((ext_vector_type(8)));
__device__ __forceinline__ bf16x8 as_bf16x8(u32x4 v) { return __builtin_bit_cast(bf16x8, v); }
#define MFMA16(a, b, c) __builtin_amdgcn_mfma_f32_16x16x32_bf16((a), (b), (c), 0, 0, 0)
constexpr int YT_LD = 260;
constexpr int AT_LD = 264;
constexpr int VT_RS = 260;

__device__ __forceinline__ void small_weights(const Ctx& c, const Args& a, bf16* GMW, bf16* PWT, bf16* POOLT) {
    for (int i = c.gtid; i < NL * 4 * CHUNK * CHUNK; i += c.gsize) { const int s = i & 127, t = (i >> 7) & 127; GMW[i] = (bf16)((s <= t) ? f2bf(a.in[4][i]) : 0u); }
    for (int i = c.gtid; i < NL * DG * DG; i += c.gsize) { const int cc = i & 255, n = (i >> 8) & 255, l = i >> 16; PWT[i] = (bf16)f2bf(a.in[10][((size_t)l * DG + cc) * DG + n]); }
    for (int i = c.gtid; i < NL * 4 * 64 * 64; i += c.gsize) { const int d = i & 63, e = (i >> 6) & 63, lg = i >> 12; POOLT[i] = (bf16)f2bf(a.in[11][((size_t)lg * 64 + d) * 64 + e]); }
}

__device__ __forceinline__ void mix_final(const Ctx& c, const Lw& w, int t0, int grp, bf16* YN) {
    const LAS float* YT = (const LAS float*)c.lds;
    const f32x4 g = *(const f32x4*)(w.mix_norm_g + grp * DG + c.lane * 4);
#pragma unroll 4
    for (int i = 0; i < 16; ++i) {
        const int t = c.wave * 16 + i;
        f32x4 v = *(const LAS f32x4*)(YT + t * YT_LD + c.lane * 4);
        const float ms = wave_sum((v[0] * v[0] + v[1] * v[1]) + (v[2] * v[2] + v[3] * v[3])) * (1.f / 256.f);
        const float r = 1.0f / sqrtf(ms + RMS_EPS);
        st_bf4(YN + (size_t)(t0 + t) * DM + grp * DG + c.lane * 4, v * r * g);
    }
}

__device__ __forceinline__ void mix_conformer(const Ctx& c, const Lw& w, const bf16* Z, const bf16* PWT, int t0, bf16* YN) {
    LAS unsigned char* lds = c.lds;
    const int pos0 = t0 % SEQ;
    for (int r = c.tid >> 5; r < 158; r += 16) {
        const int c8 = (c.tid & 31) * 8; u32x4 o = (u32x4){0u, 0u, 0u, 0u};
        if (pos0 + r - 30 >= 0) {
            const size_t zr = (size_t)(t0 + r - 30) * DIN;
            const u32x4 av = *(const u32x4*)(Z + zr + 512 + c8), gv = *(const u32x4*)(Z + zr + 768 + c8);
#pragma unroll
            for (int j = 0; j < 4; ++j) {
                const float a0 = __uint_as_float(av[j] << 16), a1 = __uint_as_float(av[j] & 0xffff0000u), g0 = __uint_as_float(gv[j] << 16), g1 = __uint_as_float(gv[j] & 0xffff0000u);
                o[j] = pk2(a0 * sigmoidf_(g0), a1 * sigmoidf_(g1));
            }
        }
        *(LAS u32x4*)(lds + r * 512 + c8 * 2) = o;
    }
    __syncthreads();
    constexpr int CT_OFF = 80896;
    {
        const int ch = c.tid & 255, tg = c.tid >> 8;
        float wk[CONFK];
#pragma unroll
        for (int k = 0; k < CONFK; ++k) wk[k] = w.cf_dw_w[k * DG + ch];
        const float b0 = w.cf_dw_b[ch];
#pragma unroll 1
        for (int sb = 0; sb < 8; ++sb) {
            float acc[8];
#pragma unroll
            for (int j = 0; j < 8; ++j) acc[j] = b0;
            const int rb = tg * 64 + sb * 8;
#pragma unroll
            for (int r = 0; r < 38; ++r) {
                const float h0 = bf2f(*(const LAS bf16*)(lds + (rb + r) * 512 + ch * 2));
#pragma unroll
                for (int j = 0; j < 8; ++j) { const int k = r - j; if (k >= 0 && k < CONFK) acc[j] += wk[k] * h0; }
            }
#pragma unroll
            for (int j = 0; j < 8; ++j) *(LAS bf16*)(lds + CT_OFF + (rb + j) * 512 + ch * 2) = (bf16)f2bf(acc[j]);
        }
    }
    __syncthreads();
    {
        const f32x4 g = *(const f32x4*)(w.cf_ln_g + c.lane * 4), b = *(const f32x4*)(w.cf_ln_b + c.lane * 4);
#pragma unroll 4
        for (int i = 0; i < 16; ++i) {
            const int t = c.wave * 16 + i;
            const u32x2 pv = *(const LAS u32x2*)(lds + CT_OFF + t * 512 + c.lane * 8);
            f32x4 v = (f32x4){__uint_as_float(pv.x << 16), __uint_as_float(pv.x & 0xffff0000u), __uint_as_float(pv.y << 16), __uint_as_float(pv.y & 0xffff0000u)};
            const float mean = wave_sum((v[0] + v[1]) + (v[2] + v[3])) * (1.f / 256.f);
            v = v - mean;
            const float var = wave_sum((v[0] * v[0] + v[1] * v[1]) + (v[2] * v[2] + v[3] * v[3])) * (1.f / 256.f);
            v = v * (1.0f / sqrtf(var + LN_EPS)) * g + b;
            u32x2 o; o.x = pk2(siluf_(v[0]), siluf_(v[1])); o.y = pk2(siluf_(v[2]), siluf_(v[3]));
            *(LAS u32x2*)(lds + t * (AT_LD * 2) + c.lane * 8) = o;
        }
    }
    __syncthreads();
    {
        const int fr = c.lane & 15, fq = c.lane >> 4;
        f32x4 C[8][2];
#pragma unroll
        for (int rt = 0; rt < 8; ++rt) { C[rt][0] = (f32x4){0.f, 0.f, 0.f, 0.f}; C[rt][1] = (f32x4){0.f, 0.f, 0.f, 0.f}; }
        bf16x8 Bf[2][8];
#pragma unroll
        for (int ct = 0; ct < 2; ++ct)
#pragma unroll
            for (int ks = 0; ks < 8; ++ks) Bf[ct][ks] = as_bf16x8(*(const u32x4*)(PWT + (size_t)(c.wave * 32 + ct * 16 + fr) * DG + ks * 32 + fq * 8));
#pragma unroll
        for (int rt = 0; rt < 8; ++rt)
#pragma unroll
            for (int ks = 0; ks < 8; ++ks) {
                const bf16x8 Af = as_bf16x8(*(const LAS u32x4*)(lds + (rt * 16 + fr) * (AT_LD * 2) + (ks * 32 + fq * 8) * 2));
                C[rt][0] = MFMA16(Af, Bf[0][ks], C[rt][0]); C[rt][1] = MFMA16(Af, Bf[1][ks], C[rt][1]);
            }
        __syncthreads();
        LAS float* YT = (LAS float*)lds;
#pragma unroll
        for (int rt = 0; rt < 8; ++rt)
#pragma unroll
            for (int ct = 0; ct < 2; ++ct)
#pragma unroll
                for (int j = 0; j < 4; ++j) YT[(rt * 16 + fq * 4 + j) * YT_LD + c.wave * 32 + ct * 16 + fr] = C[rt][ct][j];
    }
    __syncthreads();
    mix_final(c, w, t0, 1, YN);
}

__device__ __forceinline__ void mix_gmlp(const Ctx& c, const Lw& w, const bf16* Z, const bf16* GMW, int t0, bf16* YN) {
    LAS unsigned char* lds = c.lds;
    {
        float g[4], b[4];
#pragma unroll
        for (int q = 0; q < 4; ++q) { g[q] = w.gm_ln_g[c.lane + 64 * q]; b[q] = w.gm_ln_b[c.lane + 64 * q]; }
#pragma unroll 2
        for (int i = 0; i < 8; ++i) {
            const int s = c.wave * 16 + 2 * i;
            float v[2][4];
#pragma unroll
            for (int p = 0; p < 2; ++p) {
#pragma unroll
                for (int q = 0; q < 4; ++q) v[p][q] = bf2f(Z[(size_t)(t0 + s + p) * DIN + 256 + c.lane + 64 * q]);
                const float mean = wave_sum((v[p][0] + v[p][1]) + (v[p][2] + v[p][3])) * (1.f / 256.f);
#pragma unroll
                for (int q = 0; q < 4; ++q) v[p][q] -= mean;
                const float var = wave_sum((v[p][0] * v[p][0] + v[p][1] * v[p][1]) + (v[p][2] * v[p][2] + v[p][3] * v[p][3])) * (1.f / 256.f);
                const float rstd = 1.0f / sqrtf(var + LN_EPS);
#pragma unroll
                for (int q = 0; q < 4; ++q) v[p][q] = v[p][q] * rstd * g[q] + b[q];
            }
#pragma unroll
            for (int q = 0; q < 4; ++q) *(LAS unsigned*)(lds + (c.lane + 64 * q) * VT_RS + s * 2) = pk2(v[0][q], v[1][q]);
        }
    }
    __syncthreads();
    const int fr = c.lane & 15, fq = c.lane >> 4, h = c.wave >> 1, par = c.wave & 1;
    bf16x8 Bf[4][4];
#pragma unroll
    for (int ct = 0; ct < 4; ++ct)
#pragma unroll
        for (int ks = 0; ks < 4; ++ks) {
            u32x4 t;
#pragma unroll
            for (int i = 0; i < 4; ++i) t[i] = *(const LAS unsigned*)(lds + (h * 64 + ct * 16 + fr) * VT_RS + (ks * 32 + fq * 8 + 2 * i) * 2);
            Bf[ct][ks] = as_bf16x8(t);
        }
    __syncthreads();
    LAS float* YT = (LAS float*)lds;
#pragma unroll 1
    for (int i = 0; i < 4; ++i) {
        const int R = par + 2 * i;
        f32x4 C[4];
#pragma unroll
        for (int ct = 0; ct < 4; ++ct) C[ct] = (f32x4){0.f, 0.f, 0.f, 0.f};
#pragma unroll
        for (int ks = 0; ks < 4; ++ks) {
            if (32 * ks <= 16 * R + 15) {
                const bf16x8 Af = as_bf16x8(*(const u32x4*)(GMW + ((size_t)(h * CHUNK + 16 * R + fr)) * CHUNK + ks * 32 + fq * 8));
#pragma unroll
                for (int ct = 0; ct < 4; ++ct) C[ct] = MFMA16(Af, Bf[ct][ks], C[ct]);
            }
        }
#pragma unroll
        for (int j = 0; j < 4; ++j) {
            const int t = 16 * R + fq * 4 + j; const float bs = w.gm_b_s[h * CHUNK + t];
#pragma unroll
            for (int ct = 0; ct < 4; ++ct) {
                const int ch = h * 64 + ct * 16 + fr;
                YT[t * YT_LD + ch] = bf2f(Z[(size_t)(t0 + t) * DIN + ch]) * (C[ct][j] + bs);
            }
        }
    }
    __syncthreads();
    mix_final(c, w, t0, 0, YN);
}

__device__ __forceinline__ void mix_pool(const Ctx& c, const Lw& w, const bf16* Z, const bf16* POOLT, int t0, bf16* YN) {
    LAS unsigned char* lds = c.lds;
    const int pos0 = t0 % SEQ;
    constexpr int PA_OFF = 73728;
    for (int r = c.tid >> 5; r < 143; r += 16) {
        const int c8 = (c.tid & 31) * 8; u32x4 o = (u32x4){0u, 0u, 0u, 0u};
        if (pos0 + r - 15 >= 0) o = *(const u32x4*)(Z + (size_t)(t0 + r - 15) * DIN + 1024 + c8);
        *(LAS u32x4*)(lds + r * 512 + c8 * 2) = o;
    }
    __syncthreads();
    {
        const int cp = c.tid & 127, tg = c.tid >> 7, W = 2 << (cp >> 5);
        float s0 = 0.f, s1 = 0.f;
        for (int i = 1; i < W; ++i) { const unsigned zv = *(const LAS unsigned*)(lds + (tg * 32 + 15 - i) * 512 + cp * 4); s0 += __uint_as_float(zv << 16); s1 += __uint_as_float(zv & 0xffff0000u); }
        for (int j = 0; j < 32; ++j) {
            const int tl = tg * 32 + j, pos = pos0 + tl;
            const unsigned zv = *(const LAS unsigned*)(lds + (tl + 15) * 512 + cp * 4);
            const float z0 = __uint_as_float(zv << 16), z1 = __uint_as_float(zv & 0xffff0000u);
            s0 += z0; s1 += z1;
            const float inv = 1.0f / (float)((pos + 1 < W) ? pos + 1 : W);
            *(LAS unsigned*)(lds + PA_OFF + tl * (AT_LD * 2) + cp * 4) = pk2(s0 * inv - z0, s1 * inv - z1);
            const unsigned zo = *(const LAS unsigned*)(lds + (tl + 15 - (W - 1)) * 512 + cp * 4);
            s0 -= __uint_as_float(zo << 16); s1 -= __uint_as_float(zo & 0xffff0000u);
        }
    }
    __syncthreads();
    {
        const int fr = c.lane & 15, fq = c.lane >> 4, g = c.wave >> 1, cb = (c.wave & 1) * 2;
        f32x4 C[8][2];
#pragma unroll
        for (int rt = 0; rt < 8; ++rt) { C[rt][0] = (f32x4){0.f, 0.f, 0.f, 0.f}; C[rt][1] = (f32x4){0.f, 0.f, 0.f, 0.f}; }
        bf16x8 Bf[2][2];
#pragma unroll
        for (int ct = 0; ct < 2; ++ct)
#pragma unroll
            for (int ks = 0; ks < 2; ++ks) Bf[ct][ks] = as_bf16x8(*(const u32x4*)(POOLT + (size_t)(g * 64 + (cb + ct) * 16 + fr) * 64 + ks * 32 + fq * 8));
#pragma unroll
        for (int rt = 0; rt < 8; ++rt)
#pragma unroll
            for (int ks = 0; ks < 2; ++ks) {
                const bf16x8 Af = as_bf16x8(*(const LAS u32x4*)(lds + PA_OFF + (rt * 16 + fr) * (AT_LD * 2) + (g * 64 + ks * 32 + fq * 8) * 2));
                C[rt][0] = MFMA16(Af, Bf[0][ks], C[rt][0]); C[rt][1] = MFMA16(Af, Bf[1][ks], C[rt][1]);
            }
        __syncthreads();
        LAS float* YT = (LAS float*)lds;
#pragma unroll
        for (int ct = 0; ct < 2; ++ct) {
            const int ch = g * 64 + (cb + ct) * 16 + fr; const float sc = w.pool_scale[ch];
#pragma unroll
            for (int rt = 0; rt < 8; ++rt)
#pragma unroll
                for (int j = 0; j < 4; ++j) YT[(rt * 16 + fq * 4 + j) * YT_LD + ch] = C[rt][ct][j] * sc;
        }
    }
    __syncthreads();
    mix_final(c, w, t0, 2, YN);
}

__device__ __forceinline__ void mix_sconv(const Ctx& c, const Lw& w, const bf16* Z, int t0, bf16* YN) {
    LAS float* YT = (LAS float*)c.lds;
    const int pos0 = t0 % SEQ;
    for (int r = c.tid >> 5; r < 128; r += 16) {
        const int c8 = (c.tid & 31) * 8;
        float acc[8];
#pragma unroll
        for (int j = 0; j < 8; ++j) acc[j] = 0.f;
#pragma unroll
        for (int k = 0; k < 3; ++k) {
            const int d = k - 2;
            if (pos0 + r + d >= 0) {
                const size_t zr = (size_t)(t0 + r + d) * DIN;
                const u32x4 cv = *(const u32x4*)(Z + zr + 1536 + c8), hv = *(const u32x4*)(Z + zr + 1792 + c8);
                const f32x4 w0 = *(const f32x4*)(w.sc_w + k * DG + c8), w1 = *(const f32x4*)(w.sc_w + k * DG + c8 + 4);
#pragma unroll
                for (int j = 0; j < 4; ++j) {
                    acc[2 * j] += (j < 2 ? w0[2 * j] : w1[2 * j - 4]) * (__uint_as_float(cv[j] << 16) * __uint_as_float(hv[j] << 16));
                    acc[2 * j + 1] += (j < 2 ? w0[2 * j + 1] : w1[2 * j - 3]) * (__uint_as_float(cv[j] & 0xffff0000u) * __uint_as_float(hv[j] & 0xffff0000u));
                }
            }
        }
        const u32x4 bv = *(const u32x4*)(Z + (size_t)(t0 + r) * DIN + 1280 + c8);
        f32x4 o0, o1;
        o0[0] = __uint_as_float(bv[0] << 16) * acc[0]; o0[1] = __uint_as_float(bv[0] & 0xffff0000u) * acc[1]; o0[2] = __uint_as_float(bv[1] << 16) * acc[2]; o0[3] = __uint_as_float(bv[1] & 0xffff0000u) * acc[3];
        o1[0] = __uint_as_float(bv[2] << 16) * acc[4]; o1[1] = __uint_as_float(bv[2] & 0xffff0000u) * acc[5]; o1[2] = __uint_as_float(bv[3] << 16) * acc[6]; o1[3] = __uint_as_float(bv[3] & 0xffff0000u) * acc[7];
        *(LAS f32x4*)(YT + r * YT_LD + c8) = o0; *(LAS f32x4*)(YT + r * YT_LD + c8 + 4) = o1;
    }
    __syncthreads();
    mix_final(c, w, t0, 3, YN);
}

__device__ __forceinline__ void mixer_phase(const Ctx& c0, const Lw& w, int l, const bf16* Z, const bf16* GMW, const bf16* PWT, const bf16* POOLT, bf16* YN) {
    for (int it = blockIdx.x; it < 512; it += gridDim.x) {
        Ctx c = c0; asm volatile("" : "+v"(c.tid)); c.lane = c.tid & 63;
        const int mx = it >> 7, t0 = (it & 127) * CHUNK;
        if (mx == 0) mix_conformer(c, w, Z, PWT + (size_t)l * DG * DG, t0, YN);
        else if (mx == 1) mix_gmlp(c, w, Z, GMW + (size_t)l * 4 * CHUNK * CHUNK, t0, YN);
        else if (mx == 2) mix_pool(c, w, Z, POOLT + (size_t)l * 4 * 64 * 64, t0, YN);
        else mix_sconv(c, w, Z, t0, YN);
        __syncthreads();
    }
}

struct EpiZ { bf16* Z; __device__ __forceinline__ void operator()(int r, int cc, f32x4 v) const { st_bf4(Z + (size_t)r * DIN + cc, v); } };
struct EpiU { float* U; const float* X; __device__ __forceinline__ void operator()(int r, int cc, f32x4 v) const { *(f32x4*)(U + (size_t)r * DM + cc) = v + ALPHA * *(const f32x4*)(X + (size_t)r * DM + cc); } };

__device__ __forceinline__ void ln1024(f32x4 (&v)[4], const float* g, const float* b, int lane) {
    float s = 0.f;
#pragma unroll
    for (int j = 0; j < 4; ++j) s += (v[j][0] + v[j][1]) + (v[j][2] + v[j][3]);
    const float mean = wave_sum(s) * (1.f / DM);
    float q = 0.f;
#pragma unroll
    for (int j = 0; j < 4; ++j) { v[j] = v[j] - mean; q += (v[j][0] * v[j][0] + v[j][1] * v[j][1]) + (v[j][2] * v[j][2] + v[j][3] * v[j][3]); }
    const float rstd = 1.0f / sqrtf(wave_sum(q) * (1.f / DM) + LN_EPS);
#pragma unroll
    for (int j = 0; j < 4; ++j) v[j] = v[j] * rstd * *(const f32x4*)(g + lane * 4 + 256 * j) + *(const f32x4*)(b + lane * 4 + 256 * j);
}
__device__ __forceinline__ void nv_ln1_router(const Ctx& c, const Lw& w, const float* U, float* X1, unsigned* RTE, float* RTG) {
    for (int t = c.gw; t < M; t += c.ngw) {
        f32x4 v[4];
#pragma unroll
        for (int j = 0; j < 4; ++j) v[j] = *(const f32x4*)(U + (size_t)t * DM + c.lane * 4 + 256 * j);
        ln1024(v, w.ln1_g, w.ln1_b, c.lane);
#pragma unroll
        for (int j = 0; j < 4; ++j) *(f32x4*)(X1 + (size_t)t * DM + c.lane * 4 + 256 * j) = v[j];
        float lg[16];
#pragma unroll
        for (int e = 0; e < 16; ++e) lg[e] = 0.f;
#pragma unroll
        for (int j = 0; j < 4; ++j)
#pragma unroll
            for (int q = 0; q < 4; ++q) {
                const float xv = v[j][q]; const float* wr = w.router_w + (size_t)(c.lane * 4 + 256 * j + q) * NE;
#pragma unroll
                for (int e4 = 0; e4 < 4; ++e4) { const f32x4 ww = *(const f32x4*)(wr + e4 * 4);
                    lg[e4 * 4 + 0] += xv * ww[0]; lg[e4 * 4 + 1] += xv * ww[1]; lg[e4 * 4 + 2] += xv * ww[2]; lg[e4 * 4 + 3] += xv * ww[3]; }
            }
#pragma unroll
        for (int e = 0; e < 16; ++e) lg[e] = wave_sum(lg[e]);
        float best_score = 0.f; int best = -1;
#pragma unroll
        for (int g = 0; g < 4; ++g) {
            float m1 = -INFINITY, m2 = -INFINITY;
#pragma unroll
            for (int j = 0; j < 4; ++j) { const float s = lg[g * 4 + j] + w.router_b[g * 4 + j]; if (s > m1) { m2 = m1; m1 = s; } else if (s > m2) m2 = s; }
            const float sc = m1 + m2;
            if (best < 0 || sc > best_score) { best_score = sc; best = g; }
        }
        float s1 = -INFINITY, s2 = -INFINITY, l1 = 0.f, l2 = 0.f; int i1 = 0, i2 = 0;
#pragma unroll
        for (int e = 0; e < 16; ++e) {
            if ((e >> 2) == best) { const float s = lg[e] + w.router_b[e];
                if (s > s1) { s2 = s1; i2 = i1; l2 = l1; s1 = s; i1 = e; l1 = lg[e]; } else if (s > s2) { s2 = s; i2 = e; l2 = lg[e]; } }
        }
        const float mx = fmaxf(l1, l2), e1 = __expf(l1 - mx), e2 = __expf(l2 - mx), inv = 1.0f / (e1 + e2);
        if (c.lane == 0) { RTE[t] = (unsigned)i1 | ((unsigned)i2 << 8); RTG[2 * t] = e1 * inv; RTG[2 * t + 1] = e2 * inv; }
    }
}
constexpr int CW_CNT = 8192;
__device__ __forceinline__ void moe_ranks(const Ctx& c, const unsigned* RTE, int* RTP, unsigned* CNT) {
    LAS int* LC = (LAS int*)c.lds;
    __syncthreads();
    if (c.tid < 32) LC[c.tid] = 0;
    __syncthreads();
    for (int t = c.gw; t < M; t += c.ngw) {
        if (c.lane == 0) { const unsigned ee = RTE[t]; RTP[2 * t] = __hip_atomic_fetch_add(&LC[ee & 0xff], 1, __ATOMIC_RELAXED, __HIP_MEMORY_SCOPE_WORKGROUP); RTP[2 * t + 1] = __hip_atomic_fetch_add(&LC[(ee >> 8) & 0xff], 1, __ATOMIC_RELAXED, __HIP_MEMORY_SCOPE_WORKGROUP); }
    }
    __syncthreads();
    if (c.tid < 16) LC[16 + c.tid] = (int)atomicAdd(&CNT[c.tid], (unsigned)LC[c.tid]);
    __syncthreads();
    for (int t = c.gw; t < M; t += c.ngw) {
        if (c.lane == 0) { const unsigned ee = RTE[t]; RTP[2 * t] += LC[16 + (ee & 0xff)]; RTP[2 * t + 1] += LC[16 + ((ee >> 8) & 0xff)]; }
    }
}
constexpr int LDS_TAB_OFF = 131072;
__device__ __forceinline__ void moe_tiles(const Ctx& c, const unsigned* CNT) {
    LAS int* ts = (LAS int*)(c.lds + LDS_TAB_OFF);
    __syncthreads();
    if (c.tid < 17) { int s = 0; for (int e = 0; e < c.tid; ++e) s += (int)((CNT[e] + 255u) >> 8); ts[c.tid] = s; }
    __syncthreads();
}
__device__ __forceinline__ void moe_gather(const Ctx& c, const float* X1, const unsigned* RTE, int* RTP, const unsigned* CNT, bf16* XG) {
    LAS int* RS = (LAS int*)c.lds;
    __syncthreads();
    if (c.tid < 16) { int s = 0; for (int e = 0; e < c.tid; ++e) s += (int)((CNT[e] + 255u) >> 8); RS[c.tid] = s * 256; }
    __syncthreads();
    for (int p = c.gw; p < 2 * M; p += c.ngw) {
        const int t = p >> 1, k = p & 1;
        const int e = (RTE[t] >> (8 * k)) & 0xff;
        const int slot = RS[e] + RTP[p];
        f32x4 v[4];
#pragma unroll
        for (int j = 0; j < 4; ++j) v[j] = *(const f32x4*)(X1 + (size_t)t * DM + c.lane * 4 + 256 * j);
#pragma unroll
        for (int j = 0; j < 4; ++j) st_bf4(XG + (size_t)slot * DM + c.lane * 4 + 256 * j, v[j]);
        asm volatile("" ::: "memory");
        if (c.lane == 0) RTP[p] = slot;
    }
}
__device__ __forceinline__ void moe_combine_ln2(const Ctx& c, const Lw& w, const float* X1, const bf16* YS, const float* RTG, const int* RTP, float* X2, bf16* XB) {
    for (int t = c.gw; t < M; t += c.ngw) {
        const int s0 = RTP[2 * t], s1 = RTP[2 * t + 1]; const float g0 = RTG[2 * t], g1 = RTG[2 * t + 1];
        f32x4 v[4];
#pragma unroll
        for (int j = 0; j < 4; ++j) {
            const int col = c.lane * 4 + 256 * j;
            v[j] = ALPHA * *(const f32x4*)(X1 + (size_t)t * DM + col) + g0 * ld_bf4(YS + (size_t)s0 * DM + col) + g1 * ld_bf4(YS + (size_t)s1 * DM + col);
        }
        ln1024(v, w.ln2_g, w.ln2_b, c.lane);
#pragma unroll
        for (int j = 0; j < 4; ++j) { *(f32x4*)(X2 + (size_t)t * DM + c.lane * 4 + 256 * j) = v[j]; st_bf4(XB + (size_t)t * DM + c.lane * 4 + 256 * j, v[j]); }
    }
}

__device__ __forceinline__ void nv_moe(const Ctx& c, const Lw& w, const float* X1, const unsigned* RTE, const float* RTG, float* F) {
    LAS float* xs = (LAS float*)c.lds; LAS float* hs = xs + DM;
    for (int t = blockIdx.x; t < M; t += gridDim.x) {
        __syncthreads();
        xs[c.tid] = X1[(size_t)t * DM + c.tid]; xs[c.tid + 512] = X1[(size_t)t * DM + c.tid + 512];
        __syncthreads();
        const unsigned ee = RTE[t]; float f0 = 0.f, f1 = 0.f;
        for (int k = 0; k < 2; ++k) {
            const int e = (ee >> (8 * k)) & 0xff; const float gk = RTG[2 * t + k];
            const float* wg = w.wg + (size_t)e * DM * DE + c.tid; const float* wu = w.wu + (size_t)e * DM * DE + c.tid;
            float ga = 0.f, ua = 0.f;
            for (int i = 0; i < DM; ++i) { const float xv = xs[i]; ga += xv * wg[(size_t)i * DE]; ua += xv * wu[(size_t)i * DE]; }
            __syncthreads();
            hs[c.tid] = siluf_(ga) * ua;
            __syncthreads();
            const float* wd = w.wd + (size_t)e * DE * DM + c.tid;
            float y0 = 0.f, y1 = 0.f;
            for (int i = 0; i < DE; ++i) { const float hv = hs[i]; y0 += hv * wd[(size_t)i * DM]; y1 += hv * wd[(size_t)i * DM + 512]; }
            f0 += gk * y0; f1 += gk * y1;
        }
        F[(size_t)t * DM + c.tid] = f0; F[(size_t)t * DM + c.tid + 512] = f1;
    }
}
__device__ __forceinline__ void nv_ln2(const Ctx& c, const Lw& w, const float* X1, const float* F, float* X2, bf16* XB) {
    for (int t = c.gw; t < M; t += c.ngw) {
        f32x4 v[4];
#pragma unroll
        for (int j = 0; j < 4; ++j) v[j] = ALPHA * *(const f32x4*)(X1 + (size_t)t * DM + c.lane * 4 + 256 * j) + *(const f32x4*)(F + (size_t)t * DM + c.lane * 4 + 256 * j);
        ln1024(v, w.ln2_g, w.ln2_b, c.lane);
#pragma unroll
        for (int j = 0; j < 4; ++j) { *(f32x4*)(X2 + (size_t)t * DM + c.lane * 4 + 256 * j) = v[j]; st_bf4(XB + (size_t)t * DM + c.lane * 4 + 256 * j, v[j]); }
    }
}

namespace pg8 {
#define PG8_LAS __attribute__((address_space(3)))
typedef unsigned short bf16_t;
typedef short bf16x8 __attribute__((ext_vector_type(8)));
typedef float f32x4 __attribute__((ext_vector_type(4)));
typedef unsigned u32x4 __attribute__((ext_vector_type(4)));
constexpr int BM = 256, BK = 64, HALF = 128, HTB = HALF * BK * 2  , STAGE_BYTES = 8 * HTB, NXCD = 8, WGM = 8;

__host__ __device__ __forceinline__ int lds_byte(int r, int c) { const int st = (r >> 4) * 2 + (c >> 5), rr = r & 15, cc = c & 31, ob = rr * 64 + cc * 2; return st * 1024 + (ob ^ (((ob >> 9) & 1) << 5)); }
__host__ __device__ __forceinline__ void stage_rc(int b, int& R, int& C) { const int st = b / 1024, sb = b % 1024, swz = sb ^ (((sb >> 9) & 1) << 5); R = (st >> 1) * 16 + swz / 64; C = (st & 1) * 32 + (swz % 64) / 2; }
__host__ __device__ __forceinline__ int perm32(int rho) { const int n = rho >> 4, i = rho & 15; return 8 * (i >> 2) + 4 * n + (i & 3); }

struct Unit { int pm, pn; };
struct Gemm { const bf16_t* A; const bf16_t* Bt; int M, N, K; };

struct StaticOrder {
    int nM, nN, nwg, G, c;
    __host__ __device__ void init(int M, int N, int G_, int c_) { nM = M / BM; nN = N / BM; nwg = nM * nN; G = G_; c = c_; }
    __host__ __device__ bool next(int i, Unit& u) const {
        const long L = (long)i * G + c; if (L >= nwg) return false;
        int wgid = (int)L; { const int q = nwg / NXCD, r = nwg % NXCD, xcd = wgid % NXCD, off = wgid / NXCD; wgid = (xcd < r ? xcd * (q + 1) : r * (q + 1) + (xcd - r) * q) + off; }
        const int nig = WGM * nN, gid = wgid / nig, fm = gid * WGM, gsz = (nM - fm) < WGM ? (nM - fm) : WGM;
        u.pm = fm + ((wgid % nig) % gsz); u.pn = (wgid % nig) / gsz; return true;
    }
    __device__ __forceinline__ void a_ready(const Unit&) const {}
    __device__ __forceinline__ void done(const Unit&) const {}
};

__device__ __forceinline__ unsigned cvt_pk_bf16(float lo, float hi) { unsigned r; asm volatile("v_cvt_pk_bf16_f32 %0, %1, %2" : "=v"(r) : "v"(lo), "v"(hi)); return r; }
typedef float f32x2 __attribute__((ext_vector_type(2)));
__device__ __forceinline__ f32x2 gelu_pk(f32x2 v) {
    const f32x2 av = __builtin_elementwise_abs(v), d = av * 0.2316418882f + 1.0f;
    f32x2 t; t.x = __builtin_amdgcn_rcpf(d.x); t.y = __builtin_amdgcn_rcpf(d.y);
    f32x2 q = t * 0.5307027145f + (-0.7265760135f); q = q * t + 0.7107068705f; q = q * t + (-0.142248368f); q = q * t + 0.127414796f; q = q * t;
    const f32x2 s = (v * v) * (-0.72134752044f);
    f32x2 e; e.x = __builtin_amdgcn_exp2f(s.x); e.y = __builtin_amdgcn_exp2f(s.y);
    const f32x2 m = v * (q * e), r = v - m;
    f32x2 o; o.x = v.x < 0.f ? m.x : r.x; o.y = v.y < 0.f ? m.y : r.y; return o;
}

template <int ACT  > struct EpiBf16 {
    static constexpr bool PERM = true, AFTER_DRAIN = false; static_assert(ACT == 0 || ACT == 1, "EpiBf16: ACT is 0 (none) or 1 (gelu_pk)");
    bf16_t* O; int ldc; const float* bias; int split_cols; size_t split_stride; float scale0; int pn_mask;
    __device__ __forceinline__ void operator()(const f32x4 (&acc)[2][2][4][2], const Unit& u, int wr, int wc, int fr, int fq) const {
        const int row0 = u.pm * BM + wr * 64 + fr; int colt = (u.pn & pn_mask) * BM; bf16_t* base = O;
        float sc = 1.f; if (split_cols) { const int t = colt / split_cols; base += (size_t)t * split_stride; colt -= t * split_cols; if (t == 0) sc = scale0; }
        const int col0 = colt + wc * 32 + 8 * fq, bcol0 = (u.pn & pn_mask) * BM + wc * 32 + 8 * fq;
        f32x4 bv[2][2];
#pragma unroll
        for (int bj = 0; bj < 2; ++bj)
#pragma unroll
            for (int n = 0; n < 2; ++n) bv[bj][n] = bias ? *(const f32x4*)(bias + bcol0 + bj * HALF + 4 * n) : (f32x4){0.f, 0.f, 0.f, 0.f};
#pragma unroll
        for (int ai = 0; ai < 2; ++ai)
#pragma unroll
            for (int m = 0; m < 4; ++m) { bf16_t* rowp = base + (size_t)(row0 + ai * HALF + m * 16) * ldc + col0;
#pragma unroll
                for (int bj = 0; bj < 2; ++bj) { f32x4 v0 = acc[ai][bj][m][0] + bv[bj][0], v1 = acc[ai][bj][m][1] + bv[bj][1];
                    if (ACT == 1) { f32x2 a = gelu_pk((f32x2){v0[0], v0[1]}), b = gelu_pk((f32x2){v0[2], v0[3]}), c = gelu_pk((f32x2){v1[0], v1[1]}), d = gelu_pk((f32x2){v1[2], v1[3]});
                        v0 = (f32x4){a.x, a.y, b.x, b.y}; v1 = (f32x4){c.x, c.y, d.x, d.y}; }
                    v0 = v0 * sc; v1 = v1 * sc; u32x4 w; w.x = cvt_pk_bf16(v0[0], v0[1]); w.y = cvt_pk_bf16(v0[2], v0[3]); w.z = cvt_pk_bf16(v1[0], v1[1]); w.w = cvt_pk_bf16(v1[2], v1[3]);
                    *(u32x4*)(rowp + bj * HALF) = w; } }
    }
};


struct EpiResF32 {
    static constexpr bool PERM = false, AFTER_DRAIN = false;
    const float* X; float* U; float alpha;
    __device__ __forceinline__ void operator()(const f32x4 (&acc)[2][2][4][2], const Unit& u, int wr, int wc, int fr, int fq) const {
        const int col0 = u.pn * BM + wc * 32 + 4 * fq;
#pragma unroll
        for (int ai = 0; ai < 2; ++ai)
#pragma unroll
            for (int m = 0; m < 4; ++m) { const size_t off = (size_t)(u.pm * BM + ai * HALF + wr * 64 + m * 16 + fr) * 1024 + col0;
#pragma unroll
                for (int bj = 0; bj < 2; ++bj)
#pragma unroll
                    for (int n = 0; n < 2; ++n) *(f32x4*)(U + off + bj * HALF + n * 16) = acc[ai][bj][m][n] + alpha * *(const f32x4*)(X + off + bj * HALF + n * 16); }
    }
};

struct MoeOrder {
    const PG8_LAS int* ts; int G, c;
    __device__ __forceinline__ bool next(int i, Unit& u) const {
        const int L = i * G + c; if (L >= __builtin_amdgcn_readfirstlane(ts[16]) * 4) return false;
        const int rt = L >> 2; int e = 0;
#pragma unroll
        for (int k = 1; k < 16; ++k) e += (rt >= ts[k]) ? 1 : 0;
        u.pm = rt; u.pn = __builtin_amdgcn_readfirstlane(e) * 4 + (L & 3); return true;
    }
    __device__ __forceinline__ void a_ready(const Unit&) const {}
    __device__ __forceinline__ void done(const Unit&) const {}
};
struct EpiSwiGLU {
    static constexpr bool PERM = true, AFTER_DRAIN = false;
    bf16_t* H;
    __device__ __forceinline__ void operator()(const f32x4 (&acc)[2][2][4][2], const Unit& u, int wr, int wc, int fr, int fq) const {
        const int row0 = u.pm * BM + wr * 64 + fr, col0 = (u.pn & 3) * HALF + wc * 32 + 8 * fq;
#pragma unroll
        for (int ai = 0; ai < 2; ++ai)
#pragma unroll
            for (int m = 0; m < 4; ++m) {
                u32x4 w4;
#pragma unroll
                for (int n = 0; n < 2; ++n) {
                    const f32x4 g = acc[ai][0][m][n], up = acc[ai][1][m][n]; f32x4 h;
#pragma unroll
                    for (int q = 0; q < 4; ++q) h[q] = g[q] * __builtin_amdgcn_rcpf(1.0f + __expf(-g[q])) * up[q];
                    w4[2 * n] = cvt_pk_bf16(h[0], h[1]); w4[2 * n + 1] = cvt_pk_bf16(h[2], h[3]);
                }
                *(u32x4*)(H + (size_t)(row0 + ai * HALF + m * 16) * 512 + col0) = w4;
            }
    }
};
template <class Epi, class Sched, bool ALIGN_EPI = false, bool SP2 = false>
__device__ __forceinline__ void gemm_phase(PG8_LAS unsigned char* lds, const Gemm g, const Sched& S, const Epi& E, const int tid) {
    const int wid = __builtin_amdgcn_readfirstlane(tid >> 6), lane = tid & 63, wr = wid >> 2, wc = wid & 3, fr = lane & 15, fq = lane >> 4;
    const int K = g.K, nt = K / BK;
    unsigned voffA[2], voffB[2];
#pragma unroll
    for (int i = 0; i < 2; ++i) { int R, C; stage_rc(tid * 16 + i * 8192, R, C); const int Rb = Epi::PERM ? ((R & ~31) + perm32(R & 31)) : R;
        voffA[i] = (unsigned)(R * K + C) * 2u; voffB[i] = (unsigned)(Rb * K + C) * 2u; }
    const size_t kstep = (size_t)(BK * 2);
    const size_t hstep = (size_t)HALF * K * 2;
    const size_t tstep = 2 * hstep;
    const unsigned ldsw = (unsigned)wid * 1024u;
    const int aoff = lds_byte(wr * 64 + fr, fq * 8), boff = lds_byte(wc * 32 + fr, fq * 8);
#define PG8_SA(b, h) (((b) * 2 + (h)) * HTB)
#define PG8_SB(b, h) ((4 + (b) * 2 + (h)) * HTB)
#define PG8_STAGE(bufoff, gbase, voff) do { _Pragma("unroll") for (int _i = 0; _i < 2; ++_i) \
        __builtin_amdgcn_global_load_lds((const unsigned*)((const char*)(gbase) + (voff)[_i]), (PG8_LAS unsigned*)(lds + (bufoff) + ldsw + _i * 8192), 16, 0, 0); } while (0)
#define PG8_LDA(dst, b, h) do { _Pragma("unroll") for (int m = 0; m < 4; ++m) _Pragma("unroll") for (int k = 0; k < 2; ++k) dst[m][k] = *(const PG8_LAS bf16x8*)(lds + PG8_SA(b, h) + aoff + m * 2048 + k * 1024); } while (0)
#define PG8_LDB(dst, b, h) do { _Pragma("unroll") for (int n = 0; n < 2; ++n) _Pragma("unroll") for (int k = 0; k < 2; ++k) dst[n][k] = *(const PG8_LAS bf16x8*)(lds + PG8_SB(b, h) + boff + n * 2048 + k * 1024); } while (0)
#define PG8_MMA(ai, bj, At, Bt) do { __builtin_amdgcn_s_setprio(1); _Pragma("unroll") for (int m = 0; m < 4; ++m) _Pragma("unroll") for (int n = 0; n < 2; ++n) _Pragma("unroll") for (int k = 0; k < 2; ++k) \
        acc[ai][bj][m][n] = __builtin_amdgcn_mfma_f32_16x16x32_bf16(Bt[n][k], At[m][k], acc[ai][bj][m][n], 0, 0, 0); __builtin_amdgcn_s_setprio(0); } while (0)
#define PG8_WAIT_V(n) asm volatile("s_waitcnt vmcnt(" #n ")" ::: "memory")
#define PG8_WAIT_L(n) asm volatile("s_waitcnt lgkmcnt(" #n ")" ::: "memory")
#define PG8_BAR __builtin_amdgcn_s_barrier()
#define PG8_SCHED __builtin_amdgcn_sched_barrier(0)
    Unit cur, nxt; int ui = 0;
    if (!S.next(0, cur)) return;
    f32x4 acc[2][2][4][2];
#pragma unroll
    for (int a = 0; a < 2; ++a)
#pragma unroll
        for (int b = 0; b < 2; ++b)
#pragma unroll
            for (int m = 0; m < 4; ++m)
#pragma unroll
                for (int n = 0; n < 2; ++n) acc[a][b][m][n] = (f32x4){0.f, 0.f, 0.f, 0.f};
    bf16x8 At[4][2], B0[2][2], B1[2][2];
    const char* cA = (const char*)g.A + (size_t)cur.pm * tstep; const char* cB = (const char*)g.Bt + (size_t)cur.pn * tstep;
    S.a_ready(cur);
    if constexpr (SP2) {
        PG8_STAGE(PG8_SB(0, 0), cB, voffB); PG8_STAGE(PG8_SB(0, 1), cB + hstep, voffB); PG8_STAGE(PG8_SA(0, 0), cA, voffA); PG8_STAGE(PG8_SA(0, 1), cA + hstep, voffA);
        if (wr == 1) PG8_BAR;
        PG8_WAIT_V(2); PG8_BAR;
        PG8_STAGE(PG8_SB(1, 0), cB + kstep, voffB); PG8_STAGE(PG8_SA(1, 0), cA + kstep, voffA); PG8_STAGE(PG8_SB(1, 1), cB + hstep + kstep, voffB);
        PG8_WAIT_V(6); PG8_BAR;
    } else {
        PG8_STAGE(PG8_SB(0, 0), cB, voffB); PG8_STAGE(PG8_SA(0, 0), cA, voffA); PG8_STAGE(PG8_SB(0, 1), cB + hstep, voffB); PG8_STAGE(PG8_SA(0, 1), cA + hstep, voffA);
        if (wr == 1) PG8_BAR;
        PG8_WAIT_V(4); PG8_BAR;
        PG8_STAGE(PG8_SB(1, 0), cB + kstep, voffB); PG8_STAGE(PG8_SA(1, 0), cA + kstep, voffA); PG8_STAGE(PG8_SB(1, 1), cB + hstep + kstep, voffB);
        PG8_WAIT_V(6); PG8_BAR;
    }
    for (;;) {
        const bool has_next = S.next(ui + 1, nxt);
        const char* nA = has_next ? (const char*)g.A + (size_t)nxt.pm * tstep : cA; const char* nB = has_next ? (const char*)g.Bt + (size_t)nxt.pn * tstep : cB;
        for (int t = 0; t < nt; t += 2) {
            const bool last = (t == nt - 2);
            const char* a1 = cA + (size_t)(t + 1) * kstep;
            const char* a2 = last ? nA : cA + (size_t)(t + 2) * kstep; const char* b2 = last ? nB : cB + (size_t)(t + 2) * kstep;
            const char* a3 = a2 + kstep; const char* b3 = b2 + kstep;
            if (last && has_next) S.a_ready(nxt);
            if constexpr (SP2) {
            PG8_LDB(B0, 0, 0); PG8_LDB(B1, 0, 1); PG8_SCHED; PG8_LDA(At, 0, 0); PG8_STAGE(PG8_SA(1, 1), a1 + hstep, voffA);
            PG8_WAIT_V(8); PG8_WAIT_L(0); PG8_BAR; PG8_MMA(0, 0, At, B0); PG8_MMA(0, 1, At, B1); PG8_BAR; PG8_SCHED;
            PG8_LDA(At, 0, 1); PG8_STAGE(PG8_SB(0, 0), b2, voffB); PG8_STAGE(PG8_SB(0, 1), b2 + hstep, voffB); PG8_STAGE(PG8_SA(0, 0), a2, voffA);
            PG8_WAIT_V(8); PG8_WAIT_L(0); PG8_BAR; PG8_MMA(1, 0, At, B0); PG8_MMA(1, 1, At, B1); PG8_BAR; PG8_SCHED;
            PG8_LDB(B0, 1, 0); PG8_LDB(B1, 1, 1); PG8_SCHED; PG8_LDA(At, 1, 0); PG8_STAGE(PG8_SA(0, 1), a2 + hstep, voffA);
            PG8_WAIT_V(8); PG8_WAIT_L(0); PG8_BAR; PG8_MMA(0, 0, At, B0); PG8_MMA(0, 1, At, B1); PG8_BAR; PG8_SCHED;
            PG8_LDA(At, 1, 1); PG8_STAGE(PG8_SB(1, 0), b3, voffB); PG8_STAGE(PG8_SB(1, 1), b3 + hstep, voffB); PG8_STAGE(PG8_SA(1, 0), a3, voffA);
            PG8_WAIT_V(8); PG8_WAIT_L(0); PG8_BAR; PG8_MMA(1, 0, At, B0); PG8_MMA(1, 1, At, B1); PG8_BAR; PG8_SCHED;
            } else {
            PG8_LDB(B0, 0, 0); PG8_SCHED; PG8_LDA(At, 0, 0); PG8_STAGE(PG8_SA(1, 1), a1 + hstep, voffA);
            PG8_WAIT_L(8); PG8_BAR; PG8_WAIT_L(0); PG8_MMA(0, 0, At, B0); PG8_BAR; PG8_SCHED;
            PG8_LDB(B1, 0, 1); PG8_STAGE(PG8_SB(0, 0), b2, voffB);
            PG8_BAR; PG8_WAIT_L(0); PG8_MMA(0, 1, At, B1); PG8_BAR;
            PG8_LDA(At, 0, 1); PG8_STAGE(PG8_SA(0, 0), a2, voffA);
            PG8_BAR; PG8_WAIT_L(0); PG8_MMA(1, 0, At, B0); PG8_BAR; PG8_SCHED;
            PG8_STAGE(PG8_SB(0, 1), b2 + hstep, voffB);
            PG8_WAIT_V(6); PG8_BAR; PG8_MMA(1, 1, At, B1); PG8_BAR;
            PG8_LDB(B0, 1, 0); PG8_SCHED; PG8_LDA(At, 1, 0); PG8_STAGE(PG8_SA(0, 1), a2 + hstep, voffA);
            PG8_WAIT_L(8); PG8_BAR; PG8_WAIT_L(0); PG8_MMA(0, 0, At, B0); PG8_BAR; PG8_SCHED;
            PG8_LDB(B1, 1, 1); PG8_STAGE(PG8_SB(1, 0), b3, voffB);
            PG8_BAR; PG8_WAIT_L(0); PG8_MMA(0, 1, At, B1); PG8_BAR;
            PG8_LDA(At, 1, 1); PG8_STAGE(PG8_SA(1, 0), a3, voffA);
            PG8_BAR; PG8_WAIT_L(0); PG8_MMA(1, 0, At, B0); PG8_BAR; PG8_SCHED;
            PG8_STAGE(PG8_SB(1, 1), b3 + hstep, voffB);
            PG8_WAIT_V(6); PG8_BAR; PG8_MMA(1, 1, At, B1); PG8_BAR;
            }
        }
        if constexpr (ALIGN_EPI) { if (wr == 0) PG8_BAR; }
        if constexpr (!Epi::AFTER_DRAIN) { E(acc, cur, wr, wc, fr, fq); S.done(cur); }
        if (!has_next) break;
#pragma unroll
        for (int a = 0; a < 2; ++a)
#pragma unroll
            for (int b = 0; b < 2; ++b)
#pragma unroll
                for (int m = 0; m < 4; ++m)
#pragma unroll
                    for (int n = 0; n < 2; ++n) acc[a][b][m][n] = (f32x4){0.f, 0.f, 0.f, 0.f};
        cur = nxt; cA = nA; cB = nB; ++ui;
        if constexpr (ALIGN_EPI) { if (wr == 1) PG8_BAR; }
    }
    PG8_WAIT_V(0);
    if constexpr (!ALIGN_EPI) { if (wr == 0) PG8_BAR; }
    PG8_BAR;
    if constexpr (Epi::AFTER_DRAIN) { E.fused(acc, cur, wr, wc, fr, fq, lds, wid, lane); S.done(cur); }
#undef PG8_SA
#undef PG8_SB
#undef PG8_STAGE
#undef PG8_LDA
#undef PG8_LDB
#undef PG8_MMA
#undef PG8_WAIT_V
#undef PG8_WAIT_L
#undef PG8_BAR
#undef PG8_SCHED
}
}


__device__ __forceinline__ void transpose_item(const float* W, int K, int N, bf16* WT, int dst_row0, LAS float* scr, int k0, int n0, int lane) {
#pragma unroll 8
    for (int i = 0; i < 32; ++i) { const int kk = 2 * i + (lane >> 5); scr[kk * 33 + (lane & 31)] = W[(size_t)(k0 + kk) * N + n0 + (lane & 31)]; }
    asm volatile("s_waitcnt lgkmcnt(0)" ::: "memory");
    const int cc = lane & 7;
#pragma unroll
    for (int j = 0; j < 4; ++j) { const int n = (lane >> 3) + 8 * j; const LAS float* s = scr + (8 * cc) * 33 + n;
        u32x4 o; o.x = pk2(s[0 * 33], s[1 * 33]); o.y = pk2(s[2 * 33], s[3 * 33]); o.z = pk2(s[4 * 33], s[5 * 33]); o.w = pk2(s[6 * 33], s[7 * 33]);
        *(u32x4*)(WT + (size_t)(dst_row0 + n) * K + k0 + 8 * cc) = o; }
    asm volatile("s_waitcnt lgkmcnt(0)" ::: "memory");
}
__device__ __forceinline__ void weights_prologue(const Ctx& c, const Args& a, unsigned char* ws) {
    LAS float* scr = (LAS float*)(c.lds + c.wave * 16384);
    bf16* WIN = (bf16*)(ws + WS_WIN); bf16* WO = (bf16*)(ws + WS_WO); bf16* WGU = (bf16*)(ws + WS_WGU); bf16* WD = (bf16*)(ws + WS_WD);
    constexpr int I_IN = NL * 16 * 64, I_O = NL * 16 * 32, I_G = NL * NE * 16 * 16, I_D = NL * NE * 8 * 32;
    constexpr int NITEMS = I_IN + I_O + 2 * I_G + I_D;
    for (int it = c.gw; it < NITEMS; it += c.ngw) {
        int r = it;
        if (r < I_IN) { const int l = r >> 10, kb = (r >> 6) & 15, nb = r & 63; transpose_item(a.in[1] + (size_t)l * DM * DIN, DM, DIN, WIN, l * DIN + nb * 32, scr, kb * 64, nb * 32, c.lane); continue; } r -= I_IN;
        if (r < I_O) { const int l = r >> 9, kb = (r >> 5) & 15, nb = r & 31; transpose_item(a.in[15] + (size_t)l * DM * DM, DM, DM, WO, l * DM + nb * 32, scr, kb * 64, nb * 32, c.lane); continue; } r -= I_O;
        if (r < 2 * I_G) { const int up = r >= I_G; if (up) r -= I_G; const int le = r >> 8, kb = (r >> 4) & 15, nb = r & 15, n0 = nb * 32;
            transpose_item(a.in[up ? 21 : 20] + (size_t)le * DM * DE, DM, DE, WGU, le * 1024 + (n0 >> 7) * 256 + (n0 & 127) + up * 128, scr, kb * 64, n0, c.lane); continue; } r -= 2 * I_G;
        { const int le = r >> 8, kb = (r >> 5) & 7, nb = r & 31; transpose_item(a.in[22] + (size_t)le * DE * DM, DE, DM, WD, le * 1024 + nb * 32, scr, kb * 64, nb * 32, c.lane); }
    }
}

constexpr int PH_PER_LAYER = 8, N_PHASES = 1 + NL * PH_PER_LAYER;
struct Ptrs { bf16 *Z, *XB, *YN, *XG, *YS, *H, *GMW, *PWT, *POOLT; float *U, *RTG; unsigned* RTE; int* RTP; };
__device__ __forceinline__ Ptrs make_ptrs(unsigned char* ws) {
    Ptrs p;
    p.Z = (bf16*)(ws + WS_Z); p.XB = (bf16*)(ws + WS_XB); p.YN = (bf16*)(ws + WS_YN); p.U = (float*)(ws + WS_U); p.XG = (bf16*)(ws + WS_A); p.YS = (bf16*)(ws + WS_A); p.H = (bf16*)(ws + WS_H);
    p.GMW = (bf16*)(ws + WS_GMW); p.PWT = (bf16*)(ws + WS_PWT); p.POOLT = (bf16*)(ws + WS_POOLT);
    p.RTE = (unsigned*)(ws + WS_RT); p.RTG = (float*)(ws + WS_RT + 256 * 1024); p.RTP = (int*)(ws + WS_RT + 512 * 1024);
    return p;
}
template <int L>
__device__ __forceinline__ void run_layer(const Args& args, const Ctx& c, const XcdBarrier& bar, const bool one, const int lo, const int hi) {
    constexpr int PB = 1 + L * PH_PER_LAYER;
    unsigned char* ws = args.ws;
    const Ptrs P = make_ptrs(ws);
    const float* X = (L == 0) ? args.in[0] : args.out;
    unsigned* CNT = (unsigned*)ws + CW_CNT + 64 * L;
#define IN(k) (lo <= PB + (k) && PB + (k) < hi)
#define SEAM(k) do { if (one && PB + (k) + 1 < hi) xcd_barrier(bar); } while (0)
    if (IN(0)) { pg8::Gemm g{P.XB, (const bf16*)(ws + WS_WIN) + (size_t)L * DIN * DM, M, DIN, DM}; pg8::StaticOrder S; S.init(M, DIN, (int)gridDim.x, (int)blockIdx.x);
        pg8::EpiBf16<0> E{P.Z, DIN, nullptr, 0, 0, 1.f, 0xffff};
        pg8::gemm_phase<pg8::EpiBf16<0>, pg8::StaticOrder, true, true>(c.lds, g, S, E, c.tid); SEAM(0); }
    if (IN(1)) { const Lw w = layer_weights(args, L); mixer_phase(c, w, L, P.Z, P.GMW, P.PWT, P.POOLT, P.YN); SEAM(1); }
    if (IN(2)) { pg8::Gemm g{P.YN, (const bf16*)(ws + WS_WO) + (size_t)L * DM * DM, M, DM, DM}; pg8::StaticOrder S; S.init(M, DM, (int)gridDim.x, (int)blockIdx.x);
        pg8::EpiResF32 E{X, P.U, ALPHA};
        pg8::gemm_phase<pg8::EpiResF32, pg8::StaticOrder, true, true>(c.lds, g, S, E, c.tid); SEAM(2); }
    if (IN(3)) { const Lw w = layer_weights(args, L); nv_ln1_router(c, w, P.U, args.out, P.RTE, P.RTG); moe_ranks(c, P.RTE, P.RTP, CNT); SEAM(3); }
    if (IN(4)) { moe_gather(c, args.out, P.RTE, P.RTP, CNT, P.XG); SEAM(4); }
    if (IN(5)) { moe_tiles(c, CNT); pg8::MoeOrder S{(const LAS int*)(c.lds + LDS_TAB_OFF), (int)gridDim.x, (int)blockIdx.x};
        pg8::Gemm g{P.XG, (const bf16*)(ws + WS_WGU) + (size_t)L * NE * 1024 * DM, 0, 0, DM};
        pg8::EpiSwiGLU E{P.H};
        pg8::gemm_phase<pg8::EpiSwiGLU, pg8::MoeOrder, true, true>(c.lds, g, S, E, c.tid); SEAM(5); }
    if (IN(6)) { moe_tiles(c, CNT); pg8::MoeOrder S{(const LAS int*)(c.lds + LDS_TAB_OFF), (int)gridDim.x, (int)blockIdx.x};
        pg8::Gemm g{P.H, (const bf16*)(ws + WS_WD) + (size_t)L * NE * 1024 * DE, 0, 0, DE};
        pg8::EpiBf16<0> E{P.YS, DM, nullptr, 0, 0, 1.f, 3};
        pg8::gemm_phase<pg8::EpiBf16<0>, pg8::MoeOrder, true, true>(c.lds, g, S, E, c.tid); SEAM(6); }
    if (IN(7)) { const Lw w = layer_weights(args, L); moe_combine_ln2(c, w, args.out, P.YS, P.RTG, P.RTP, args.out, P.XB); SEAM(7); }
#undef IN
#undef SEAM
}
__global__ void __launch_bounds__(NT, 2) fwd_kernel(Args args) {
    extern __shared__ __attribute__((aligned(16))) unsigned char lds_raw[];
    Ctx c;
    c.lds = (LAS unsigned char*)lds_raw;
    c.tid = threadIdx.x; c.lane = c.tid & 63; c.wave = __builtin_amdgcn_readfirstlane(c.tid >> 6);
    c.gtid = blockIdx.x * NT + c.tid; c.gsize = gridDim.x * NT; c.gw = blockIdx.x * NWAVES + c.wave; c.ngw = gridDim.x * NWAVES;
    volatile LAS unsigned* MISC = (volatile LAS unsigned*)(c.lds + LDS_BYTES - 64);
    if (c.tid < 16) MISC[c.tid] = 0u;
    __syncthreads();
    XcdBarrier bar; bar.bar = (unsigned*)args.ws + CW_BAR; bar.x = 0; bar.st = nullptr;
    const int lo = args.ph_lo, hi = args.ph_hi;
    const bool one = (hi - lo) > 1;
    if (one) bar = xcd_barrier_post((unsigned*)args.ws + CW_BAR, MISC + 8);
    if (lo <= 0 && 0 < hi) {
        const Ptrs P = make_ptrs(args.ws);
        nv_prologue(c, args.in[0], P.XB); small_weights(c, args, P.GMW, P.PWT, P.POOLT); weights_prologue(c, args, args.ws);
        if (one && 1 < hi) xcd_barrier(bar);
    }
    run_layer<0>(args, c, bar, one, lo, hi);
    run_layer<1>(args, c, bar, one, lo, hi);
}

extern "C" void kernel_launch(void* const* d_in, const int* in_sizes, int n_in, void* d_out, int out_size, void* d_ws, size_t ws_size, hipStream_t stream) {
    static int grid = 0;
    if (grid == 0) {
        if (n_in != 25 || in_sizes[0] != M * DM || out_size != M * DM || ws_size < WS_END) { fprintf(stderr, "kernel_launch: unexpected shapes/ws (n_in %d ws %zu)\n", n_in, ws_size); grid = -1; return; }
        int dev = 0, cus = 0;
        if (hipGetDevice(&dev) != hipSuccess || hipDeviceGetAttribute(&cus, hipDeviceAttributeMultiprocessorCount, dev) != hipSuccess) { grid = -1; return; }
        if (hipFuncSetAttribute((const void*)fwd_kernel, hipFuncAttributeMaxDynamicSharedMemorySize, LDS_BYTES) != hipSuccess) { grid = -1; return; }
        (void)hipGetLastError();
        grid = cus;
    }
    if (grid < 0) return;
    (void)hipMemsetAsync((char*)d_ws + WS_CTL, 0, CTL_ZERO_BYTES, stream);
    Args a{};
    for (int i = 0; i < 25; ++i) a.in[i] = (const float*)d_in[i];
    a.out = (float*)d_out; a.ws = (unsigned char*)d_ws;
#if MK_ONE_LAUNCH
    a.ph_lo = 0; a.ph_hi = N_PHASES;
    hipLaunchKernelGGL(fwd_kernel, dim3(grid), dim3(NT), LDS_BYTES, stream, a);
#else
    for (int ph = 0; ph < N_PHASES; ++ph) { a.ph_lo = ph; a.ph_hi = ph + 1; hipLaunchKernelGGL(fwd_kernel, dim3(grid), dim3(NT), LDS_BYTES, stream, a); }
#endif
}
```

```cpp
#include <hip/hip_runtime.h>
#include <cstdio>
#include <cstdint>

#ifndef RPT_PRO
#define RPT_PRO 1
#endif
#ifndef RPT_MIX
#define RPT_MIX 1
#endif
#ifndef RPT_LN1
#define RPT_LN1 1
#endif
#ifndef MK_ONE_LAUNCH
#define MK_ONE_LAUNCH 1
#endif

constexpr int NB = 4, SEQ = 4096, DM = 1024, M = NB * SEQ, DIN = 2048, NE = 16, DE = 512, NL = 2;
constexpr int DG = 256, CHUNK = 128, CONFK = 31;
constexpr float ALPHA = 1.41421356237309515f;
constexpr float LN_EPS = 1e-5f, RMS_EPS = 1e-6f;
constexpr int NWAVES = 8, NT = NWAVES * 64;
constexpr int LDS_BYTES = 147456;

typedef unsigned short bf16;
typedef float f32x4 __attribute__((ext_vector_type(4)));
typedef unsigned u32x4 __attribute__((ext_vector_type(4)));
typedef unsigned u32x2 __attribute__((ext_vector_type(2)));
#define LAS __attribute__((address_space(3)))
#define GAS __attribute__((address_space(1)))
typedef GAS unsigned gu32;
#define RLX_AGENT __ATOMIC_RELAXED, __HIP_MEMORY_SCOPE_AGENT

constexpr size_t MiB = 1u << 20;
constexpr size_t WS_CTL = 0, CTL_ZERO_BYTES = 1 * MiB;
constexpr size_t WS_WIN = 1 * MiB;
constexpr size_t WS_WO = 9 * MiB;
constexpr size_t WS_WGU = 13 * MiB;
constexpr size_t WS_WD = 77 * MiB;
constexpr size_t WS_SMALL = 109 * MiB;
constexpr size_t WS_GMW = WS_SMALL, WS_PWT = WS_SMALL + 256 * 1024, WS_POOLT = WS_SMALL + 512 * 1024;
constexpr size_t WS_A = 110 * MiB;
constexpr size_t WS_Z = WS_A, WS_U = WS_A, WS_F = WS_A;
constexpr size_t WS_D = 182 * MiB;
constexpr size_t WS_XB = WS_D, WS_YN = WS_D, WS_H = WS_D;
constexpr size_t WS_RT = 218 * MiB;
constexpr size_t WS_END = 219 * MiB;
constexpr int CW_BAR = 4096;

__device__ __forceinline__ float bf2f(bf16 v) { return __uint_as_float(((unsigned)v) << 16); }
__device__ __forceinline__ unsigned f2bf(float f) { unsigned u = __float_as_uint(f); return (u + 0x7fffu + ((u >> 16) & 1u)) >> 16; }
__device__ __forceinline__ unsigned pk2(float lo, float hi) { return f2bf(lo) | (f2bf(hi) << 16); }
__device__ __forceinline__ float sigmoidf_(float x) { return 1.0f / (1.0f + __expf(-x)); }
__device__ __forceinline__ float siluf_(float x) { return x * sigmoidf_(x); }
__device__ __forceinline__ float wave_sum(float v) {
#pragma unroll
    for (int o = 1; o < 64; o <<= 1) v += __shfl_xor(v, o);
    return v;
}

#define XB_TMO      128
#define XB_XCNT(j)  (256  + 64 * (j))
#define XB_XSUB(j)  (1280 + 64 * (j))
#define XB_XGEN(j)  (2304 + 64 * (j))
#define XB_TOP      3328
#define XB_TOPGEN   3392
#define XCD_BAR_WORDS 3456
#define XB_SPIN_CAP (1u << 18)
__device__ __forceinline__ unsigned xb_ld(unsigned* p)              { return __hip_atomic_load(p, __ATOMIC_RELAXED, __HIP_MEMORY_SCOPE_AGENT); }
__device__ __forceinline__ unsigned xb_add(unsigned* p, unsigned v) { return __hip_atomic_fetch_add(p, v, __ATOMIC_RELAXED, __HIP_MEMORY_SCOPE_AGENT); }
__device__ __forceinline__ unsigned xb_xcc_id() { return (unsigned)__builtin_amdgcn_s_getreg((3 << 11) | 20) & 0xFu; }
#define XB_SPIN(cond, bar) do { unsigned _sp = 0; while (cond) { __builtin_amdgcn_s_sleep(1); \
    if ((++_sp & 255u) == 0u) { if (xb_ld(&(bar)[XB_TMO])) break; if (_sp > XB_SPIN_CAP) { atomicAdd(&(bar)[XB_TMO], 1u); break; } } } } while (0)
struct XcdBarrier { unsigned* bar; unsigned x; volatile LAS unsigned* st; };
__device__ __forceinline__ XcdBarrier xcd_barrier_post(unsigned* bar, volatile LAS unsigned* st) {
    XcdBarrier b; b.bar = bar; b.x = xb_xcc_id(); b.st = st;
    if (threadIdx.x == 0) (void)xb_add(&bar[XB_XCNT(b.x)], 1u);
    return b;
}
__device__ __forceinline__ void xcd_barrier_complete(unsigned* bar, unsigned x, unsigned& nloc, unsigned& nx) {
    const unsigned G = gridDim.x * gridDim.y * gridDim.z;
    unsigned sum, cnt, mine, sp = 0u;
    for (;;) {
        sum = 0u; cnt = 0u; mine = 0u;
#pragma unroll
        for (unsigned j = 0; j < 16; ++j) { const unsigned c = xb_ld(&bar[XB_XCNT(j)]); sum += c; cnt += (c > 0u) ? 1u : 0u; mine = (j == x) ? c : mine; }
        if (sum == G) break;
        __builtin_amdgcn_s_sleep(1);
        if ((++sp & 255u) == 0u) { if (xb_ld(&bar[XB_TMO])) break; if (sp > XB_SPIN_CAP) { atomicAdd(&bar[XB_TMO], 1u); break; } }
    }
    nloc = mine > 0u ? mine : 1u; nx = cnt > 0u ? cnt : 1u;
}
__device__ __forceinline__ void xcd_barrier(const XcdBarrier& b) {
    asm volatile("s_waitcnt vmcnt(0)" ::: "memory");
    __syncthreads();
    if (threadIdx.x == 0) {
        unsigned* bar = b.bar;
        __builtin_amdgcn_s_waitcnt(0);
        unsigned nloc = b.st[0], nx = b.st[1];
        if (nloc == 0u) { xcd_barrier_complete(bar, b.x, nloc, nx); b.st[0] = nloc; b.st[1] = nx; }
        const unsigned old = xb_add(&bar[XB_XSUB(b.x)], 1u);
        const unsigned gen = old / nloc;
        if (old + 1u == (gen + 1u) * nloc) {
            __builtin_amdgcn_fence(__ATOMIC_RELEASE, "agent");
            asm volatile("s_waitcnt vmcnt(0)" ::: "memory");
            const unsigned og = xb_add(&bar[XB_TOP], 1u);
            const unsigned tg = og / nx;
            if (og + 1u == (tg + 1u) * nx) xb_add(&bar[XB_TOPGEN], 1u);
            else XB_SPIN(xb_ld(&bar[XB_TOPGEN]) == tg, bar);
            __builtin_amdgcn_fence(__ATOMIC_ACQUIRE, "agent");
            xb_add(&bar[XB_XGEN(b.x)], 1u);
            asm volatile("s_waitcnt vmcnt(0)" ::: "memory");
        } else {
            XB_SPIN(xb_ld(&bar[XB_XGEN(b.x)]) == gen, bar);
            __builtin_amdgcn_fence(__ATOMIC_ACQUIRE, "agent");
            asm volatile("s_waitcnt vmcnt(0)" ::: "memory");
        }
    }
    __syncthreads();
}

struct Args { const float* in[25]; float* out; unsigned char* ws; int ph_lo, ph_hi; };

struct Ctx {
    int tid, lane, wave, gtid, gsize, gw, ngw;
    LAS unsigned char* lds;
};

template <class Epi>
__device__ __forceinline__ void nv_gemm(const Ctx& c, const bf16* A, int lda, const float* W, int ldw, int Mr, int N, int K, const Epi& epi) {
    const int ntn = N / 4; const long total = (long)ntn * (Mr / 4);
    for (long i = c.gtid; i < total; i += c.gsize) {
        const int tn = (int)(i % ntn), tm = (int)(i / ntn);
        float acc[4][4];
#pragma unroll
        for (int r = 0; r < 4; ++r)
#pragma unroll
            for (int q = 0; q < 4; ++q) acc[r][q] = 0.f;
        const bf16* a0 = A + (size_t)(tm * 4) * lda;
        const float* w0 = W + tn * 4;
        for (int k = 0; k < K; k += 8) {
            u32x4 av[4];
#pragma unroll
            for (int r = 0; r < 4; ++r) av[r] = *(const u32x4*)(a0 + (size_t)r * lda + k);
#pragma unroll
            for (int kk = 0; kk < 8; ++kk) {
                const f32x4 w = *(const f32x4*)(w0 + (size_t)(k + kk) * ldw);
#pragma unroll
                for (int r = 0; r < 4; ++r) {
                    const unsigned pr = av[r][kk >> 1];
                    const float a = (kk & 1) ? __uint_as_float(pr & 0xffff0000u) : __uint_as_float(pr << 16);
#pragma unroll
                    for (int q = 0; q < 4; ++q) acc[r][q] += a * w[q];
                }
            }
        }
#pragma unroll
        for (int r = 0; r < 4; ++r) epi(tm * 4 + r, tn * 4, (f32x4){acc[r][0], acc[r][1], acc[r][2], acc[r][3]});
    }
}

__device__ __forceinline__ void ln256(f32x4& v, const float* g, const float* b, int lane) {
    const float mean = wave_sum((v[0] + v[1]) + (v[2] + v[3])) * (1.f / 256.f);
    v = v - mean;
    const float var = wave_sum((v[0] * v[0] + v[1] * v[1]) + (v[2] * v[2] + v[3] * v[3])) * (1.f / 256.f);
    const float rstd = 1.0f / sqrtf(var + LN_EPS);
    const f32x4 gg = *(const f32x4*)(g + lane * 4), bb = *(const f32x4*)(b + lane * 4);
    v = v * rstd * gg + bb;
}
__device__ __forceinline__ f32x4 ld_bf4(const bf16* p) { const u32x2 w = *(const u32x2*)p; return (f32x4){__uint_as_float(w.x << 16), __uint_as_float(w.x & 0xffff0000u), __uint_as_float(w.y << 16), __uint_as_float(w.y & 0xffff0000u)}; }
__device__ __forceinline__ void st_bf4(bf16* p, f32x4 v) { u32x2 w; w.x = pk2(v[0], v[1]); w.y = pk2(v[2], v[3]); *(u32x2*)p = w; }

struct Lw {
    const float *w_in, *gm_ln_g, *gm_ln_b, *gm_w_s, *gm_b_s, *cf_dw_w, *cf_dw_b, *cf_ln_g, *cf_ln_b, *cf_pw, *pool_w, *pool_scale, *sc_w, *mix_norm_g, *w_o, *ln1_g, *ln1_b,
        *router_w, *router_b, *wg, *wu, *wd, *ln2_g, *ln2_b;
};
__device__ __forceinline__ Lw layer_weights(const Args& a, int l) {
    Lw w;
    w.w_in = a.in[1] + (size_t)l * DM * DIN; w.gm_ln_g = a.in[2] + l * DG; w.gm_ln_b = a.in[3] + l * DG; w.gm_w_s = a.in[4] + (size_t)l * 4 * CHUNK * CHUNK; w.gm_b_s = a.in[5] + l * 4 * CHUNK;
    w.cf_dw_w = a.in[6] + l * CONFK * DG; w.cf_dw_b = a.in[7] + l * DG; w.cf_ln_g = a.in[8] + l * DG; w.cf_ln_b = a.in[9] + l * DG; w.cf_pw = a.in[10] + (size_t)l * DG * DG;
    w.pool_w = a.in[11] + l * 4 * 64 * 64; w.pool_scale = a.in[12] + l * DG; w.sc_w = a.in[13] + l * 3 * DG; w.mix_norm_g = a.in[14] + l * DM; w.w_o = a.in[15] + (size_t)l * DM * DM;
    w.ln1_g = a.in[16] + l * DM; w.ln1_b = a.in[17] + l * DM; w.router_w = a.in[18]; w.router_b = a.in[19];
    w.wg = a.in[20] + (size_t)l * NE * DM * DE; w.wu = a.in[21] + (size_t)l * NE * DM * DE; w.wd = a.in[22] + (size_t)l * NE * DE * DM;
    w.ln2_g = a.in[23] + l * DM; w.ln2_b = a.in[24] + l * DM;
    return w;
}

__device__ __forceinline__ void nv_prologue(const Ctx& c, const float* x, bf16* XB) {
    constexpr size_t N4 = (size_t)M * DM / 4;
    for (size_t i0 = (size_t)c.gtid; i0 < N4; i0 += (size_t)c.gsize * 8) {
        f32x4 v[8];
#pragma unroll
        for (int j = 0; j < 8; ++j) { const size_t i = i0 + (size_t)j * c.gsize; if (i < N4) v[j] = *(const f32x4*)(x + i * 4); }
#pragma unroll
        for (int j = 0; j < 8; ++j) { const size_t i = i0 + (size_t)j * c.gsize; if (i < N4) st_bf4(XB + i * 4, v[j]); }
    }
}
typedef short bf16x8 __attribute__((ext_vector_type(8)));
__device__ __forceinline__ bf16x8 as_bf16x8(u32x4 v) { return __builtin_bit_cast(bf16x8, v); }
#define MFMA16(a, b, c) __builtin_amdgcn_mfma_f32_16x16x32_bf16((a), (b), (c), 0, 0, 0)
constexpr int YT_LD = 260;
constexpr int AT_LD = 264;
constexpr int VT_RS = 260;

__device__ __forceinline__ void small_weights(const Ctx& c, const Args& a, bf16* GMW, bf16* PWT, bf16* POOLT) {
    for (int i = c.gtid; i < NL * 4 * CHUNK * CHUNK; i += c.gsize) { const int s = i & 127, t = (i >> 7) & 127; GMW[i] = (bf16)((s <= t) ? f2bf(a.in[4][i]) : 0u); }
    for (int i = c.gtid; i < NL * DG * DG; i += c.gsize) { const int cc = i & 255, n = (i >> 8) & 255, l = i >> 16; PWT[i] = (bf16)f2bf(a.in[10][((size_t)l * DG + cc) * DG + n]); }
    for (int i = c.gtid; i < NL * 4 * 64 * 64; i += c.gsize) { const int d = i & 63, e = (i >> 6) & 63, lg = i >> 12; POOLT[i] = (bf16)f2bf(a.in[11][((size_t)lg * 64 + d) * 64 + e]); }
}

template <bool UMUL>
__device__ __forceinline__ void mix_final(const Ctx& c, const Lw& w, int t0, int grp, bf16* YN, const bf16* Z = nullptr) {
    const LAS float* YT = (const LAS float*)c.lds;
    const f32x4 g = *(const f32x4*)(w.mix_norm_g + grp * DG + c.lane * 4);
    u32x2 uu[16];
    if (UMUL) {
#pragma unroll
        for (int i = 0; i < 16; ++i) uu[i] = *(const u32x2*)(Z + (size_t)(t0 + c.wave * 16 + i) * DIN + c.lane * 4);
    }
#pragma unroll
    for (int i = 0; i < 16; ++i) {
        const int t = c.wave * 16 + i;
        f32x4 v = *(const LAS f32x4*)(YT + t * YT_LD + c.lane * 4);
        if (UMUL) v = v * (f32x4){__uint_as_float(uu[i].x << 16), __uint_as_float(uu[i].x & 0xffff0000u), __uint_as_float(uu[i].y << 16), __uint_as_float(uu[i].y & 0xffff0000u)};
        const float ms = wave_sum((v[0] * v[0] + v[1] * v[1]) + (v[2] * v[2] + v[3] * v[3])) * (1.f / 256.f);
        const float r = 1.0f / sqrtf(ms + RMS_EPS);
        st_bf4(YN + (size_t)(t0 + t) * DM + grp * DG + c.lane * 4, v * r * g);
    }
}

__device__ __forceinline__ void mix_conformer(const Ctx& c, const Lw& w, const bf16* Z, const bf16* PWT, int t0, bf16* YN) {
    LAS unsigned char* lds = c.lds;
    const int pos0 = t0 % SEQ;
    {
        const int c8 = (c.tid & 31) * 8, r0 = c.tid >> 5;
        u32x4 av[10], gv[10];
#pragma unroll
        for (int it = 0; it < 10; ++it) {
            const int r = r0 + 16 * it;
            av[it] = (u32x4){0u, 0u, 0u, 0u}; gv[it] = (u32x4){0u, 0u, 0u, 0u};
            if (r < 158 && pos0 + r - 30 >= 0) { const size_t zr = (size_t)(t0 + r - 30) * DIN; av[it] = *(const u32x4*)(Z + zr + 512 + c8); gv[it] = *(const u32x4*)(Z + zr + 768 + c8); }
        }
#pragma unroll
        for (int it = 0; it < 10; ++it) {
            const int r = r0 + 16 * it;
            if (r < 158) {
                u32x4 o;
#pragma unroll
                for (int j = 0; j < 4; ++j) {
                    const float a0 = __uint_as_float(av[it][j] << 16), a1 = __uint_as_float(av[it][j] & 0xffff0000u), g0 = __uint_as_float(gv[it][j] << 16), g1 = __uint_as_float(gv[it][j] & 0xffff0000u);
                    o[j] = pk2(a0 * sigmoidf_(g0), a1 * sigmoidf_(g1));
                }
                *(LAS u32x4*)(lds + r * 512 + c8 * 2) = o;
            }
        }
    }
    __syncthreads();
    constexpr int CT_OFF = 80896;
    {
        const int ch = c.tid & 255, tg = c.tid >> 8;
        float wk[CONFK];
#pragma unroll
        for (int k = 0; k < CONFK; ++k) wk[k] = w.cf_dw_w[k * DG + ch];
        const float b0 = w.cf_dw_b[ch];
#pragma unroll 1
        for (int sb = 0; sb < 8; ++sb) {
            float acc[8];
#pragma unroll
            for (int j = 0; j < 8; ++j) acc[j] = b0;
            const int rb = tg * 64 + sb * 8;
#pragma unroll
            for (int r = 0; r < 38; ++r) {
                const float h0 = bf2f(*(const LAS bf16*)(lds + (rb + r) * 512 + ch * 2));
#pragma unroll
                for (int j = 0; j < 8; ++j) { const int k = r - j; if (k >= 0 && k < CONFK) acc[j] += wk[k] * h0; }
            }
#pragma unroll
            for (int j = 0; j < 8; ++j) *(LAS bf16*)(lds + CT_OFF + (rb + j) * 512 + ch * 2) = (bf16)f2bf(acc[j]);
        }
    }
    __syncthreads();
    {
        const f32x4 g = *(const f32x4*)(w.cf_ln_g + c.lane * 4), b = *(const f32x4*)(w.cf_ln_b + c.lane * 4);
#pragma unroll 4
        for (int i = 0; i < 16; ++i) {
            const int t = c.wave * 16 + i;
            const u32x2 pv = *(const LAS u32x2*)(lds + CT_OFF + t * 512 + c.lane * 8);
            f32x4 v = (f32x4){__uint_as_float(pv.x << 16), __uint_as_float(pv.x & 0xffff0000u), __uint_as_float(pv.y << 16), __uint_as_float(pv.y & 0xffff0000u)};
            const float mean = wave_sum((v[0] + v[1]) + (v[2] + v[3])) * (1.f / 256.f);
            v = v - mean;
            const float var = wave_sum((v[0] * v[0] + v[1] * v[1]) + (v[2] * v[2] + v[3] * v[3])) * (1.f / 256.f);
            v = v * (1.0f / sqrtf(var + LN_EPS)) * g + b;
            u32x2 o; o.x = pk2(siluf_(v[0]), siluf_(v[1])); o.y = pk2(siluf_(v[2]), siluf_(v[3]));
            *(LAS u32x2*)(lds + t * (AT_LD * 2) + c.lane * 8) = o;
        }
    }
    __syncthreads();
    {
        const int fr = c.lane & 15, fq = c.lane >> 4;
        f32x4 C[8][2];
#pragma unroll
        for (int rt = 0; rt < 8; ++rt) { C[rt][0] = (f32x4){0.f, 0.f, 0.f, 0.f}; C[rt][1] = (f32x4){0.f, 0.f, 0.f, 0.f}; }
        bf16x8 Bf[2][8];
#pragma unroll
        for (int ct = 0; ct < 2; ++ct)
#pragma unroll
            for (int ks = 0; ks < 8; ++ks) Bf[ct][ks] = as_bf16x8(*(const u32x4*)(PWT + (size_t)(c.wave * 32 + ct * 16 + fr) * DG + ks * 32 + fq * 8));
#pragma unroll
        for (int rt = 0; rt < 8; ++rt)
#pragma unroll
            for (int ks = 0; ks < 8; ++ks) {
                const bf16x8 Af = as_bf16x8(*(const LAS u32x4*)(lds + (rt * 16 + fr) * (AT_LD * 2) + (ks * 32 + fq * 8) * 2));
                C[rt][0] = MFMA16(Af, Bf[0][ks], C[rt][0]); C[rt][1] = MFMA16(Af, Bf[1][ks], C[rt][1]);
            }
        __syncthreads();
        LAS float* YT = (LAS float*)lds;
#pragma unroll
        for (int rt = 0; rt < 8; ++rt)
#pragma unroll
            for (int ct = 0; ct < 2; ++ct)
#pragma unroll
                for (int j = 0; j < 4; ++j) YT[(rt * 16 + fq * 4 + j) * YT_LD + c.wave * 32 + ct * 16 + fr] = C[rt][ct][j];
    }
    __syncthreads();
    mix_final<false>(c, w, t0, 1, YN);
}

__device__ __forceinline__ void mix_gmlp(const Ctx& c, const Lw& w, const bf16* Z, const bf16* GMW, int t0, bf16* YN) {
    LAS unsigned char* lds = c.lds;
    {
        float g[4], b[4];
#pragma unroll
        for (int q = 0; q < 4; ++q) { g[q] = w.gm_ln_g[c.lane + 64 * q]; b[q] = w.gm_ln_b[c.lane + 64 * q]; }
        bf16 raw[16][4];
#pragma unroll
        for (int i = 0; i < 16; ++i)
#pragma unroll
            for (int q = 0; q < 4; ++q) raw[i][q] = Z[(size_t)(t0 + c.wave * 16 + i) * DIN + 256 + c.lane + 64 * q];
#pragma unroll
        for (int i = 0; i < 8; ++i) {
            const int s = c.wave * 16 + 2 * i;
            float v[2][4];
#pragma unroll
            for (int p = 0; p < 2; ++p) {
#pragma unroll
                for (int q = 0; q < 4; ++q) v[p][q] = bf2f(raw[2 * i + p][q]);
                const float mean = wave_sum((v[p][0] + v[p][1]) + (v[p][2] + v[p][3])) * (1.f / 256.f);
#pragma unroll
                for (int q = 0; q < 4; ++q) v[p][q] -= mean;
                const float var = wave_sum((v[p][0] * v[p][0] + v[p][1] * v[p][1]) + (v[p][2] * v[p][2] + v[p][3] * v[p][3])) * (1.f / 256.f);
                const float rstd = 1.0f / sqrtf(var + LN_EPS);
#pragma unroll
                for (int q = 0; q < 4; ++q) v[p][q] = v[p][q] * rstd * g[q] + b[q];
            }
#pragma unroll
            for (int q = 0; q < 4; ++q) *(LAS unsigned*)(lds + (c.lane + 64 * q) * VT_RS + s * 2) = pk2(v[0][q], v[1][q]);
        }
    }
    __syncthreads();
    const int fr = c.lane & 15, fq = c.lane >> 4, h = c.wave >> 1, par = c.wave & 1;
    bf16x8 Bf[4][4];
#pragma unroll
    for (int ct = 0; ct < 4; ++ct)
#pragma unroll
        for (int ks = 0; ks < 4; ++ks) {
            u32x4 t;
#pragma unroll
            for (int i = 0; i < 4; ++i) t[i] = *(const LAS unsigned*)(lds + (h * 64 + ct * 16 + fr) * VT_RS + (ks * 32 + fq * 8 + 2 * i) * 2);
            Bf[ct][ks] = as_bf16x8(t);
        }
    __syncthreads();
    LAS float* YT = (LAS float*)lds;
    bf16x8 Af[4][4];
#pragma unroll
    for (int i = 0; i < 4; ++i)
#pragma unroll
        for (int ks = 0; ks <= i; ++ks) Af[i][ks] = as_bf16x8(*(const u32x4*)(GMW + ((size_t)(h * CHUNK + 16 * (par + 2 * i) + fr)) * CHUNK + ks * 32 + fq * 8));
#pragma unroll
    for (int i = 0; i < 4; ++i) {
        const int R = par + 2 * i;
        f32x4 C[4];
#pragma unroll
        for (int ct = 0; ct < 4; ++ct) C[ct] = (f32x4){0.f, 0.f, 0.f, 0.f};
#pragma unroll
        for (int ks = 0; ks <= i; ++ks)
#pragma unroll
            for (int ct = 0; ct < 4; ++ct) C[ct] = MFMA16(Af[i][ks], Bf[ct][ks], C[ct]);
#pragma unroll
        for (int j = 0; j < 4; ++j) {
            const int t = 16 * R + fq * 4 + j; const float bs = w.gm_b_s[h * CHUNK + t];
#pragma unroll
            for (int ct = 0; ct < 4; ++ct) YT[t * YT_LD + h * 64 + ct * 16 + fr] = C[ct][j] + bs;
        }
    }
    __syncthreads();
    mix_final<true>(c, w, t0, 0, YN, Z);
}

__device__ __forceinline__ void mix_pool(const Ctx& c, const Lw& w, const bf16* Z, const bf16* POOLT, int t0, bf16* YN) {
    LAS unsigned char* lds = c.lds;
    const int pos0 = t0 % SEQ;
    constexpr int PA_OFF = 73728;
    {
        const int c8 = (c.tid & 31) * 8, r0 = c.tid >> 5;
        u32x4 zv[9];
#pragma unroll
        for (int it = 0; it < 9; ++it) { const int r = r0 + 16 * it; zv[it] = (u32x4){0u, 0u, 0u, 0u};
            if (r < 143 && pos0 + r - 15 >= 0) zv[it] = *(const u32x4*)(Z + (size_t)(t0 + r - 15) * DIN + 1024 + c8); }
#pragma unroll
        for (int it = 0; it < 9; ++it) { const int r = r0 + 16 * it; if (r < 143) *(LAS u32x4*)(lds + r * 512 + c8 * 2) = zv[it]; }
    }
    __syncthreads();
    {
        const int cp = c.tid & 127, tg = c.tid >> 7, W = 2 << (cp >> 5);
        float s0 = 0.f, s1 = 0.f;
        for (int i = 1; i < W; ++i) { const unsigned zv = *(const LAS unsigned*)(lds + (tg * 32 + 15 - i) * 512 + cp * 4); s0 += __uint_as_float(zv << 16); s1 += __uint_as_float(zv & 0xffff0000u); }
        for (int j = 0; j < 32; ++j) {
            const int tl = tg * 32 + j, pos = pos0 + tl;
            const unsigned zv = *(const LAS unsigned*)(lds + (tl + 15) * 512 + cp * 4);
            const float z0 = __uint_as_float(zv << 16), z1 = __uint_as_float(zv & 0xffff0000u);
            s0 += z0; s1 += z1;
            const float inv = 1.0f / (float)((pos + 1 < W) ? pos + 1 : W);
            *(LAS unsigned*)(lds + PA_OFF + tl * (AT_LD * 2) + cp * 4) = pk2(s0 * inv - z0, s1 * inv - z1);
            const unsigned zo = *(const LAS unsigned*)(lds + (tl + 15 - (W - 1)) * 512 + cp * 4);
            s0 -= __uint_as_float(zo << 16); s1 -= __uint_as_float(zo & 0xffff0000u);
        }
    }
    __syncthreads();
    {
        const int fr = c.lane & 15, fq = c.lane >> 4, g = c.wave >> 1, cb = (c.wave & 1) * 2;
        f32x4 C[8][2];
#pragma unroll
        for (int rt = 0; rt < 8; ++rt) { C[rt][0] = (f32x4){0.f, 0.f, 0.f, 0.f}; C[rt][1] = (f32x4){0.f, 0.f, 0.f, 0.f}; }
        bf16x8 Bf[2][2];
#pragma unroll
        for (int ct = 0; ct < 2; ++ct)
#pragma unroll
            for (int ks = 0; ks < 2; ++ks) Bf[ct][ks] = as_bf16x8(*(const u32x4*)(POOLT + (size_t)(g * 64 + (cb + ct) * 16 + fr) * 64 + ks * 32 + fq * 8));
#pragma unroll
        for (int rt = 0; rt < 8; ++rt)
#pragma unroll
            for (int ks = 0; ks < 2; ++ks) {
                const bf16x8 Af = as_bf16x8(*(const LAS u32x4*)(lds + PA_OFF + (rt * 16 + fr) * (AT_LD * 2) + (g * 64 + ks * 32 + fq * 8) * 2));
                C[rt][0] = MFMA16(Af, Bf[0][ks], C[rt][0]); C[rt][1] = MFMA16(Af, Bf[1][ks], C[rt][1]);
            }
        __syncthreads();
        LAS float* YT = (LAS float*)lds;
#pragma unroll
        for (int ct = 0; ct < 2; ++ct) {
            const int ch = g * 64 + (cb + ct) * 16 + fr; const float sc = w.pool_scale[ch];
#pragma unroll
            for (int rt = 0; rt < 8; ++rt)
#pragma unroll
                for (int j = 0; j < 4; ++j) YT[(rt * 16 + fq * 4 + j) * YT_LD + ch] = C[rt][ct][j] * sc;
        }
    }
    __syncthreads();
    mix_final<false>(c, w, t0, 2, YN);
}

__device__ __forceinline__ void mix_sconv(const Ctx& c, const Lw& w, const bf16* Z, int t0, bf16* YN) {
    LAS float* YT = (LAS float*)c.lds;
    const int pos0 = t0 % SEQ;
#pragma unroll 1
    for (int task = c.tid; task < 1024; task += NT) {
        const int c8 = (task & 31) * 8, R0 = (task >> 5) * 4;
        u32x4 cv[6], hv[6], bv[4];
#pragma unroll
        for (int i = 0; i < 6; ++i) { cv[i] = (u32x4){0u, 0u, 0u, 0u}; hv[i] = (u32x4){0u, 0u, 0u, 0u};
            if (pos0 + R0 - 2 + i >= 0) { const size_t zr = (size_t)(t0 + R0 - 2 + i) * DIN; cv[i] = *(const u32x4*)(Z + zr + 1536 + c8); hv[i] = *(const u32x4*)(Z + zr + 1792 + c8); } }
#pragma unroll
        for (int j = 0; j < 4; ++j) bv[j] = *(const u32x4*)(Z + (size_t)(t0 + R0 + j) * DIN + 1280 + c8);
        float wk[3][8];
#pragma unroll
        for (int k = 0; k < 3; ++k) { const f32x4 w0 = *(const f32x4*)(w.sc_w + k * DG + c8), w1 = *(const f32x4*)(w.sc_w + k * DG + c8 + 4);
#pragma unroll
            for (int q = 0; q < 4; ++q) { wk[k][q] = w0[q]; wk[k][4 + q] = w1[q]; } }
        float p[6][8];
#pragma unroll
        for (int i = 0; i < 6; ++i)
#pragma unroll
            for (int q = 0; q < 4; ++q) { p[i][2 * q] = __uint_as_float(cv[i][q] << 16) * __uint_as_float(hv[i][q] << 16); p[i][2 * q + 1] = __uint_as_float(cv[i][q] & 0xffff0000u) * __uint_as_float(hv[i][q] & 0xffff0000u); }
#pragma unroll
        for (int j = 0; j < 4; ++j) {
            float o[8];
#pragma unroll
            for (int q = 0; q < 8; ++q) o[q] = wk[0][q] * p[j][q] + wk[1][q] * p[j + 1][q] + wk[2][q] * p[j + 2][q];
#pragma unroll
            for (int q = 0; q < 4; ++q) { o[2 * q] *= __uint_as_float(bv[j][q] << 16); o[2 * q + 1] *= __uint_as_float(bv[j][q] & 0xffff0000u); }
            *(LAS f32x4*)(YT + (R0 + j) * YT_LD + c8) = (f32x4){o[0], o[1], o[2], o[3]}; *(LAS f32x4*)(YT + (R0 + j) * YT_LD + c8 + 4) = (f32x4){o[4], o[5], o[6], o[7]};
        }
    }
    __syncthreads();
    mix_final<false>(c, w, t0, 3, YN);
}

__device__ __forceinline__ void mixer_phase(const Ctx& c0, const Lw& w, int l, const bf16* Z, const bf16* GMW, const bf16* PWT, const bf16* POOLT, bf16* YN) {
    for (int it = blockIdx.x; it < 512; it += gridDim.x) {
        Ctx c = c0; asm volatile("" : "+v"(c.tid)); c.lane = c.tid & 63;
        const int mx = it >> 7, t0 = (it & 127) * CHUNK;
        if (mx == 0) mix_conformer(c, w, Z, PWT + (size_t)l * DG * DG, t0, YN);
        else if (mx == 1) mix_gmlp(c, w, Z, GMW + (size_t)l * 4 * CHUNK * CHUNK, t0, YN);
        else if (mx == 2) mix_pool(c, w, Z, POOLT + (size_t)l * 4 * 64 * 64, t0, YN);
        else mix_sconv(c, w, Z, t0, YN);
        __syncthreads();
    }
}

struct EpiZ { bf16* Z; __device__ __forceinline__ void operator()(int r, int cc, f32x4 v) const { st_bf4(Z + (size_t)r * DIN + cc, v); } };
struct EpiU { float* U; const float* X; __device__ __forceinline__ void operator()(int r, int cc, f32x4 v) const { *(f32x4*)(U + (size_t)r * DM + cc) = v + ALPHA * *(const f32x4*)(X + (size_t)r * DM + cc); } };

__device__ __forceinline__ void ln1024(f32x4 (&v)[4], const float* g, const float* b, int lane) {
    float s = 0.f;
#pragma unroll
    for (int j = 0; j < 4; ++j) s += (v[j][0] + v[j][1]) + (v[j][2] + v[j][3]);
    const float mean = wave_sum(s) * (1.f / DM);
    float q = 0.f;
#pragma unroll
    for (int j = 0; j < 4; ++j) { v[j] = v[j] - mean; q += (v[j][0] * v[j][0] + v[j][1] * v[j][1]) + (v[j][2] * v[j][2] + v[j][3] * v[j][3]); }
    const float rstd = 1.0f / sqrtf(wave_sum(q) * (1.f / DM) + LN_EPS);
#pragma unroll
    for (int j = 0; j < 4; ++j) v[j] = v[j] * rstd * *(const f32x4*)(g + lane * 4 + 256 * j) + *(const f32x4*)(b + lane * 4 + 256 * j);
}
__device__ __forceinline__ void nv_ln1_router(const Ctx& c, const Lw& w, const float* U, float* X1, unsigned* RTE, float* RTG) {
    LAS float* RWt = (LAS float*)c.lds;
    __syncthreads();
#pragma unroll
    for (int h = 0; h < 2; ++h) { const int ch = c.tid + 512 * h;
#pragma unroll
        for (int e4 = 0; e4 < 4; ++e4) { const f32x4 ww = *(const f32x4*)(w.router_w + (size_t)ch * NE + e4 * 4);
#pragma unroll
            for (int q = 0; q < 4; ++q) RWt[(e4 * 4 + q) * DM + ch] = ww[q]; } }
    __syncthreads();
    for (int t = c.gw; t < M; t += c.ngw) {
        f32x4 v[4];
#pragma unroll
        for (int j = 0; j < 4; ++j) v[j] = *(const f32x4*)(U + (size_t)t * DM + c.lane * 4 + 256 * j);
        ln1024(v, w.ln1_g, w.ln1_b, c.lane);
#pragma unroll
        for (int j = 0; j < 4; ++j) *(f32x4*)(X1 + (size_t)t * DM + c.lane * 4 + 256 * j) = v[j];
        float lg[16];
        int lo = c.lane * 4; asm volatile("" : "+v"(lo));
#pragma unroll
        for (int e = 0; e < 16; ++e) {
            float a = 0.f;
#pragma unroll
            for (int j = 0; j < 4; ++j) { const f32x4 ww = *(const LAS f32x4*)(RWt + e * DM + lo + 256 * j); a += (v[j][0] * ww[0] + v[j][1] * ww[1]) + (v[j][2] * ww[2] + v[j][3] * ww[3]); }
            lg[e] = a;
        }
#pragma unroll
        for (int e = 0; e < 16; ++e) lg[e] = wave_sum(lg[e]);
        float best_score = 0.f; int best = -1;
#pragma unroll
        for (int g = 0; g < 4; ++g) {
            float m1 = -INFINITY, m2 = -INFINITY;
#pragma unroll
            for (int j = 0; j < 4; ++j) { const float s = lg[g * 4 + j] + w.router_b[g * 4 + j]; if (s > m1) { m2 = m1; m1 = s; } else if (s > m2) m2 = s; }
            const float sc = m1 + m2;
            if (best < 0 || sc > best_score) { best_score = sc; best = g; }
        }
        float s1 = -INFINITY, s2 = -INFINITY, l1 = 0.f, l2 = 0.f; int i1 = 0, i2 = 0;
#pragma unroll
        for (int e = 0; e < 16; ++e) {
            if ((e >> 2) == best) { const float s = lg[e] + w.router_b[e];
                if (s > s1) { s2 = s1; i2 = i1; l2 = l1; s1 = s; i1 = e; l1 = lg[e]; } else if (s > s2) { s2 = s; i2 = e; l2 = lg[e]; } }
        }
        const float mx = fmaxf(l1, l2), e1 = __expf(l1 - mx), e2 = __expf(l2 - mx), inv = 1.0f / (e1 + e2);
        if (c.lane == 0) { RTE[t] = (unsigned)i1 | ((unsigned)i2 << 8); RTG[2 * t] = e1 * inv; RTG[2 * t + 1] = e2 * inv; }
    }
}
constexpr int CW_CNT = 8192;
__device__ __forceinline__ void moe_ranks(const Ctx& c, const unsigned* RTE, int* RTP, unsigned* CNT) {
    LAS int* LC = (LAS int*)c.lds;
    __syncthreads();
    if (c.tid < 32) LC[c.tid] = 0;
    __syncthreads();
    for (int t = c.gw; t < M; t += c.ngw) {
        if (c.lane == 0) { const unsigned ee = RTE[t]; RTP[2 * t] = __hip_atomic_fetch_add(&LC[ee & 0xff], 1, __ATOMIC_RELAXED, __HIP_MEMORY_SCOPE_WORKGROUP); RTP[2 * t + 1] = __hip_atomic_fetch_add(&LC[(ee >> 8) & 0xff], 1, __ATOMIC_RELAXED, __HIP_MEMORY_SCOPE_WORKGROUP); }
    }
    __syncthreads();
    if (c.tid < 16) LC[16 + c.tid] = (int)atomicAdd(&CNT[c.tid], (unsigned)LC[c.tid]);
    __syncthreads();
    for (int t = c.gw; t < M; t += c.ngw) {
        if (c.lane == 0) { const unsigned ee = RTE[t]; RTP[2 * t] += LC[16 + (ee & 0xff)]; RTP[2 * t + 1] += LC[16 + ((ee >> 8) & 0xff)]; }
    }
}
constexpr int LDS_TAB_OFF = 131072;
__device__ __forceinline__ void moe_tiles(const Ctx& c, const unsigned* CNT) {
    LAS int* ts = (LAS int*)(c.lds + LDS_TAB_OFF);
    __syncthreads();
    if (c.tid < 17) { int s = 0; for (int e = 0; e < c.tid; ++e) s += (int)((CNT[e] + 255u) >> 8); ts[c.tid] = s; }
    __syncthreads();
}
__device__ __forceinline__ void moe_gather(const Ctx& c, const float* X1, const unsigned* RTE, int* RTP, const unsigned* CNT, bf16* XG) {
    LAS int* RS = (LAS int*)c.lds;
    __syncthreads();
    if (c.tid < 16) { int s = 0; for (int e = 0; e < c.tid; ++e) s += (int)((CNT[e] + 255u) >> 8); RS[c.tid] = s * 256; }
    __syncthreads();
    for (int p = c.gw; p < 2 * M; p += c.ngw) {
        const int t = p >> 1, k = p & 1;
        const int e = (RTE[t] >> (8 * k)) & 0xff;
        const int slot = RS[e] + RTP[p];
        f32x4 v[4];
#pragma unroll
        for (int j = 0; j < 4; ++j) v[j] = *(const f32x4*)(X1 + (size_t)t * DM + c.lane * 4 + 256 * j);
#pragma unroll
        for (int j = 0; j < 4; ++j) st_bf4(XG + (size_t)slot * DM + c.lane * 4 + 256 * j, v[j]);
        asm volatile("" ::: "memory");
        if (c.lane == 0) RTP[p] = slot;
    }
}
__device__ __forceinline__ void moe_combine_ln2(const Ctx& c, const Lw& w, const float* X1, const bf16* YS, const float* RTG, const int* RTP, float* X2, bf16* XB) {
    for (int t = c.gw; t < M; t += c.ngw) {
        const int s0 = RTP[2 * t], s1 = RTP[2 * t + 1]; const float g0 = RTG[2 * t], g1 = RTG[2 * t + 1];
        f32x4 v[4];
#pragma unroll
        for (int j = 0; j < 4; ++j) {
            const int col = c.lane * 4 + 256 * j;
            v[j] = ALPHA * *(const f32x4*)(X1 + (size_t)t * DM + col) + g0 * ld_bf4(YS + (size_t)s0 * DM + col) + g1 * ld_bf4(YS + (size_t)s1 * DM + col);
        }
        ln1024(v, w.ln2_g, w.ln2_b, c.lane);
#pragma unroll
        for (int j = 0; j < 4; ++j) { *(f32x4*)(X2 + (size_t)t * DM + c.lane * 4 + 256 * j) = v[j]; st_bf4(XB + (size_t)t * DM + c.lane * 4 + 256 * j, v[j]); }
    }
}

__device__ __forceinline__ void nv_moe(const Ctx& c, const Lw& w, const float* X1, const unsigned* RTE, const float* RTG, float* F) {
    LAS float* xs = (LAS float*)c.lds; LAS float* hs = xs + DM;
    for (int t = blockIdx.x; t < M; t += gridDim.x) {
        __syncthreads();
        xs[c.tid] = X1[(size_t)t * DM + c.tid]; xs[c.tid + 512] = X1[(size_t)t * DM + c.tid + 512];
        __syncthreads();
        const unsigned ee = RTE[t]; float f0 = 0.f, f1 = 0.f;
        for (int k = 0; k < 2; ++k) {
            const int e = (ee >> (8 * k)) & 0xff; const float gk = RTG[2 * t + k];
            const float* wg = w.wg + (size_t)e * DM * DE + c.tid; const float* wu = w.wu + (size_t)e * DM * DE + c.tid;
            float ga = 0.f, ua = 0.f;
            for (int i = 0; i < DM; ++i) { const float xv = xs[i]; ga += xv * wg[(size_t)i * DE]; ua += xv * wu[(size_t)i * DE]; }
            __syncthreads();
            hs[c.tid] = siluf_(ga) * ua;
            __syncthreads();
            const float* wd = w.wd + (size_t)e * DE * DM + c.tid;
            float y0 = 0.f, y1 = 0.f;
            for (int i = 0; i < DE; ++i) { const float hv = hs[i]; y0 += hv * wd[(size_t)i * DM]; y1 += hv * wd[(size_t)i * DM + 512]; }
            f0 += gk * y0; f1 += gk * y1;
        }
        F[(size_t)t * DM + c.tid] = f0; F[(size_t)t * DM + c.tid + 512] = f1;
    }
}
__device__ __forceinline__ void nv_ln2(const Ctx& c, const Lw& w, const float* X1, const float* F, float* X2, bf16* XB) {
    for (int t = c.gw; t < M; t += c.ngw) {
        f32x4 v[4];
#pragma unroll
        for (int j = 0; j < 4; ++j) v[j] = ALPHA * *(const f32x4*)(X1 + (size_t)t * DM + c.lane * 4 + 256 * j) + *(const f32x4*)(F + (size_t)t * DM + c.lane * 4 + 256 * j);
        ln1024(v, w.ln2_g, w.ln2_b, c.lane);
#pragma unroll
        for (int j = 0; j < 4; ++j) { *(f32x4*)(X2 + (size_t)t * DM + c.lane * 4 + 256 * j) = v[j]; st_bf4(XB + (size_t)t * DM + c.lane * 4 + 256 * j, v[j]); }
    }
}

namespace pg8 {
#define PG8_LAS __attribute__((address_space(3)))
typedef unsigned short bf16_t;
typedef short bf16x8 __attribute__((ext_vector_type(8)));
typedef float f32x4 __attribute__((ext_vector_type(4)));
typedef unsigned u32x4 __attribute__((ext_vector_type(4)));
constexpr int BM = 256, BK = 64, HALF = 128, HTB = HALF * BK * 2  , STAGE_BYTES = 8 * HTB, NXCD = 8, WGM = 8;

__host__ __device__ __forceinline__ int lds_byte(int r, int c) { const int st = (r >> 4) * 2 + (c >> 5), rr = r & 15, cc = c & 31, ob = rr * 64 + cc * 2; return st * 1024 + (ob ^ (((ob >> 9) & 1) << 5)); }
__host__ __device__ __forceinline__ void stage_rc(int b, int& R, int& C) { const int st = b / 1024, sb = b % 1024, swz = sb ^ (((sb >> 9) & 1) << 5); R = (st >> 1) * 16 + swz / 64; C = (st & 1) * 32 + (swz % 64) / 2; }
__host__ __device__ __forceinline__ int perm32(int rho) { const int n = rho >> 4, i = rho & 15; return 8 * (i >> 2) + 4 * n + (i & 3); }

struct Unit { int pm, pn; };
struct Gemm { const bf16_t* A; const bf16_t* Bt; int M, N, K; };

struct StaticOrder {
    int nM, nN, nwg, G, c;
    __host__ __device__ void init(int M, int N, int G_, int c_) { nM = M / BM; nN = N / BM; nwg = nM * nN; G = G_; c = c_; }
    __host__ __device__ bool next(int i, Unit& u) const {
        const long L = (long)i * G + c; if (L >= nwg) return false;
        int wgid = (int)L; { const int q = nwg / NXCD, r = nwg % NXCD, xcd = wgid % NXCD, off = wgid / NXCD; wgid = (xcd < r ? xcd * (q + 1) : r * (q + 1) + (xcd - r) * q) + off; }
        const int nig = WGM * nN, gid = wgid / nig, fm = gid * WGM, gsz = (nM - fm) < WGM ? (nM - fm) : WGM;
        u.pm = fm + ((wgid % nig) % gsz); u.pn = (wgid % nig) / gsz; return true;
    }
    __device__ __forceinline__ void a_ready(const Unit&) const {}
    __device__ __forceinline__ void done(const Unit&) const {}
};

__device__ __forceinline__ unsigned cvt_pk_bf16(float lo, float hi) { unsigned r; asm volatile("v_cvt_pk_bf16_f32 %0, %1, %2" : "=v"(r) : "v"(lo), "v"(hi)); return r; }
typedef float f32x2 __attribute__((ext_vector_type(2)));
__device__ __forceinline__ f32x2 gelu_pk(f32x2 v) {
    const f32x2 av = __builtin_elementwise_abs(v), d = av * 0.2316418882f + 1.0f;
    f32x2 t; t.x = __builtin_amdgcn_rcpf(d.x); t.y = __builtin_amdgcn_rcpf(d.y);
    f32x2 q = t * 0.5307027145f + (-0.7265760135f); q = q * t + 0.7107068705f; q = q * t + (-0.142248368f); q = q * t + 0.127414796f; q = q * t;
    const f32x2 s = (v * v) * (-0.72134752044f);
    f32x2 e; e.x = __builtin_amdgcn_exp2f(s.x); e.y = __builtin_amdgcn_exp2f(s.y);
    const f32x2 m = v * (q * e), r = v - m;
    f32x2 o; o.x = v.x < 0.f ? m.x : r.x; o.y = v.y < 0.f ? m.y : r.y; return o;
}

template <int ACT  > struct EpiBf16 {
    static constexpr bool PERM = true, AFTER_DRAIN = false; static_assert(ACT == 0 || ACT == 1, "EpiBf16: ACT is 0 (none) or 1 (gelu_pk)");
    bf16_t* O; int ldc; const float* bias; int split_cols; size_t split_stride; float scale0; int pn_mask;
    __device__ __forceinline__ void operator()(const f32x4 (&acc)[2][2][4][2], const Unit& u, int wr, int wc, int fr, int fq) const {
        const int row0 = u.pm * BM + wr * 64 + fr; int colt = (u.pn & pn_mask) * BM; bf16_t* base = O;
        float sc = 1.f; if (split_cols) { const int t = colt / split_cols; base += (size_t)t * split_stride; colt -= t * split_cols; if (t == 0) sc = scale0; }
        const int col0 = colt + wc * 32 + 8 * fq, bcol0 = (u.pn & pn_mask) * BM + wc * 32 + 8 * fq;
        f32x4 bv[2][2];
#pragma unroll
        for (int bj = 0; bj < 2; ++bj)
#pragma unroll
            for (int n = 0; n < 2; ++n) bv[bj][n] = bias ? *(const f32x4*)(bias + bcol0 + bj * HALF + 4 * n) : (f32x4){0.f, 0.f, 0.f, 0.f};
#pragma unroll
        for (int ai = 0; ai < 2; ++ai)
#pragma unroll
            for (int m = 0; m < 4; ++m) { bf16_t* rowp = base + (size_t)(row0 + ai * HALF + m * 16) * ldc + col0;
#pragma unroll
                for (int bj = 0; bj < 2; ++bj) { f32x4 v0 = acc[ai][bj][m][0] + bv[bj][0], v1 = acc[ai][bj][m][1] + bv[bj][1];
                    if (ACT == 1) { f32x2 a = gelu_pk((f32x2){v0[0], v0[1]}), b = gelu_pk((f32x2){v0[2], v0[3]}), c = gelu_pk((f32x2){v1[0], v1[1]}), d = gelu_pk((f32x2){v1[2], v1[3]});
                        v0 = (f32x4){a.x, a.y, b.x, b.y}; v1 = (f32x4){c.x, c.y, d.x, d.y}; }
                    v0 = v0 * sc; v1 = v1 * sc; u32x4 w; w.x = cvt_pk_bf16(v0[0], v0[1]); w.y = cvt_pk_bf16(v0[2], v0[3]); w.z = cvt_pk_bf16(v1[0], v1[1]); w.w = cvt_pk_bf16(v1[2], v1[3]);
                    *(u32x4*)(rowp + bj * HALF) = w; } }
    }
};


struct EpiResF32 {
    static constexpr bool PERM = false, AFTER_DRAIN = false;
    const float* X; float* U; float alpha;
    __device__ __forceinline__ void operator()(const f32x4 (&acc)[2][2][4][2], const Unit& u, int wr, int wc, int fr, int fq) const {
        const int col0 = u.pn * BM + wc * 32 + 4 * fq;
#pragma unroll
        for (int ai = 0; ai < 2; ++ai)
#pragma unroll
            for (int m = 0; m < 4; ++m) { const size_t off = (size_t)(u.pm * BM + ai * HALF + wr * 64 + m * 16 + fr) * 1024 + col0;
#pragma unroll
                for (int bj = 0; bj < 2; ++bj)
#pragma unroll
                    for (int n = 0; n < 2; ++n) *(f32x4*)(U + off + bj * HALF + n * 16) = acc[ai][bj][m][n] + alpha * *(const f32x4*)(X + off + bj * HALF + n * 16); }
    }
};

struct MoeOrder {
    const PG8_LAS int* ts; int G, c;
    __device__ __forceinline__ bool next(int i, Unit& u) const {
        const int L = i * G + c; if (L >= __builtin_amdgcn_readfirstlane(ts[16]) * 4) return false;
        const int rt = L >> 2; int e = 0;
#pragma unroll
        for (int k = 1; k < 16; ++k) e += (rt >= ts[k]) ? 1 : 0;
        u.pm = rt; u.pn = __builtin_amdgcn_readfirstlane(e) * 4 + (L & 3); return true;
    }
    __device__ __forceinline__ void a_ready(const Unit&) const {}
    __device__ __forceinline__ void done(const Unit&) const {}
};
struct EpiSwiGLU {
    static constexpr bool PERM = true, AFTER_DRAIN = false;
    bf16_t* H;
    __device__ __forceinline__ void operator()(const f32x4 (&acc)[2][2][4][2], const Unit& u, int wr, int wc, int fr, int fq) const {
        const int row0 = u.pm * BM + wr * 64 + fr, col0 = (u.pn & 3) * HALF + wc * 32 + 8 * fq;
#pragma unroll
        for (int ai = 0; ai < 2; ++ai)
#pragma unroll
            for (int m = 0; m < 4; ++m) {
                u32x4 w4;
#pragma unroll
                for (int n = 0; n < 2; ++n) {
                    const f32x4 g = acc[ai][0][m][n], up = acc[ai][1][m][n]; f32x4 h;
#pragma unroll
                    for (int q = 0; q < 4; ++q) h[q] = g[q] * __builtin_amdgcn_rcpf(1.0f + __expf(-g[q])) * up[q];
                    w4[2 * n] = cvt_pk_bf16(h[0], h[1]); w4[2 * n + 1] = cvt_pk_bf16(h[2], h[3]);
                }
                *(u32x4*)(H + (size_t)(row0 + ai * HALF + m * 16) * 512 + col0) = w4;
            }
    }
};
template <class Epi, class Sched, bool ALIGN_EPI = false, bool SP2 = false>
__device__ __forceinline__ void gemm_phase(PG8_LAS unsigned char* lds, const Gemm g, const Sched& S, const Epi& E, const int tid) {
    const int wid = __builtin_amdgcn_readfirstlane(tid >> 6), lane = tid & 63, wr = wid >> 2, wc = wid & 3, fr = lane & 15, fq = lane >> 4;
    const int K = g.K, nt = K / BK;
    unsigned voffA[2], voffB[2];
#pragma unroll
    for (int i = 0; i < 2; ++i) { int R, C; stage_rc(tid * 16 + i * 8192, R, C); const int Rb = Epi::PERM ? ((R & ~31) + perm32(R & 31)) : R;
        voffA[i] = (unsigned)(R * K + C) * 2u; voffB[i] = (unsigned)(Rb * K + C) * 2u; }
    const size_t kstep = (size_t)(BK * 2);
    const size_t hstep = (size_t)HALF * K * 2;
    const size_t tstep = 2 * hstep;
    const unsigned ldsw = (unsigned)wid * 1024u;
    const int aoff = lds_byte(wr * 64 + fr, fq * 8), boff = lds_byte(wc * 32 + fr, fq * 8);
#define PG8_SA(b, h) (((b) * 2 + (h)) * HTB)
#define PG8_SB(b, h) ((4 + (b) * 2 + (h)) * HTB)
#define PG8_STAGE(bufoff, gbase, voff) do { _Pragma("unroll") for (int _i = 0; _i < 2; ++_i) \
        __builtin_amdgcn_global_load_lds((const unsigned*)((const char*)(gbase) + (voff)[_i]), (PG8_LAS unsigned*)(lds + (bufoff) + ldsw + _i * 8192), 16, 0, 0); } while (0)
#define PG8_LDA(dst, b, h) do { _Pragma("unroll") for (int m = 0; m < 4; ++m) _Pragma("unroll") for (int k = 0; k < 2; ++k) dst[m][k] = *(const PG8_LAS bf16x8*)(lds + PG8_SA(b, h) + aoff + m * 2048 + k * 1024); } while (0)
#define PG8_LDB(dst, b, h) do { _Pragma("unroll") for (int n = 0; n < 2; ++n) _Pragma("unroll") for (int k = 0; k < 2; ++k) dst[n][k] = *(const PG8_LAS bf16x8*)(lds + PG8_SB(b, h) + boff + n * 2048 + k * 1024); } while (0)
#define PG8_MMA(ai, bj, At, Bt) do { __builtin_amdgcn_s_setprio(1); _Pragma("unroll") for (int m = 0; m < 4; ++m) _Pragma("unroll") for (int n = 0; n < 2; ++n) _Pragma("unroll") for (int k = 0; k < 2; ++k) \
        acc[ai][bj][m][n] = __builtin_amdgcn_mfma_f32_16x16x32_bf16(Bt[n][k], At[m][k], acc[ai][bj][m][n], 0, 0, 0); __builtin_amdgcn_s_setprio(0); } while (0)
#define PG8_WAIT_V(n) asm volatile("s_waitcnt vmcnt(" #n ")" ::: "memory")
#define PG8_WAIT_L(n) asm volatile("s_waitcnt lgkmcnt(" #n ")" ::: "memory")
#define PG8_BAR __builtin_amdgcn_s_barrier()
#define PG8_SCHED __builtin_amdgcn_sched_barrier(0)
    Unit cur, nxt; int ui = 0;
    if (!S.next(0, cur)) return;
    f32x4 acc[2][2][4][2];
#pragma unroll
    for (int a = 0; a < 2; ++a)
#pragma unroll
        for (int b = 0; b < 2; ++b)
#pragma unroll
            for (int m = 0; m < 4; ++m)
#pragma unroll
                for (int n = 0; n < 2; ++n) acc[a][b][m][n] = (f32x4){0.f, 0.f, 0.f, 0.f};
    bf16x8 At[4][2], B0[2][2], B1[2][2];
    const char* cA = (const char*)g.A + (size_t)cur.pm * tstep; const char* cB = (const char*)g.Bt + (size_t)cur.pn * tstep;
    S.a_ready(cur);
    if constexpr (SP2) {
        PG8_STAGE(PG8_SB(0, 0), cB, voffB); PG8_STAGE(PG8_SB(0, 1), cB + hstep, voffB); PG8_STAGE(PG8_SA(0, 0), cA, voffA); PG8_STAGE(PG8_SA(0, 1), cA + hstep, voffA);
        if (wr == 1) PG8_BAR;
        PG8_WAIT_V(2); PG8_BAR;
        PG8_STAGE(PG8_SB(1, 0), cB + kstep, voffB); PG8_STAGE(PG8_SA(1, 0), cA + kstep, voffA); PG8_STAGE(PG8_SB(1, 1), cB + hstep + kstep, voffB);
        PG8_WAIT_V(6); PG8_BAR;
    } else {
        PG8_STAGE(PG8_SB(0, 0), cB, voffB); PG8_STAGE(PG8_SA(0, 0), cA, voffA); PG8_STAGE(PG8_SB(0, 1), cB + hstep, voffB); PG8_STAGE(PG8_SA(0, 1), cA + hstep, voffA);
        if (wr == 1) PG8_BAR;
        PG8_WAIT_V(4); PG8_BAR;
        PG8_STAGE(PG8_SB(1, 0), cB + kstep, voffB); PG8_STAGE(PG8_SA(1, 0), cA + kstep, voffA); PG8_STAGE(PG8_SB(1, 1), cB + hstep + kstep, voffB);
        PG8_WAIT_V(6); PG8_BAR;
    }
    for (;;) {
        const bool has_next = S.next(ui + 1, nxt);
        const char* nA = has_next ? (const char*)g.A + (size_t)nxt.pm * tstep : cA; const char* nB = has_next ? (const char*)g.Bt + (size_t)nxt.pn * tstep : cB;
        for (int t = 0; t < nt; t += 2) {
            const bool last = (t == nt - 2);
            const char* a1 = cA + (size_t)(t + 1) * kstep;
            const char* a2 = last ? nA : cA + (size_t)(t + 2) * kstep; const char* b2 = last ? nB : cB + (size_t)(t + 2) * kstep;
            const char* a3 = a2 + kstep; const char* b3 = b2 + kstep;
            if (last && has_next) S.a_ready(nxt);
            if constexpr (SP2) {
            PG8_LDB(B0, 0, 0); PG8_LDB(B1, 0, 1); PG8_SCHED; PG8_LDA(At, 0, 0); PG8_STAGE(PG8_SA(1, 1), a1 + hstep, voffA);
            PG8_WAIT_V(8); PG8_WAIT_L(0); PG8_BAR; PG8_MMA(0, 0, At, B0); PG8_MMA(0, 1, At, B1); PG8_BAR; PG8_SCHED;
            PG8_LDA(At, 0, 1); PG8_STAGE(PG8_SB(0, 0), b2, voffB); PG8_STAGE(PG8_SB(0, 1), b2 + hstep, voffB); PG8_STAGE(PG8_SA(0, 0), a2, voffA);
            PG8_WAIT_V(8); PG8_WAIT_L(0); PG8_BAR; PG8_MMA(1, 0, At, B0); PG8_MMA(1, 1, At, B1); PG8_BAR; PG8_SCHED;
            PG8_LDB(B0, 1, 0); PG8_LDB(B1, 1, 1); PG8_SCHED; PG8_LDA(At, 1, 0); PG8_STAGE(PG8_SA(0, 1), a2 + hstep, voffA);
            PG8_WAIT_V(8); PG8_WAIT_L(0); PG8_BAR; PG8_MMA(0, 0, At, B0); PG8_MMA(0, 1, At, B1); PG8_BAR; PG8_SCHED;
            PG8_LDA(At, 1, 1); PG8_STAGE(PG8_SB(1, 0), b3, voffB); PG8_STAGE(PG8_SB(1, 1), b3 + hstep, voffB); PG8_STAGE(PG8_SA(1, 0), a3, voffA);
            PG8_WAIT_V(8); PG8_WAIT_L(0); PG8_BAR; PG8_MMA(1, 0, At, B0); PG8_MMA(1, 1, At, B1); PG8_BAR; PG8_SCHED;
            } else {
            PG8_LDB(B0, 0, 0); PG8_SCHED; PG8_LDA(At, 0, 0); PG8_STAGE(PG8_SA(1, 1), a1 + hstep, voffA);
            PG8_WAIT_L(8); PG8_BAR; PG8_WAIT_L(0); PG8_MMA(0, 0, At, B0); PG8_BAR; PG8_SCHED;
            PG8_LDB(B1, 0, 1); PG8_STAGE(PG8_SB(0, 0), b2, voffB);
            PG8_BAR; PG8_WAIT_L(0); PG8_MMA(0, 1, At, B1); PG8_BAR;
            PG8_LDA(At, 0, 1); PG8_STAGE(PG8_SA(0, 0), a2, voffA);
            PG8_BAR; PG8_WAIT_L(0); PG8_MMA(1, 0, At, B0); PG8_BAR; PG8_SCHED;
            PG8_STAGE(PG8_SB(0, 1), b2 + hstep, voffB);
            PG8_WAIT_V(6); PG8_BAR; PG8_MMA(1, 1, At, B1); PG8_BAR;
            PG8_LDB(B0, 1, 0); PG8_SCHED; PG8_LDA(At, 1, 0); PG8_STAGE(PG8_SA(0, 1), a2 + hstep, voffA);
            PG8_WAIT_L(8); PG8_BAR; PG8_WAIT_L(0); PG8_MMA(0, 0, At, B0); PG8_BAR; PG8_SCHED;
            PG8_LDB(B1, 1, 1); PG8_STAGE(PG8_SB(1, 0), b3, voffB);
            PG8_BAR; PG8_WAIT_L(0); PG8_MMA(0, 1, At, B1); PG8_BAR;
            PG8_LDA(At, 1, 1); PG8_STAGE(PG8_SA(1, 0), a3, voffA);
            PG8_BAR; PG8_WAIT_L(0); PG8_MMA(1, 0, At, B0); PG8_BAR; PG8_SCHED;
            PG8_STAGE(PG8_SB(1, 1), b3 + hstep, voffB);
            PG8_WAIT_V(6); PG8_BAR; PG8_MMA(1, 1, At, B1); PG8_BAR;
            }
        }
        if constexpr (ALIGN_EPI) { if (wr == 0) PG8_BAR; }
        if constexpr (!Epi::AFTER_DRAIN) { E(acc, cur, wr, wc, fr, fq); S.done(cur); }
        if (!has_next) break;
#pragma unroll
        for (int a = 0; a < 2; ++a)
#pragma unroll
            for (int b = 0; b < 2; ++b)
#pragma unroll
                for (int m = 0; m < 4; ++m)
#pragma unroll
                    for (int n = 0; n < 2; ++n) acc[a][b][m][n] = (f32x4){0.f, 0.f, 0.f, 0.f};
        cur = nxt; cA = nA; cB = nB; ++ui;
        if constexpr (ALIGN_EPI) { if (wr == 1) PG8_BAR; }
    }
    PG8_WAIT_V(0);
    if constexpr (!ALIGN_EPI) { if (wr == 0) PG8_BAR; }
    PG8_BAR;
    if constexpr (Epi::AFTER_DRAIN) { E.fused(acc, cur, wr, wc, fr, fq, lds, wid, lane); S.done(cur); }
#undef PG8_SA
#undef PG8_SB
#undef PG8_STAGE
#undef PG8_LDA
#undef PG8_LDB
#undef PG8_MMA
#undef PG8_WAIT_V
#undef PG8_WAIT_L
#undef PG8_BAR
#undef PG8_SCHED
}
}


__device__ __forceinline__ void transpose_item(const float* W, int K, int N, bf16* WT, int dst_row0, LAS float* scr, int k0, int n0, int lane) {
    float tv[32];
#pragma unroll
    for (int i = 0; i < 32; ++i) tv[i] = W[(size_t)(k0 + 2 * i + (lane >> 5)) * N + n0 + (lane & 31)];
#pragma unroll
    for (int i = 0; i < 32; ++i) scr[(2 * i + (lane >> 5)) * 33 + (lane & 31)] = tv[i];
    asm volatile("s_waitcnt lgkmcnt(0)" ::: "memory");
    const int cc = lane & 7;
#pragma unroll
    for (int j = 0; j < 4; ++j) { const int n = (lane >> 3) + 8 * j; const LAS float* s = scr + (8 * cc) * 33 + n;
        u32x4 o; o.x = pk2(s[0 * 33], s[1 * 33]); o.y = pk2(s[2 * 33], s[3 * 33]); o.z = pk2(s[4 * 33], s[5 * 33]); o.w = pk2(s[6 * 33], s[7 * 33]);
        *(u32x4*)(WT + (size_t)(dst_row0 + n) * K + k0 + 8 * cc) = o; }
    asm volatile("s_waitcnt lgkmcnt(0)" ::: "memory");
}
__device__ __forceinline__ void weights_prologue(const Ctx& c, const Args& a, unsigned char* ws) {
    LAS float* scr = (LAS float*)(c.lds + c.wave * 16384);
    bf16* WIN = (bf16*)(ws + WS_WIN); bf16* WO = (bf16*)(ws + WS_WO); bf16* WGU = (bf16*)(ws + WS_WGU); bf16* WD = (bf16*)(ws + WS_WD);
    constexpr int I_IN = NL * 16 * 64, I_O = NL * 16 * 32, I_G = NL * NE * 16 * 16, I_D = NL * NE * 8 * 32;
    constexpr int NITEMS = I_IN + I_O + 2 * I_G + I_D;
    for (int it = c.gw; it < NITEMS; it += c.ngw) {
        int r = it;
        if (r < I_IN) { const int l = r >> 10, kb = (r >> 6) & 15, nb = r & 63; transpose_item(a.in[1] + (size_t)l * DM * DIN, DM, DIN, WIN, l * DIN + nb * 32, scr, kb * 64, nb * 32, c.lane); continue; } r -= I_IN;
        if (r < I_O) { const int l = r >> 9, kb = (r >> 5) & 15, nb = r & 31; transpose_item(a.in[15] + (size_t)l * DM * DM, DM, DM, WO, l * DM + nb * 32, scr, kb * 64, nb * 32, c.lane); continue; } r -= I_O;
        if (r < 2 * I_G) { const int up = r >= I_G; if (up) r -= I_G; const int le = r >> 8, kb = (r >> 4) & 15, nb = r & 15, n0 = nb * 32;
            transpose_item(a.in[up ? 21 : 20] + (size_t)le * DM * DE, DM, DE, WGU, le * 1024 + (n0 >> 7) * 256 + (n0 & 127) + up * 128, scr, kb * 64, n0, c.lane); continue; } r -= 2 * I_G;
        { const int le = r >> 8, kb = (r >> 5) & 7, nb = r & 31; transpose_item(a.in[22] + (size_t)le * DE * DM, DE, DM, WD, le * 1024 + nb * 32, scr, kb * 64, nb * 32, c.lane); }
    }
}

constexpr int PH_PER_LAYER = 8, N_PHASES = 1 + NL * PH_PER_LAYER;
struct Ptrs { bf16 *Z, *XB, *YN, *XG, *YS, *H, *GMW, *PWT, *POOLT; float *U, *RTG; unsigned* RTE; int* RTP; };
__device__ __forceinline__ Ptrs make_ptrs(unsigned char* ws) {
    Ptrs p;
    p.Z = (bf16*)(ws + WS_Z); p.XB = (bf16*)(ws + WS_XB); p.YN = (bf16*)(ws + WS_YN); p.U = (float*)(ws + WS_U); p.XG = (bf16*)(ws + WS_A); p.YS = (bf16*)(ws + WS_A); p.H = (bf16*)(ws + WS_H);
    p.GMW = (bf16*)(ws + WS_GMW); p.PWT = (bf16*)(ws + WS_PWT); p.POOLT = (bf16*)(ws + WS_POOLT);
    p.RTE = (unsigned*)(ws + WS_RT); p.RTG = (float*)(ws + WS_RT + 256 * 1024); p.RTP = (int*)(ws + WS_RT + 512 * 1024);
    return p;
}
template <int L>
__device__ __forceinline__ void run_layer(const Args& args, const Ctx& c0, const XcdBarrier& bar, const bool one, const int lo, const int hi) {
    constexpr int PB = 1 + L * PH_PER_LAYER;
    unsigned char* ws = args.ws;
    const Ptrs P = make_ptrs(ws);
    const float* X = (L == 0) ? args.in[0] : args.out;
    unsigned* CNT = (unsigned*)ws + CW_CNT + 64 * L;
#define IN(k) (lo <= PB + (k) && PB + (k) < hi)
#define PHASE_CTX Ctx c = c0; asm volatile("" : "+v"(c.tid)); c.lane = c.tid & 63; c.gtid = blockIdx.x * NT + c.tid
#define SEAM(k) do { if (one && PB + (k) + 1 < hi) xcd_barrier(bar); } while (0)
    if (IN(0)) { PHASE_CTX; pg8::Gemm g{P.XB, (const bf16*)(ws + WS_WIN) + (size_t)L * DIN * DM, M, DIN, DM}; pg8::StaticOrder S; S.init(M, DIN, (int)gridDim.x, (int)blockIdx.x);
        pg8::EpiBf16<0> E{P.Z, DIN, nullptr, 0, 0, 1.f, 0xffff};
        pg8::gemm_phase<pg8::EpiBf16<0>, pg8::StaticOrder, true, true>(c.lds, g, S, E, c.tid); SEAM(0); }
    if (IN(1)) { PHASE_CTX; const Lw w = layer_weights(args, L); for (int r = 0; r < RPT_MIX; ++r) mixer_phase(c, w, L, P.Z, P.GMW, P.PWT, P.POOLT, P.YN); SEAM(1); }
    if (IN(2)) { PHASE_CTX; pg8::Gemm g{P.YN, (const bf16*)(ws + WS_WO) + (size_t)L * DM * DM, M, DM, DM}; pg8::StaticOrder S; S.init(M, DM, (int)gridDim.x, (int)blockIdx.x);
        pg8::EpiResF32 E{X, P.U, ALPHA};
        pg8::gemm_phase<pg8::EpiResF32, pg8::StaticOrder, true, true>(c.lds, g, S, E, c.tid); SEAM(2); }
    if (IN(3)) { PHASE_CTX; const Lw w = layer_weights(args, L); for (int r = 0; r < RPT_LN1; ++r) nv_ln1_router(c, w, P.U, args.out, P.RTE, P.RTG); moe_ranks(c, P.RTE, P.RTP, CNT); SEAM(3); }
    if (IN(4)) { PHASE_CTX; moe_gather(c, args.out, P.RTE, P.RTP, CNT, P.XG); SEAM(4); }
    if (IN(5)) { PHASE_CTX; moe_tiles(c, CNT); pg8::MoeOrder S{(const LAS int*)(c.lds + LDS_TAB_OFF), (int)gridDim.x, (int)blockIdx.x};
        pg8::Gemm g{P.XG, (const bf16*)(ws + WS_WGU) + (size_t)L * NE * 1024 * DM, 0, 0, DM};
        pg8::EpiSwiGLU E{P.H};
        pg8::gemm_phase<pg8::EpiSwiGLU, pg8::MoeOrder, true, true>(c.lds, g, S, E, c.tid); SEAM(5); }
    if (IN(6)) { PHASE_CTX; moe_tiles(c, CNT); pg8::MoeOrder S{(const LAS int*)(c.lds + LDS_TAB_OFF), (int)gridDim.x, (int)blockIdx.x};
        pg8::Gemm g{P.H, (const bf16*)(ws + WS_WD) + (size_t)L * NE * 1024 * DE, 0, 0, DE};
        pg8::EpiBf16<0> E{P.YS, DM, nullptr, 0, 0, 1.f, 3};
        pg8::gemm_phase<pg8::EpiBf16<0>, pg8::MoeOrder, true, true>(c.lds, g, S, E, c.tid); SEAM(6); }
    if (IN(7)) { PHASE_CTX; const Lw w = layer_weights(args, L); moe_combine_ln2(c, w, args.out, P.YS, P.RTG, P.RTP, args.out, P.XB); SEAM(7); }
#undef IN
#undef SEAM
#undef PHASE_CTX
}
__global__ void __launch_bounds__(NT, 2) fwd_kernel(Args args) {
    extern __shared__ __attribute__((aligned(16))) unsigned char lds_raw[];
    Ctx c;
    c.lds = (LAS unsigned char*)lds_raw;
    c.tid = threadIdx.x; c.lane = c.tid & 63; c.wave = __builtin_amdgcn_readfirstlane(c.tid >> 6);
    c.gtid = blockIdx.x * NT + c.tid; c.gsize = gridDim.x * NT; c.gw = blockIdx.x * NWAVES + c.wave; c.ngw = gridDim.x * NWAVES;
    volatile LAS unsigned* MISC = (volatile LAS unsigned*)(c.lds + LDS_BYTES - 64);
    if (c.tid < 16) MISC[c.tid] = 0u;
    __syncthreads();
    XcdBarrier bar; bar.bar = (unsigned*)args.ws + CW_BAR; bar.x = 0; bar.st = nullptr;
    const int lo = args.ph_lo, hi = args.ph_hi;
    const bool one = (hi - lo) > 1;
    if (one) bar = xcd_barrier_post((unsigned*)args.ws + CW_BAR, MISC + 8);
    if (lo <= 0 && 0 < hi) {
        const Ptrs P = make_ptrs(args.ws);
        Ctx c0 = c; asm volatile("" : "+v"(c.tid)); c.lane = c.tid & 63; c.gtid = blockIdx.x * NT + c.tid;
        for (int r = 0; r < RPT_PRO; ++r) { nv_prologue(c, args.in[0], P.XB); small_weights(c, args, P.GMW, P.PWT, P.POOLT); weights_prologue(c, args, args.ws); }
        if (one && 1 < hi) xcd_barrier(bar);
    }
    run_layer<0>(args, c, bar, one, lo, hi);
    run_layer<1>(args, c, bar, one, lo, hi);
}

extern "C" void kernel_launch(void* const* d_in, const int* in_sizes, int n_in, void* d_out, int out_size, void* d_ws, size_t ws_size, hipStream_t stream) {
    static int grid = 0;
    if (grid == 0) {
        if (n_in != 25 || in_sizes[0] != M * DM || out_size != M * DM || ws_size < WS_END) { fprintf(stderr, "kernel_launch: unexpected shapes/ws (n_in %d ws %zu)\n", n_in, ws_size); grid = -1; return; }
        int dev = 0, cus = 0;
        if (hipGetDevice(&dev) != hipSuccess || hipDeviceGetAttribute(&cus, hipDeviceAttributeMultiprocessorCount, dev) != hipSuccess) { grid = -1; return; }
        if (hipFuncSetAttribute((const void*)fwd_kernel, hipFuncAttributeMaxDynamicSharedMemorySize, LDS_BYTES) != hipSuccess) { grid = -1; return; }
        (void)hipGetLastError();
        grid = cus;
    }
    if (grid < 0) return;
    (void)hipMemsetAsync((char*)d_ws + WS_CTL, 0, CTL_ZERO_BYTES, stream);
    Args a{};
    for (int i = 0; i < 25; ++i) a.in[i] = (const float*)d_in[i];
    a.out = (float*)d_out; a.ws = (unsigned char*)d_ws;
#if MK_ONE_LAUNCH
    a.ph_lo = 0; a.ph_hi = N_PHASES;
    hipLaunchKernelGGL(fwd_kernel, dim3(grid), dim3(NT), LDS_BYTES, stream, a);
#else
    for (int ph = 0; ph < N_PHASES; ++ph) { a.ph_lo = ph; a.ph_hi = ph + 1; hipLaunchKernelGGL(fwd_kernel, dim3(grid), dim3(NT), LDS_BYTES, stream, a); }
#endif
}
```

```cpp
#include <hip/hip_runtime.h>
#include <cstdio>
#include <cstdint>

#ifndef RPT_PRO
#define RPT_PRO 1
#endif
#ifndef RPT_MIX
#define RPT_MIX 1
#endif
#ifndef RPT_LN1
#define RPT_LN1 1
#endif
#ifndef MK_ONE_LAUNCH
#define MK_ONE_LAUNCH 1
#endif

constexpr int NB = 4, SEQ = 4096, DM = 1024, M = NB * SEQ, DIN = 2048, NE = 16, DE = 512, NL = 2;
constexpr int DG = 256, CHUNK = 128, CONFK = 31;
constexpr float ALPHA = 1.41421356237309515f;
constexpr float LN_EPS = 1e-5f, RMS_EPS = 1e-6f;
constexpr int NWAVES = 8, NT = NWAVES * 64;
constexpr int LDS_BYTES = 147456;

typedef unsigned short bf16;
typedef float f32x4 __attribute__((ext_vector_type(4)));
typedef unsigned u32x4 __attribute__((ext_vector_type(4)));
typedef unsigned u32x2 __attribute__((ext_vector_type(2)));
#define LAS __attribute__((address_space(3)))
#define GAS __attribute__((address_space(1)))
typedef GAS unsigned gu32;
#define RLX_AGENT __ATOMIC_RELAXED, __HIP_MEMORY_SCOPE_AGENT

constexpr size_t MiB = 1u << 20;
constexpr size_t WS_CTL = 0, CTL_ZERO_BYTES = 1 * MiB;
constexpr size_t WS_WIN = 1 * MiB;
constexpr size_t WS_WO = 9 * MiB;
constexpr size_t WS_WGU = 13 * MiB;
constexpr size_t WS_WD = 77 * MiB;
constexpr size_t WS_SMALL = 109 * MiB;
constexpr size_t WS_GMW = WS_SMALL, WS_PWT = WS_SMALL + 256 * 1024, WS_POOLT = WS_SMALL + 512 * 1024;
constexpr size_t WS_A = 110 * MiB;
constexpr size_t WS_Z = WS_A, WS_U = WS_A, WS_F = WS_A;
constexpr size_t WS_D = 182 * MiB;
constexpr size_t WS_XB = WS_D, WS_YN = WS_D, WS_H = WS_D;
constexpr size_t WS_RT = 218 * MiB;
constexpr size_t WS_END = 219 * MiB;
constexpr int CW_BAR = 4096;

__device__ __forceinline__ float bf2f(bf16 v) { return __uint_as_float(((unsigned)v) << 16); }
__device__ __forceinline__ unsigned f2bf(float f) { unsigned u = __float_as_uint(f); return (u + 0x7fffu + ((u >> 16) & 1u)) >> 16; }
__device__ __forceinline__ unsigned pk2(float lo, float hi) { return f2bf(lo) | (f2bf(hi) << 16); }
__device__ __forceinline__ float sigmoidf_(float x) { return __builtin_amdgcn_rcpf(1.0f + __builtin_amdgcn_exp2f(-1.44269504089f * x)); }
__device__ __forceinline__ float siluf_(float x) { return x * sigmoidf_(x); }
__device__ __forceinline__ float wave_sum(float v) {
#pragma unroll
    for (int o = 1; o < 64; o <<= 1) v += __shfl_xor(v, o);
    return v;
}

#define XB_TMO      128
#define XB_XCNT(j)  (256  + 64 * (j))
#define XB_XSUB(j)  (1280 + 64 * (j))
#define XB_XGEN(j)  (2304 + 64 * (j))
#define XB_TOP      3328
#define XB_TOPGEN   3392
#define XCD_BAR_WORDS 3456
#define XB_SPIN_CAP (1u << 18)
__device__ __forceinline__ unsigned xb_ld(unsigned* p)              { return __hip_atomic_load(p, __ATOMIC_RELAXED, __HIP_MEMORY_SCOPE_AGENT); }
__device__ __forceinline__ unsigned xb_add(unsigned* p, unsigned v) { return __hip_atomic_fetch_add(p, v, __ATOMIC_RELAXED, __HIP_MEMORY_SCOPE_AGENT); }
__device__ __forceinline__ unsigned xb_xcc_id() { return (unsigned)__builtin_amdgcn_s_getreg((3 << 11) | 20) & 0xFu; }
#define XB_SPIN(cond, bar) do { unsigned _sp = 0; while (cond) { __builtin_amdgcn_s_sleep(1); \
    if ((++_sp & 255u) == 0u) { if (xb_ld(&(bar)[XB_TMO])) break; if (_sp > XB_SPIN_CAP) { atomicAdd(&(bar)[XB_TMO], 1u); break; } } } } while (0)
struct XcdBarrier { unsigned* bar; unsigned x; volatile LAS unsigned* st; };
__device__ __forceinline__ XcdBarrier xcd_barrier_post(unsigned* bar, volatile LAS unsigned* st) {
    XcdBarrier b; b.bar = bar; b.x = xb_xcc_id(); b.st = st;
    if (threadIdx.x == 0) (void)xb_add(&bar[XB_XCNT(b.x)], 1u);
    return b;
}
__device__ __forceinline__ void xcd_barrier_complete(unsigned* bar, unsigned x, unsigned& nloc, unsigned& nx) {
    const unsigned G = gridDim.x * gridDim.y * gridDim.z;
    unsigned sum, cnt, mine, sp = 0u;
    for (;;) {
        sum = 0u; cnt = 0u; mine = 0u;
#pragma unroll
        for (unsigned j = 0; j < 16; ++j) { const unsigned c = xb_ld(&bar[XB_XCNT(j)]); sum += c; cnt += (c > 0u) ? 1u : 0u; mine = (j == x) ? c : mine; }
        if (sum == G) break;
        __builtin_amdgcn_s_sleep(1);
        if ((++sp & 255u) == 0u) { if (xb_ld(&bar[XB_TMO])) break; if (sp > XB_SPIN_CAP) { atomicAdd(&bar[XB_TMO], 1u); break; } }
    }
    nloc = mine > 0u ? mine : 1u; nx = cnt > 0u ? cnt : 1u;
}
__device__ __forceinline__ void xcd_barrier(const XcdBarrier& b) {
    asm volatile("s_waitcnt vmcnt(0)" ::: "memory");
    __syncthreads();
    if (threadIdx.x == 0) {
        unsigned* bar = b.bar;
        __builtin_amdgcn_s_waitcnt(0);
        unsigned nloc = b.st[0], nx = b.st[1];
        if (nloc == 0u) { xcd_barrier_complete(bar, b.x, nloc, nx); b.st[0] = nloc; b.st[1] = nx; }
        const unsigned old = xb_add(&bar[XB_XSUB(b.x)], 1u);
        const unsigned gen = old / nloc;
        if (old + 1u == (gen + 1u) * nloc) {
            __builtin_amdgcn_fence(__ATOMIC_RELEASE, "agent");
            asm volatile("s_waitcnt vmcnt(0)" ::: "memory");
            const unsigned og = xb_add(&bar[XB_TOP], 1u);
            const unsigned tg = og / nx;
            if (og + 1u == (tg + 1u) * nx) xb_add(&bar[XB_TOPGEN], 1u);
            else XB_SPIN(xb_ld(&bar[XB_TOPGEN]) == tg, bar);
            __builtin_amdgcn_fence(__ATOMIC_ACQUIRE, "agent");
            xb_add(&bar[XB_XGEN(b.x)], 1u);
            asm volatile("s_waitcnt vmcnt(0)" ::: "memory");
        } else {
            XB_SPIN(xb_ld(&bar[XB_XGEN(b.x)]) == gen, bar);
            __builtin_amdgcn_fence(__ATOMIC_ACQUIRE, "agent");
            asm volatile("s_waitcnt vmcnt(0)" ::: "memory");
        }
    }
    __syncthreads();
}

struct Args { const float* in[25]; float* out; unsigned char* ws; int ph_lo, ph_hi; };

struct Ctx {
    int tid, lane, wave, gtid, gsize, gw, ngw;
    LAS unsigned char* lds;
};

template <class Epi>
__device__ __forceinline__ void nv_gemm(const Ctx& c, const bf16* A, int lda, const float* W, int ldw, int Mr, int N, int K, const Epi& epi) {
    const int ntn = N / 4; const long total = (long)ntn * (Mr / 4);
    for (long i = c.gtid; i < total; i += c.gsize) {
        const int tn = (int)(i % ntn), tm = (int)(i / ntn);
        float acc[4][4];
#pragma unroll
        for (int r = 0; r < 4; ++r)
#pragma unroll
            for (int q = 0; q < 4; ++q) acc[r][q] = 0.f;
        const bf16* a0 = A + (size_t)(tm * 4) * lda;
        const float* w0 = W + tn * 4;
        for (int k = 0; k < K; k += 8) {
            u32x4 av[4];
#pragma unroll
            for (int r = 0; r < 4; ++r) av[r] = *(const u32x4*)(a0 + (size_t)r * lda + k);
#pragma unroll
            for (int kk = 0; kk < 8; ++kk) {
                const f32x4 w = *(const f32x4*)(w0 + (size_t)(k + kk) * ldw);
#pragma unroll
                for (int r = 0; r < 4; ++r) {
                    const unsigned pr = av[r][kk >> 1];
                    const float a = (kk & 1) ? __uint_as_float(pr & 0xffff0000u) : __uint_as_float(pr << 16);
#pragma unroll
                    for (int q = 0; q < 4; ++q) acc[r][q] += a * w[q];
                }
            }
        }
#pragma unroll
        for (int r = 0; r < 4; ++r) epi(tm * 4 + r, tn * 4, (f32x4){acc[r][0], acc[r][1], acc[r][2], acc[r][3]});
    }
}

__device__ __forceinline__ void ln256(f32x4& v, const float* g, const float* b, int lane) {
    const float mean = wave_sum((v[0] + v[1]) + (v[2] + v[3])) * (1.f / 256.f);
    v = v - mean;
    const float var = wave_sum((v[0] * v[0] + v[1] * v[1]) + (v[2] * v[2] + v[3] * v[3])) * (1.f / 256.f);
    const float rstd = __builtin_amdgcn_rsqf(var + LN_EPS);
    const f32x4 gg = *(const f32x4*)(g + lane * 4), bb = *(const f32x4*)(b + lane * 4);
    v = v * rstd * gg + bb;
}
__device__ __forceinline__ f32x4 ld_bf4(const bf16* p) { const u32x2 w = *(const u32x2*)p; return (f32x4){__uint_as_float(w.x << 16), __uint_as_float(w.x & 0xffff0000u), __uint_as_float(w.y << 16), __uint_as_float(w.y & 0xffff0000u)}; }
__device__ __forceinline__ void st_bf4(bf16* p, f32x4 v) { u32x2 w; w.x = pk2(v[0], v[1]); w.y = pk2(v[2], v[3]); *(u32x2*)p = w; }

struct Lw {
    const float *w_in, *gm_ln_g, *gm_ln_b, *gm_w_s, *gm_b_s, *cf_dw_w, *cf_dw_b, *cf_ln_g, *cf_ln_b, *cf_pw, *pool_w, *pool_scale, *sc_w, *mix_norm_g, *w_o, *ln1_g, *ln1_b,
        *router_w, *router_b, *wg, *wu, *wd, *ln2_g, *ln2_b;
};
__device__ __forceinline__ Lw layer_weights(const Args& a, int l) {
    Lw w;
    w.w_in = a.in[1] + (size_t)l * DM * DIN; w.gm_ln_g = a.in[2] + l * DG; w.gm_ln_b = a.in[3] + l * DG; w.gm_w_s = a.in[4] + (size_t)l * 4 * CHUNK * CHUNK; w.gm_b_s = a.in[5] + l * 4 * CHUNK;
    w.cf_dw_w = a.in[6] + l * CONFK * DG; w.cf_dw_b = a.in[7] + l * DG; w.cf_ln_g = a.in[8] + l * DG; w.cf_ln_b = a.in[9] + l * DG; w.cf_pw = a.in[10] + (size_t)l * DG * DG;
    w.pool_w = a.in[11] + l * 4 * 64 * 64; w.pool_scale = a.in[12] + l * DG; w.sc_w = a.in[13] + l * 3 * DG; w.mix_norm_g = a.in[14] + l * DM; w.w_o = a.in[15] + (size_t)l * DM * DM;
    w.ln1_g = a.in[16] + l * DM; w.ln1_b = a.in[17] + l * DM; w.router_w = a.in[18]; w.router_b = a.in[19];
    w.wg = a.in[20] + (size_t)l * NE * DM * DE; w.wu = a.in[21] + (size_t)l * NE * DM * DE; w.wd = a.in[22] + (size_t)l * NE * DE * DM;
    w.ln2_g = a.in[23] + l * DM; w.ln2_b = a.in[24] + l * DM;
    return w;
}

__device__ __forceinline__ void nv_prologue(const Ctx& c, const float* x, bf16* XB) {
    constexpr size_t N4 = (size_t)M * DM / 4;
    for (size_t i0 = (size_t)c.gtid; i0 < N4; i0 += (size_t)c.gsize * 8) {
        f32x4 v[8];
#pragma unroll
        for (int j = 0; j < 8; ++j) { const size_t i = i0 + (size_t)j * c.gsize; if (i < N4) v[j] = *(const f32x4*)(x + i * 4); }
#pragma unroll
        for (int j = 0; j < 8; ++j) { const size_t i = i0 + (size_t)j * c.gsize; if (i < N4) st_bf4(XB + i * 4, v[j]); }
    }
}
typedef short bf16x8 __attribute__((ext_vector_type(8)));
__device__ __forceinline__ bf16x8 as_bf16x8(u32x4 v) { return __builtin_bit_cast(bf16x8, v); }
#define MFMA16(a, b, c) __builtin_amdgcn_mfma_f32_16x16x32_bf16((a), (b), (c), 0, 0, 0)
constexpr int YT_LD = 260;
constexpr int AT_LD = 264;
constexpr int VT_RS = 260;

__device__ __forceinline__ void small_weights(const Ctx& c, const Args& a, bf16* GMW, bf16* PWT, bf16* POOLT) {
    for (int i = c.gtid; i < NL * 4 * CHUNK * CHUNK; i += c.gsize) { const int s = i & 127, t = (i >> 7) & 127; GMW[i] = (bf16)((s <= t) ? f2bf(a.in[4][i]) : 0u); }
    for (int i = c.gtid; i < NL * DG * DG; i += c.gsize) { const int cc = i & 255, n = (i >> 8) & 255, l = i >> 16; PWT[i] = (bf16)f2bf(a.in[10][((size_t)l * DG + cc) * DG + n]); }
    for (int i = c.gtid; i < NL * 4 * 64 * 64; i += c.gsize) { const int d = i & 63, e = (i >> 6) & 63, lg = i >> 12; POOLT[i] = (bf16)f2bf(a.in[11][((size_t)lg * 64 + d) * 64 + e]); }
}

template <bool UMUL>
__device__ __forceinline__ void mix_final(const Ctx& c, const Lw& w, int t0, int grp, bf16* YN, const bf16* Z = nullptr) {
    const LAS float* YT = (const LAS float*)c.lds;
    const f32x4 g = *(const f32x4*)(w.mix_norm_g + grp * DG + c.lane * 4);
    u32x2 uu[16];
    if (UMUL) {
#pragma unroll
        for (int i = 0; i < 16; ++i) uu[i] = *(const u32x2*)(Z + (size_t)(t0 + c.wave * 16 + i) * DIN + c.lane * 4);
    }
#pragma unroll
    for (int i = 0; i < 16; ++i) {
        const int t = c.wave * 16 + i;
        f32x4 v = *(const LAS f32x4*)(YT + t * YT_LD + c.lane * 4);
        if (UMUL) v = v * (f32x4){__uint_as_float(uu[i].x << 16), __uint_as_float(uu[i].x & 0xffff0000u), __uint_as_float(uu[i].y << 16), __uint_as_float(uu[i].y & 0xffff0000u)};
        const float ms = wave_sum((v[0] * v[0] + v[1] * v[1]) + (v[2] * v[2] + v[3] * v[3])) * (1.f / 256.f);
        const float r = __builtin_amdgcn_rsqf(ms + RMS_EPS);
        st_bf4(YN + (size_t)(t0 + t) * DM + grp * DG + c.lane * 4, v * r * g);
    }
}

__device__ __forceinline__ void mix_conformer(const Ctx& c, const Lw& w, const bf16* Z, const bf16* PWT, int t0, bf16* YN) {
    LAS unsigned char* lds = c.lds;
    const int pos0 = t0 % SEQ;
    {
        const int c8 = (c.tid & 31) * 8, r0 = c.tid >> 5;
        u32x4 av[10], gv[10];
#pragma unroll
        for (int it = 0; it < 10; ++it) {
            const int r = r0 + 16 * it;
            av[it] = (u32x4){0u, 0u, 0u, 0u}; gv[it] = (u32x4){0u, 0u, 0u, 0u};
            if (r < 158 && pos0 + r - 30 >= 0) { const size_t zr = (size_t)(t0 + r - 30) * DIN; av[it] = *(const u32x4*)(Z + zr + 512 + c8); gv[it] = *(const u32x4*)(Z + zr + 768 + c8); }
        }
#pragma unroll
        for (int it = 0; it < 10; ++it) {
            const int r = r0 + 16 * it;
            if (r < 158) {
                u32x4 o;
#pragma unroll
                for (int j = 0; j < 4; ++j) {
                    const float a0 = __uint_as_float(av[it][j] << 16), a1 = __uint_as_float(av[it][j] & 0xffff0000u), g0 = __uint_as_float(gv[it][j] << 16), g1 = __uint_as_float(gv[it][j] & 0xffff0000u);
                    o[j] = pk2(a0 * sigmoidf_(g0), a1 * sigmoidf_(g1));
                }
                *(LAS u32x4*)(lds + r * 512 + c8 * 2) = o;
            }
        }
    }
    __syncthreads();
    constexpr int CT_OFF = 80896;
    {
        const int ch = c.tid & 255, tg = c.tid >> 8;
        float wk[CONFK];
#pragma unroll
        for (int k = 0; k < CONFK; ++k) wk[k] = w.cf_dw_w[k * DG + ch];
        const float b0 = w.cf_dw_b[ch];
#pragma unroll 1
        for (int sb = 0; sb < 8; ++sb) {
            float acc[8];
#pragma unroll
            for (int j = 0; j < 8; ++j) acc[j] = b0;
            const int rb = tg * 64 + sb * 8;
#pragma unroll
            for (int r = 0; r < 38; ++r) {
                const float h0 = bf2f(*(const LAS bf16*)(lds + (rb + r) * 512 + ch * 2));
#pragma unroll
                for (int j = 0; j < 8; ++j) { const int k = r - j; if (k >= 0 && k < CONFK) acc[j] += wk[k] * h0; }
            }
#pragma unroll
            for (int j = 0; j < 8; ++j) *(LAS bf16*)(lds + CT_OFF + (rb + j) * 512 + ch * 2) = (bf16)f2bf(acc[j]);
        }
    }
    __syncthreads();
    {
        const f32x4 g = *(const f32x4*)(w.cf_ln_g + c.lane * 4), b = *(const f32x4*)(w.cf_ln_b + c.lane * 4);
#pragma unroll 4
        for (int i = 0; i < 16; ++i) {
            const int t = c.wave * 16 + i;
            const u32x2 pv = *(const LAS u32x2*)(lds + CT_OFF + t * 512 + c.lane * 8);
            f32x4 v = (f32x4){__uint_as_float(pv.x << 16), __uint_as_float(pv.x & 0xffff0000u), __uint_as_float(pv.y << 16), __uint_as_float(pv.y & 0xffff0000u)};
            const float mean = wave_sum((v[0] + v[1]) + (v[2] + v[3])) * (1.f / 256.f);
            v = v - mean;
            const float var = wave_sum((v[0] * v[0] + v[1] * v[1]) + (v[2] * v[2] + v[3] * v[3])) * (1.f / 256.f);
            v = v * (__builtin_amdgcn_rsqf(var + LN_EPS)) * g + b;
            u32x2 o; o.x = pk2(siluf_(v[0]), siluf_(v[1])); o.y = pk2(siluf_(v[2]), siluf_(v[3]));
            *(LAS u32x2*)(lds + t * (AT_LD * 2) + c.lane * 8) = o;
        }
    }
    __syncthreads();
    {
        const int fr = c.lane & 15, fq = c.lane >> 4;
        f32x4 C[8][2];
#pragma unroll
        for (int rt = 0; rt < 8; ++rt) { C[rt][0] = (f32x4){0.f, 0.f, 0.f, 0.f}; C[rt][1] = (f32x4){0.f, 0.f, 0.f, 0.f}; }
        bf16x8 Bf[2][8];
#pragma unroll
        for (int ct = 0; ct < 2; ++ct)
#pragma unroll
            for (int ks = 0; ks < 8; ++ks) Bf[ct][ks] = as_bf16x8(*(const u32x4*)(PWT + (size_t)(c.wave * 32 + ct * 16 + fr) * DG + ks * 32 + fq * 8));
#pragma unroll
        for (int rt = 0; rt < 8; ++rt)
#pragma unroll
            for (int ks = 0; ks < 8; ++ks) {
                const bf16x8 Af = as_bf16x8(*(const LAS u32x4*)(lds + (rt * 16 + fr) * (AT_LD * 2) + (ks * 32 + fq * 8) * 2));
                C[rt][0] = MFMA16(Af, Bf[0][ks], C[rt][0]); C[rt][1] = MFMA16(Af, Bf[1][ks], C[rt][1]);
            }
        __syncthreads();
        LAS float* YT = (LAS float*)lds;
#pragma unroll
        for (int rt = 0; rt < 8; ++rt)
#pragma unroll
            for (int ct = 0; ct < 2; ++ct)
#pragma unroll
                for (int j = 0; j < 4; ++j) YT[(rt * 16 + fq * 4 + j) * YT_LD + c.wave * 32 + ct * 16 + fr] = C[rt][ct][j];
    }
    __syncthreads();
    mix_final<false>(c, w, t0, 1, YN);
}

__device__ __forceinline__ void mix_gmlp(const Ctx& c, const Lw& w, const bf16* Z, const bf16* GMW, int t0, bf16* YN) {
    LAS unsigned char* lds = c.lds;
    {
        float g[4], b[4];
#pragma unroll
        for (int q = 0; q < 4; ++q) { g[q] = w.gm_ln_g[c.lane + 64 * q]; b[q] = w.gm_ln_b[c.lane + 64 * q]; }
        bf16 raw[16][4];
#pragma unroll
        for (int i = 0; i < 16; ++i)
#pragma unroll
            for (int q = 0; q < 4; ++q) raw[i][q] = Z[(size_t)(t0 + c.wave * 16 + i) * DIN + 256 + c.lane + 64 * q];
#pragma unroll
        for (int i = 0; i < 8; ++i) {
            const int s = c.wave * 16 + 2 * i;
            float v[2][4];
#pragma unroll
            for (int p = 0; p < 2; ++p) {
#pragma unroll
                for (int q = 0; q < 4; ++q) v[p][q] = bf2f(raw[2 * i + p][q]);
                const float mean = wave_sum((v[p][0] + v[p][1]) + (v[p][2] + v[p][3])) * (1.f / 256.f);
#pragma unroll
                for (int q = 0; q < 4; ++q) v[p][q] -= mean;
                const float var = wave_sum((v[p][0] * v[p][0] + v[p][1] * v[p][1]) + (v[p][2] * v[p][2] + v[p][3] * v[p][3])) * (1.f / 256.f);
                const float rstd = __builtin_amdgcn_rsqf(var + LN_EPS);
#pragma unroll
                for (int q = 0; q < 4; ++q) v[p][q] = v[p][q] * rstd * g[q] + b[q];
            }
#pragma unroll
            for (int q = 0; q < 4; ++q) *(LAS unsigned*)(lds + (c.lane + 64 * q) * VT_RS + s * 2) = pk2(v[0][q], v[1][q]);
        }
    }
    __syncthreads();
    const int fr = c.lane & 15, fq = c.lane >> 4, h = c.wave >> 1, par = c.wave & 1;
    bf16x8 Bf[4][4];
#pragma unroll
    for (int ct = 0; ct < 4; ++ct)
#pragma unroll
        for (int ks = 0; ks < 4; ++ks) {
            u32x4 t;
#pragma unroll
            for (int i = 0; i < 4; ++i) t[i] = *(const LAS unsigned*)(lds + (h * 64 + ct * 16 + fr) * VT_RS + (ks * 32 + fq * 8 + 2 * i) * 2);
            Bf[ct][ks] = as_bf16x8(t);
        }
    __syncthreads();
    LAS float* YT = (LAS float*)lds;
    bf16x8 Af[4][4];
#pragma unroll
    for (int i = 0; i < 4; ++i)
#pragma unroll
        for (int ks = 0; ks <= i; ++ks) Af[i][ks] = as_bf16x8(*(const u32x4*)(GMW + ((size_t)(h * CHUNK + 16 * (par + 2 * i) + fr)) * CHUNK + ks * 32 + fq * 8));
#pragma unroll
    for (int i = 0; i < 4; ++i) {
        const int R = par + 2 * i;
        f32x4 C[4];
#pragma unroll
        for (int ct = 0; ct < 4; ++ct) C[ct] = (f32x4){0.f, 0.f, 0.f, 0.f};
#pragma unroll
        for (int ks = 0; ks <= i; ++ks)
#pragma unroll
            for (int ct = 0; ct < 4; ++ct) C[ct] = MFMA16(Af[i][ks], Bf[ct][ks], C[ct]);
#pragma unroll
        for (int j = 0; j < 4; ++j) {
            const int t = 16 * R + fq * 4 + j; const float bs = w.gm_b_s[h * CHUNK + t];
#pragma unroll
            for (int ct = 0; ct < 4; ++ct) YT[t * YT_LD + h * 64 + ct * 16 + fr] = C[ct][j] + bs;
        }
    }
    __syncthreads();
    mix_final<true>(c, w, t0, 0, YN, Z);
}

__device__ __forceinline__ void mix_pool(const Ctx& c, const Lw& w, const bf16* Z, const bf16* POOLT, int t0, bf16* YN) {
    LAS unsigned char* lds = c.lds;
    const int pos0 = t0 % SEQ;
    constexpr int PA_OFF = 73728;
    {
        const int c8 = (c.tid & 31) * 8, r0 = c.tid >> 5;
        u32x4 zv[9];
#pragma unroll
        for (int it = 0; it < 9; ++it) { const int r = r0 + 16 * it; zv[it] = (u32x4){0u, 0u, 0u, 0u};
            if (r < 143 && pos0 + r - 15 >= 0) zv[it] = *(const u32x4*)(Z + (size_t)(t0 + r - 15) * DIN + 1024 + c8); }
#pragma unroll
        for (int it = 0; it < 9; ++it) { const int r = r0 + 16 * it; if (r < 143) *(LAS u32x4*)(lds + r * 512 + c8 * 2) = zv[it]; }
    }
    __syncthreads();
    {
        const int cp = c.tid & 127, tg = c.tid >> 7, W = 2 << (cp >> 5);
        float s0 = 0.f, s1 = 0.f;
        for (int i = 1; i < W; ++i) { const unsigned zv = *(const LAS unsigned*)(lds + (tg * 32 + 15 - i) * 512 + cp * 4); s0 += __uint_as_float(zv << 16); s1 += __uint_as_float(zv & 0xffff0000u); }
        for (int j = 0; j < 32; ++j) {
            const int tl = tg * 32 + j, pos = pos0 + tl;
            const unsigned zv = *(const LAS unsigned*)(lds + (tl + 15) * 512 + cp * 4);
            const float z0 = __uint_as_float(zv << 16), z1 = __uint_as_float(zv & 0xffff0000u);
            s0 += z0; s1 += z1;
            const float inv = __builtin_amdgcn_rcpf((float)((pos + 1 < W) ? pos + 1 : W));
            *(LAS unsigned*)(lds + PA_OFF + tl * (AT_LD * 2) + cp * 4) = pk2(s0 * inv - z0, s1 * inv - z1);
            const unsigned zo = *(const LAS unsigned*)(lds + (tl + 15 - (W - 1)) * 512 + cp * 4);
            s0 -= __uint_as_float(zo << 16); s1 -= __uint_as_float(zo & 0xffff0000u);
        }
    }
    __syncthreads();
    {
        const int fr = c.lane & 15, fq = c.lane >> 4, g = c.wave >> 1, cb = (c.wave & 1) * 2;
        f32x4 C[8][2];
#pragma unroll
        for (int rt = 0; rt < 8; ++rt) { C[rt][0] = (f32x4){0.f, 0.f, 0.f, 0.f}; C[rt][1] = (f32x4){0.f, 0.f, 0.f, 0.f}; }
        bf16x8 Bf[2][2];
#pragma unroll
        for (int ct = 0; ct < 2; ++ct)
#pragma unroll
            for (int ks = 0; ks < 2; ++ks) Bf[ct][ks] = as_bf16x8(*(const u32x4*)(POOLT + (size_t)(g * 64 + (cb + ct) * 16 + fr) * 64 + ks * 32 + fq * 8));
#pragma unroll
        for (int rt = 0; rt < 8; ++rt)
#pragma unroll
            for (int ks = 0; ks < 2; ++ks) {
                const bf16x8 Af = as_bf16x8(*(const LAS u32x4*)(lds + PA_OFF + (rt * 16 + fr) * (AT_LD * 2) + (g * 64 + ks * 32 + fq * 8) * 2));
                C[rt][0] = MFMA16(Af, Bf[0][ks], C[rt][0]); C[rt][1] = MFMA16(Af, Bf[1][ks], C[rt][1]);
            }
        __syncthreads();
        LAS float* YT = (LAS float*)lds;
#pragma unroll
        for (int ct = 0; ct < 2; ++ct) {
            const int ch = g * 64 + (cb + ct) * 16 + fr; const float sc = w.pool_scale[ch];
#pragma unroll
            for (int rt = 0; rt < 8; ++rt)
#pragma unroll
                for (int j = 0; j < 4; ++j) YT[(rt * 16 + fq * 4 + j) * YT_LD + ch] = C[rt][ct][j] * sc;
        }
    }
    __syncthreads();
    mix_final<false>(c, w, t0, 2, YN);
}

__device__ __forceinline__ void mix_sconv(const Ctx& c, const Lw& w, const bf16* Z, int t0, bf16* YN) {
    LAS float* YT = (LAS float*)c.lds;
    const int pos0 = t0 % SEQ;
#pragma unroll 1
    for (int task = c.tid; task < 1024; task += NT) {
        const int c8 = (task & 31) * 8, R0 = (task >> 5) * 4;
        u32x4 cv[6], hv[6], bv[4];
#pragma unroll
        for (int i = 0; i < 6; ++i) { cv[i] = (u32x4){0u, 0u, 0u, 0u}; hv[i] = (u32x4){0u, 0u, 0u, 0u};
            if (pos0 + R0 - 2 + i >= 0) { const size_t zr = (size_t)(t0 + R0 - 2 + i) * DIN; cv[i] = *(const u32x4*)(Z + zr + 1536 + c8); hv[i] = *(const u32x4*)(Z + zr + 1792 + c8); } }
#pragma unroll
        for (int j = 0; j < 4; ++j) bv[j] = *(const u32x4*)(Z + (size_t)(t0 + R0 + j) * DIN + 1280 + c8);
        float wk[3][8];
#pragma unroll
        for (int k = 0; k < 3; ++k) { const f32x4 w0 = *(const f32x4*)(w.sc_w + k * DG + c8), w1 = *(const f32x4*)(w.sc_w + k * DG + c8 + 4);
#pragma unroll
            for (int q = 0; q < 4; ++q) { wk[k][q] = w0[q]; wk[k][4 + q] = w1[q]; } }
        float p[6][8];
#pragma unroll
        for (int i = 0; i < 6; ++i)
#pragma unroll
            for (int q = 0; q < 4; ++q) { p[i][2 * q] = __uint_as_float(cv[i][q] << 16) * __uint_as_float(hv[i][q] << 16); p[i][2 * q + 1] = __uint_as_float(cv[i][q] & 0xffff0000u) * __uint_as_float(hv[i][q] & 0xffff0000u); }
#pragma unroll
        for (int j = 0; j < 4; ++j) {
            float o[8];
#pragma unroll
            for (int q = 0; q < 8; ++q) o[q] = wk[0][q] * p[j][q] + wk[1][q] * p[j + 1][q] + wk[2][q] * p[j + 2][q];
#pragma unroll
            for (int q = 0; q < 4; ++q) { o[2 * q] *= __uint_as_float(bv[j][q] << 16); o[2 * q + 1] *= __uint_as_float(bv[j][q] & 0xffff0000u); }
            *(LAS f32x4*)(YT + (R0 + j) * YT_LD + c8) = (f32x4){o[0], o[1], o[2], o[3]}; *(LAS f32x4*)(YT + (R0 + j) * YT_LD + c8 + 4) = (f32x4){o[4], o[5], o[6], o[7]};
        }
    }
    __syncthreads();
    mix_final<false>(c, w, t0, 3, YN);
}

__device__ __forceinline__ void mixer_phase(const Ctx& c0, const Lw& w, int l, const bf16* Z, const bf16* GMW, const bf16* PWT, const bf16* POOLT, bf16* YN) {
    for (int it = blockIdx.x; it < 512; it += gridDim.x) {
        Ctx c = c0; asm volatile("" : "+v"(c.tid)); c.lane = c.tid & 63;
        const int mx = it >> 7, t0 = (it & 127) * CHUNK;
        if (mx == 0) mix_conformer(c, w, Z, PWT + (size_t)l * DG * DG, t0, YN);
        else if (mx == 1) mix_gmlp(c, w, Z, GMW + (size_t)l * 4 * CHUNK * CHUNK, t0, YN);
        else if (mx == 2) mix_pool(c, w, Z, POOLT + (size_t)l * 4 * 64 * 64, t0, YN);
        else mix_sconv(c, w, Z, t0, YN);
        __syncthreads();
    }
}

struct EpiZ { bf16* Z; __device__ __forceinline__ void operator()(int r, int cc, f32x4 v) const { st_bf4(Z + (size_t)r * DIN + cc, v); } };
struct EpiU { float* U; const float* X; __device__ __forceinline__ void operator()(int r, int cc, f32x4 v) const { *(f32x4*)(U + (size_t)r * DM + cc) = v + ALPHA * *(const f32x4*)(X + (size_t)r * DM + cc); } };

__device__ __forceinline__ void ln1024(f32x4 (&v)[4], const float* g, const float* b, int lane) {
    float s = 0.f;
#pragma unroll
    for (int j = 0; j < 4; ++j) s += (v[j][0] + v[j][1]) + (v[j][2] + v[j][3]);
    const float mean = wave_sum(s) * (1.f / DM);
    float q = 0.f;
#pragma unroll
    for (int j = 0; j < 4; ++j) { v[j] = v[j] - mean; q += (v[j][0] * v[j][0] + v[j][1] * v[j][1]) + (v[j][2] * v[j][2] + v[j][3] * v[j][3]); }
    const float rstd = __builtin_amdgcn_rsqf(wave_sum(q) * (1.f / DM) + LN_EPS);
#pragma unroll
    for (int j = 0; j < 4; ++j) v[j] = v[j] * rstd * *(const f32x4*)(g + lane * 4 + 256 * j) + *(const f32x4*)(b + lane * 4 + 256 * j);
}
__device__ __forceinline__ void nv_ln1_router(const Ctx& c, const Lw& w, const float* U, float* X1, unsigned* RTE, float* RTG) {
    LAS float* RWt = (LAS float*)c.lds;
    __syncthreads();
#pragma unroll
    for (int h = 0; h < 2; ++h) { const int ch = c.tid + 512 * h;
#pragma unroll
        for (int e4 = 0; e4 < 4; ++e4) { const f32x4 ww = *(const f32x4*)(w.router_w + (size_t)ch * NE + e4 * 4);
#pragma unroll
            for (int q = 0; q < 4; ++q) RWt[(e4 * 4 + q) * DM + ch] = ww[q]; } }
    __syncthreads();
    for (int t = c.gw; t < M; t += c.ngw) {
        f32x4 v[4];
#pragma unroll
        for (int j = 0; j < 4; ++j) v[j] = *(const f32x4*)(U + (size_t)t * DM + c.lane * 4 + 256 * j);
        ln1024(v, w.ln1_g, w.ln1_b, c.lane);
#pragma unroll
        for (int j = 0; j < 4; ++j) *(f32x4*)(X1 + (size_t)t * DM + c.lane * 4 + 256 * j) = v[j];
        float lg[16];
        int lo = c.lane * 4; asm volatile("" : "+v"(lo));
#pragma unroll
        for (int e = 0; e < 16; ++e) {
            float a = 0.f;
#pragma unroll
            for (int j = 0; j < 4; ++j) { const f32x4 ww = *(const LAS f32x4*)(RWt + e * DM + lo + 256 * j); a += (v[j][0] * ww[0] + v[j][1] * ww[1]) + (v[j][2] * ww[2] + v[j][3] * ww[3]); }
            lg[e] = a;
        }
#pragma unroll
        for (int e = 0; e < 16; ++e) lg[e] = wave_sum(lg[e]);
        float best_score = 0.f; int best = -1;
#pragma unroll
        for (int g = 0; g < 4; ++g) {
            float m1 = -INFINITY, m2 = -INFINITY;
#pragma unroll
            for (int j = 0; j < 4; ++j) { const float s = lg[g * 4 + j] + w.router_b[g * 4 + j]; if (s > m1) { m2 = m1; m1 = s; } else if (s > m2) m2 = s; }
            const float sc = m1 + m2;
            if (best < 0 || sc > best_score) { best_score = sc; best = g; }
        }
        float s1 = -INFINITY, s2 = -INFINITY, l1 = 0.f, l2 = 0.f; int i1 = 0, i2 = 0;
#pragma unroll
        for (int e = 0; e < 16; ++e) {
            if ((e >> 2) == best) { const float s = lg[e] + w.router_b[e];
                if (s > s1) { s2 = s1; i2 = i1; l2 = l1; s1 = s; i1 = e; l1 = lg[e]; } else if (s > s2) { s2 = s; i2 = e; l2 = lg[e]; } }
        }
        const float mx = fmaxf(l1, l2), e1 = __expf(l1 - mx), e2 = __expf(l2 - mx), inv = 1.0f / (e1 + e2);
        if (c.lane == 0) { RTE[t] = (unsigned)i1 | ((unsigned)i2 << 8); RTG[2 * t] = e1 * inv; RTG[2 * t + 1] = e2 * inv; }
    }
}
constexpr int CW_CNT = 8192;
__device__ __forceinline__ void moe_ranks(const Ctx& c, const unsigned* RTE, int* RTP, unsigned* CNT) {
    LAS int* LC = (LAS int*)c.lds;
    __syncthreads();
    if (c.tid < 32) LC[c.tid] = 0;
    __syncthreads();
    for (int t = c.gw; t < M; t += c.ngw) {
        if (c.lane == 0) { const unsigned ee = RTE[t]; RTP[2 * t] = __hip_atomic_fetch_add(&LC[ee & 0xff], 1, __ATOMIC_RELAXED, __HIP_MEMORY_SCOPE_WORKGROUP); RTP[2 * t + 1] = __hip_atomic_fetch_add(&LC[(ee >> 8) & 0xff], 1, __ATOMIC_RELAXED, __HIP_MEMORY_SCOPE_WORKGROUP); }
    }
    __syncthreads();
    if (c.tid < 16) LC[16 + c.tid] = (int)atomicAdd(&CNT[c.tid], (unsigned)LC[c.tid]);
    __syncthreads();
    for (int t = c.gw; t < M; t += c.ngw) {
        if (c.lane == 0) { const unsigned ee = RTE[t]; RTP[2 * t] += LC[16 + (ee & 0xff)]; RTP[2 * t + 1] += LC[16 + ((ee >> 8) & 0xff)]; }
    }
}
constexpr int LDS_TAB_OFF = 131072;
__device__ __forceinline__ void moe_tiles(const Ctx& c, const unsigned* CNT) {
    LAS int* ts = (LAS int*)(c.lds + LDS_TAB_OFF);
    __syncthreads();
    if (c.tid < 17) { int s = 0; for (int e = 0; e < c.tid; ++e) s += (int)((CNT[e] + 255u) >> 8); ts[c.tid] = s; }
    __syncthreads();
}
__device__ __forceinline__ void moe_gather(const Ctx& c, const float* X1, const unsigned* RTE, int* RTP, const unsigned* CNT, bf16* XG) {
    LAS int* RS = (LAS int*)c.lds;
    __syncthreads();
    if (c.tid < 16) { int s = 0; for (int e = 0; e < c.tid; ++e) s += (int)((CNT[e] + 255u) >> 8); RS[c.tid] = s * 256; }
    __syncthreads();
    for (int p = c.gw; p < 2 * M; p += c.ngw) {
        const int t = p >> 1, k = p & 1;
        const int e = (RTE[t] >> (8 * k)) & 0xff;
        const int slot = RS[e] + RTP[p];
        f32x4 v[4];
#pragma unroll
        for (int j = 0; j < 4; ++j) v[j] = *(const f32x4*)(X1 + (size_t)t * DM + c.lane * 4 + 256 * j);
#pragma unroll
        for (int j = 0; j < 4; ++j) st_bf4(XG + (size_t)slot * DM + c.lane * 4 + 256 * j, v[j]);
        asm volatile("" ::: "memory");
        if (c.lane == 0) RTP[p] = slot;
    }
}
__device__ __forceinline__ void moe_combine_ln2(const Ctx& c, const Lw& w, const float* X1, const bf16* YS, const float* RTG, const int* RTP, float* X2, bf16* XB) {
    for (int t = c.gw; t < M; t += c.ngw) {
        const int s0 = RTP[2 * t], s1 = RTP[2 * t + 1]; const float g0 = RTG[2 * t], g1 = RTG[2 * t + 1];
        f32x4 v[4];
#pragma unroll
        for (int j = 0; j < 4; ++j) {
            const int col = c.lane * 4 + 256 * j;
            v[j] = ALPHA * *(const f32x4*)(X1 + (size_t)t * DM + col) + g0 * ld_bf4(YS + (size_t)s0 * DM + col) + g1 * ld_bf4(YS + (size_t)s1 * DM + col);
        }
        ln1024(v, w.ln2_g, w.ln2_b, c.lane);
#pragma unroll
        for (int j = 0; j < 4; ++j) { *(f32x4*)(X2 + (size_t)t * DM + c.lane * 4 + 256 * j) = v[j]; st_bf4(XB + (size_t)t * DM + c.lane * 4 + 256 * j, v[j]); }
    }
}

__device__ __forceinline__ void nv_moe(const Ctx& c, const Lw& w, const float* X1, const unsigned* RTE, const float* RTG, float* F) {
    LAS float* xs = (LAS float*)c.lds; LAS float* hs = xs + DM;
    for (int t = blockIdx.x; t < M; t += gridDim.x) {
        __syncthreads();
        xs[c.tid] = X1[(size_t)t * DM + c.tid]; xs[c.tid + 512] = X1[(size_t)t * DM + c.tid + 512];
        __syncthreads();
        const unsigned ee = RTE[t]; float f0 = 0.f, f1 = 0.f;
        for (int k = 0; k < 2; ++k) {
            const int e = (ee >> (8 * k)) & 0xff; const float gk = RTG[2 * t + k];
            const float* wg = w.wg + (size_t)e * DM * DE + c.tid; const float* wu = w.wu + (size_t)e * DM * DE + c.tid;
            float ga = 0.f, ua = 0.f;
            for (int i = 0; i < DM; ++i) { const float xv = xs[i]; ga += xv * wg[(size_t)i * DE]; ua += xv * wu[(size_t)i * DE]; }
            __syncthreads();
            hs[c.tid] = siluf_(ga) * ua;
            __syncthreads();
            const float* wd = w.wd + (size_t)e * DE * DM + c.tid;
            float y0 = 0.f, y1 = 0.f;
            for (int i = 0; i < DE; ++i) { const float hv = hs[i]; y0 += hv * wd[(size_t)i * DM]; y1 += hv * wd[(size_t)i * DM + 512]; }
            f0 += gk * y0; f1 += gk * y1;
        }
        F[(size_t)t * DM + c.tid] = f0; F[(size_t)t * DM + c.tid + 512] = f1;
    }
}
__device__ __forceinline__ void nv_ln2(const Ctx& c, const Lw& w, const float* X1, const float* F, float* X2, bf16* XB) {
    for (int t = c.gw; t < M; t += c.ngw) {
        f32x4 v[4];
#pragma unroll
        for (int j = 0; j < 4; ++j) v[j] = ALPHA * *(const f32x4*)(X1 + (size_t)t * DM + c.lane * 4 + 256 * j) + *(const f32x4*)(F + (size_t)t * DM + c.lane * 4 + 256 * j);
        ln1024(v, w.ln2_g, w.ln2_b, c.lane);
#pragma unroll
        for (int j = 0; j < 4; ++j) { *(f32x4*)(X2 + (size_t)t * DM + c.lane * 4 + 256 * j) = v[j]; st_bf4(XB + (size_t)t * DM + c.lane * 4 + 256 * j, v[j]); }
    }
}

namespace pg8 {
#define PG8_LAS __attribute__((address_space(3)))
typedef unsigned short bf16_t;
typedef short bf16x8 __attribute__((ext_vector_type(8)));
typedef float f32x4 __attribute__((ext_vector_type(4)));
typedef unsigned u32x4 __attribute__((ext_vector_type(4)));
constexpr int BM = 256, BK = 64, HALF = 128, HTB = HALF * BK * 2  , STAGE_BYTES = 8 * HTB, NXCD = 8, WGM = 8;

__host__ __device__ __forceinline__ int lds_byte(int r, int c) { const int st = (r >> 4) * 2 + (c >> 5), rr = r & 15, cc = c & 31, ob = rr * 64 + cc * 2; return st * 1024 + (ob ^ (((ob >> 9) & 1) << 5)); }
__host__ __device__ __forceinline__ void stage_rc(int b, int& R, int& C) { const int st = b / 1024, sb = b % 1024, swz = sb ^ (((sb >> 9) & 1) << 5); R = (st >> 1) * 16 + swz / 64; C = (st & 1) * 32 + (swz % 64) / 2; }
__host__ __device__ __forceinline__ int perm32(int rho) { const int n = rho >> 4, i = rho & 15; return 8 * (i >> 2) + 4 * n + (i & 3); }

struct Unit { int pm, pn; };
struct Gemm { const bf16_t* A; const bf16_t* Bt; int M, N, K; };

struct StaticOrder {
    int nM, nN, nwg, G, c;
    __host__ __device__ void init(int M, int N, int G_, int c_) { nM = M / BM; nN = N / BM; nwg = nM * nN; G = G_; c = c_; }
    __host__ __device__ bool next(int i, Unit& u) const {
        const long L = (long)i * G + c; if (L >= nwg) return false;
        int wgid = (int)L; { const int q = nwg / NXCD, r = nwg % NXCD, xcd = wgid % NXCD, off = wgid / NXCD; wgid = (xcd < r ? xcd * (q + 1) : r * (q + 1) + (xcd - r) * q) + off; }
        const int nig = WGM * nN, gid = wgid / nig, fm = gid * WGM, gsz = (nM - fm) < WGM ? (nM - fm) : WGM;
        u.pm = fm + ((wgid % nig) % gsz); u.pn = (wgid % nig) / gsz; return true;
    }
    __device__ __forceinline__ void a_ready(const Unit&) const {}
    __device__ __forceinline__ void done(const Unit&) const {}
};

__device__ __forceinline__ unsigned cvt_pk_bf16(float lo, float hi) { unsigned r; asm volatile("v_cvt_pk_bf16_f32 %0, %1, %2" : "=v"(r) : "v"(lo), "v"(hi)); return r; }
typedef float f32x2 __attribute__((ext_vector_type(2)));
__device__ __forceinline__ f32x2 gelu_pk(f32x2 v) {
    const f32x2 av = __builtin_elementwise_abs(v), d = av * 0.2316418882f + 1.0f;
    f32x2 t; t.x = __builtin_amdgcn_rcpf(d.x); t.y = __builtin_amdgcn_rcpf(d.y);
    f32x2 q = t * 0.5307027145f + (-0.7265760135f); q = q * t + 0.7107068705f; q = q * t + (-0.142248368f); q = q * t + 0.127414796f; q = q * t;
    const f32x2 s = (v * v) * (-0.72134752044f);
    f32x2 e; e.x = __builtin_amdgcn_exp2f(s.x); e.y = __builtin_amdgcn_exp2f(s.y);
    const f32x2 m = v * (q * e), r = v - m;
    f32x2 o; o.x = v.x < 0.f ? m.x : r.x; o.y = v.y < 0.f ? m.y : r.y; return o;
}

template <int ACT  > struct EpiBf16 {
    static constexpr bool PERM = true, AFTER_DRAIN = false; static_assert(ACT == 0 || ACT == 1, "EpiBf16: ACT is 0 (none) or 1 (gelu_pk)");
    bf16_t* O; int ldc; const float* bias; int split_cols; size_t split_stride; float scale0; int pn_mask;
    __device__ __forceinline__ void operator()(const f32x4 (&acc)[2][2][4][2], const Unit& u, int wr, int wc, int fr, int fq) const {
        const int row0 = u.pm * BM + wr * 64 + fr; int colt = (u.pn & pn_mask) * BM; bf16_t* base = O;
        float sc = 1.f; if (split_cols) { const int t = colt / split_cols; base += (size_t)t * split_stride; colt -= t * split_cols; if (t == 0) sc = scale0; }
        const int col0 = colt + wc * 32 + 8 * fq, bcol0 = (u.pn & pn_mask) * BM + wc * 32 + 8 * fq;
        f32x4 bv[2][2];
#pragma unroll
        for (int bj = 0; bj < 2; ++bj)
#pragma unroll
            for (int n = 0; n < 2; ++n) bv[bj][n] = bias ? *(const f32x4*)(bias + bcol0 + bj * HALF + 4 * n) : (f32x4){0.f, 0.f, 0.f, 0.f};
#pragma unroll
        for (int ai = 0; ai < 2; ++ai)
#pragma unroll
            for (int m = 0; m < 4; ++m) { bf16_t* rowp = base + (size_t)(row0 + ai * HALF + m * 16) * ldc + col0;
#pragma unroll
                for (int bj = 0; bj < 2; ++bj) { f32x4 v0 = acc[ai][bj][m][0] + bv[bj][0], v1 = acc[ai][bj][m][1] + bv[bj][1];
                    if (ACT == 1) { f32x2 a = gelu_pk((f32x2){v0[0], v0[1]}), b = gelu_pk((f32x2){v0[2], v0[3]}), c = gelu_pk((f32x2){v1[0], v1[1]}), d = gelu_pk((f32x2){v1[2], v1[3]});
                        v0 = (f32x4){a.x, a.y, b.x, b.y}; v1 = (f32x4){c.x, c.y, d.x, d.y}; }
                    v0 = v0 * sc; v1 = v1 * sc; u32x4 w; w.x = cvt_pk_bf16(v0[0], v0[1]); w.y = cvt_pk_bf16(v0[2], v0[3]); w.z = cvt_pk_bf16(v1[0], v1[1]); w.w = cvt_pk_bf16(v1[2], v1[3]);
                    *(u32x4*)(rowp + bj * HALF) = w; } }
    }
};


struct EpiResF32 {
    static constexpr bool PERM = false, AFTER_DRAIN = false;
    const float* X; float* U; float alpha;
    __device__ __forceinline__ void operator()(const f32x4 (&acc)[2][2][4][2], const Unit& u, int wr, int wc, int fr, int fq) const {
        const int col0 = u.pn * BM + wc * 32 + 4 * fq;
#pragma unroll
        for (int ai = 0; ai < 2; ++ai)
#pragma unroll
            for (int m = 0; m < 4; ++m) { const size_t off = (size_t)(u.pm * BM + ai * HALF + wr * 64 + m * 16 + fr) * 1024 + col0;
#pragma unroll
                for (int bj = 0; bj < 2; ++bj)
#pragma unroll
                    for (int n = 0; n < 2; ++n) *(f32x4*)(U + off + bj * HALF + n * 16) = acc[ai][bj][m][n] + alpha * *(const f32x4*)(X + off + bj * HALF + n * 16); }
    }
};

struct MoeOrder {
    const PG8_LAS int* ts; int G, c;
    __device__ __forceinline__ bool next(int i, Unit& u) const {
        const int L = i * G + c; if (L >= __builtin_amdgcn_readfirstlane(ts[16]) * 4) return false;
        const int rt = L >> 2; int e = 0;
#pragma unroll
        for (int k = 1; k < 16; ++k) e += (rt >= ts[k]) ? 1 : 0;
        u.pm = rt; u.pn = __builtin_amdgcn_readfirstlane(e) * 4 + (L & 3); return true;
    }
    __device__ __forceinline__ void a_ready(const Unit&) const {}
    __device__ __forceinline__ void done(const Unit&) const {}
};
struct EpiSwiGLU {
    static constexpr bool PERM = true, AFTER_DRAIN = false;
    bf16_t* H;
    __device__ __forceinline__ void operator()(const f32x4 (&acc)[2][2][4][2], const Unit& u, int wr, int wc, int fr, int fq) const {
        const int row0 = u.pm * BM + wr * 64 + fr, col0 = (u.pn & 3) * HALF + wc * 32 + 8 * fq;
#pragma unroll
        for (int ai = 0; ai < 2; ++ai)
#pragma unroll
            for (int m = 0; m < 4; ++m) {
                u32x4 w4;
#pragma unroll
                for (int n = 0; n < 2; ++n) {
                    const f32x4 g = acc[ai][0][m][n], up = acc[ai][1][m][n]; f32x4 h;
#pragma unroll
                    for (int q = 0; q < 4; ++q) h[q] = g[q] * __builtin_amdgcn_rcpf(1.0f + __builtin_amdgcn_exp2f(-1.44269504089f * g[q])) * up[q];
                    w4[2 * n] = cvt_pk_bf16(h[0], h[1]); w4[2 * n + 1] = cvt_pk_bf16(h[2], h[3]);
                }
                *(u32x4*)(H + (size_t)(row0 + ai * HALF + m * 16) * 512 + col0) = w4;
            }
    }
};
template <class Epi, class Sched, bool ALIGN_EPI = false, bool SP2 = false>
__device__ __forceinline__ void gemm_phase(PG8_LAS unsigned char* lds, const Gemm g, const Sched& S, const Epi& E, const int tid) {
    const int wid = __builtin_amdgcn_readfirstlane(tid >> 6), lane = tid & 63, wr = wid >> 2, wc = wid & 3, fr = lane & 15, fq = lane >> 4;
    const int K = g.K, nt = K / BK;
    unsigned voffA[2], voffB[2];
#pragma unroll
    for (int i = 0; i < 2; ++i) { int R, C; stage_rc(tid * 16 + i * 8192, R, C); const int Rb = Epi::PERM ? ((R & ~31) + perm32(R & 31)) : R;
        voffA[i] = (unsigned)(R * K + C) * 2u; voffB[i] = (unsigned)(Rb * K + C) * 2u; }
    const size_t kstep = (size_t)(BK * 2);
    const size_t hstep = (size_t)HALF * K * 2;
    const size_t tstep = 2 * hstep;
    const unsigned ldsw = (unsigned)wid * 1024u;
    const int aoff = lds_byte(wr * 64 + fr, fq * 8), boff = lds_byte(wc * 32 + fr, fq * 8);
#define PG8_SA(b, h) (((b) * 2 + (h)) * HTB)
#define PG8_SB(b, h) ((4 + (b) * 2 + (h)) * HTB)
#define PG8_STAGE(bufoff, gbase, voff) do { _Pragma("unroll") for (int _i = 0; _i < 2; ++_i) \
        __builtin_amdgcn_global_load_lds((const unsigned*)((const char*)(gbase) + (voff)[_i]), (PG8_LAS unsigned*)(lds + (bufoff) + ldsw + _i * 8192), 16, 0, 0); } while (0)
#define PG8_LDA(dst, b, h) do { _Pragma("unroll") for (int m = 0; m < 4; ++m) _Pragma("unroll") for (int k = 0; k < 2; ++k) dst[m][k] = *(const PG8_LAS bf16x8*)(lds + PG8_SA(b, h) + aoff + m * 2048 + k * 1024); } while (0)
#define PG8_LDB(dst, b, h) do { _Pragma("unroll") for (int n = 0; n < 2; ++n) _Pragma("unroll") for (int k = 0; k < 2; ++k) dst[n][k] = *(const PG8_LAS bf16x8*)(lds + PG8_SB(b, h) + boff + n * 2048 + k * 1024); } while (0)
#define PG8_MMA(ai, bj, At, Bt) do { __builtin_amdgcn_s_setprio(1); _Pragma("unroll") for (int m = 0; m < 4; ++m) _Pragma("unroll") for (int n = 0; n < 2; ++n) _Pragma("unroll") for (int k = 0; k < 2; ++k) \
        acc[ai][bj][m][n] = __builtin_amdgcn_mfma_f32_16x16x32_bf16(Bt[n][k], At[m][k], acc[ai][bj][m][n], 0, 0, 0); __builtin_amdgcn_s_setprio(0); } while (0)
#define PG8_WAIT_V(n) asm volatile("s_waitcnt vmcnt(" #n ")" ::: "memory")
#define PG8_WAIT_L(n) asm volatile("s_waitcnt lgkmcnt(" #n ")" ::: "memory")
#define PG8_BAR __builtin_amdgcn_s_barrier()
#define PG8_SCHED __builtin_amdgcn_sched_barrier(0)
    Unit cur, nxt; int ui = 0;
    if (!S.next(0, cur)) return;
    f32x4 acc[2][2][4][2];
#pragma unroll
    for (int a = 0; a < 2; ++a)
#pragma unroll
        for (int b = 0; b < 2; ++b)
#pragma unroll
            for (int m = 0; m < 4; ++m)
#pragma unroll
                for (int n = 0; n < 2; ++n) acc[a][b][m][n] = (f32x4){0.f, 0.f, 0.f, 0.f};
    bf16x8 At[4][2], B0[2][2], B1[2][2];
    const char* cA = (const char*)g.A + (size_t)cur.pm * tstep; const char* cB = (const char*)g.Bt + (size_t)cur.pn * tstep;
    S.a_ready(cur);
    if constexpr (SP2) {
        PG8_STAGE(PG8_SB(0, 0), cB, voffB); PG8_STAGE(PG8_SB(0, 1), cB + hstep, voffB); PG8_STAGE(PG8_SA(0, 0), cA, voffA); PG8_STAGE(PG8_SA(0, 1), cA + hstep, voffA);
        if (wr == 1) PG8_BAR;
        PG8_WAIT_V(2); PG8_BAR;
        PG8_STAGE(PG8_SB(1, 0), cB + kstep, voffB); PG8_STAGE(PG8_SA(1, 0), cA + kstep, voffA); PG8_STAGE(PG8_SB(1, 1), cB + hstep + kstep, voffB);
        PG8_WAIT_V(6); PG8_BAR;
    } else {
        PG8_STAGE(PG8_SB(0, 0), cB, voffB); PG8_STAGE(PG8_SA(0, 0), cA, voffA); PG8_STAGE(PG8_SB(0, 1), cB + hstep, voffB); PG8_STAGE(PG8_SA(0, 1), cA + hstep, voffA);
        if (wr == 1) PG8_BAR;
        PG8_WAIT_V(4); PG8_BAR;
        PG8_STAGE(PG8_SB(1, 0), cB + kstep, voffB); PG8_STAGE(PG8_SA(1, 0), cA + kstep, voffA); PG8_STAGE(PG8_SB(1, 1), cB + hstep + kstep, voffB);
        PG8_WAIT_V(6); PG8_BAR;
    }
    for (;;) {
        const bool has_next = S.next(ui + 1, nxt);
        const char* nA = has_next ? (const char*)g.A + (size_t)nxt.pm * tstep : cA; const char* nB = has_next ? (const char*)g.Bt + (size_t)nxt.pn * tstep : cB;
        for (int t = 0; t < nt; t += 2) {
            const bool last = (t == nt - 2);
            const char* a1 = cA + (size_t)(t + 1) * kstep;
            const char* a2 = last ? nA : cA + (size_t)(t + 2) * kstep; const char* b2 = last ? nB : cB + (size_t)(t + 2) * kstep;
            const char* a3 = a2 + kstep; const char* b3 = b2 + kstep;
            if (last && has_next) S.a_ready(nxt);
            if constexpr (SP2) {
            PG8_LDB(B0, 0, 0); PG8_LDB(B1, 0, 1); PG8_SCHED; PG8_LDA(At, 0, 0); PG8_STAGE(PG8_SA(1, 1), a1 + hstep, voffA);
            PG8_WAIT_V(8); PG8_WAIT_L(0); PG8_BAR; PG8_MMA(0, 0, At, B0); PG8_MMA(0, 1, At, B1); PG8_BAR; PG8_SCHED;
            PG8_LDA(At, 0, 1); PG8_STAGE(PG8_SB(0, 0), b2, voffB); PG8_STAGE(PG8_SB(0, 1), b2 + hstep, voffB); PG8_STAGE(PG8_SA(0, 0), a2, voffA);
            PG8_WAIT_V(8); PG8_WAIT_L(0); PG8_BAR; PG8_MMA(1, 0, At, B0); PG8_MMA(1, 1, At, B1); PG8_BAR; PG8_SCHED;
            PG8_LDB(B0, 1, 0); PG8_LDB(B1, 1, 1); PG8_SCHED; PG8_LDA(At, 1, 0); PG8_STAGE(PG8_SA(0, 1), a2 + hstep, voffA);
            PG8_WAIT_V(8); PG8_WAIT_L(0); PG8_BAR; PG8_MMA(0, 0, At, B0); PG8_MMA(0, 1, At, B1); PG8_BAR; PG8_SCHED;
            PG8_LDA(At, 1, 1); PG8_STAGE(PG8_SB(1, 0), b3, voffB); PG8_STAGE(PG8_SB(1, 1), b3 + hstep, voffB); PG8_STAGE(PG8_SA(1, 0), a3, voffA);
            PG8_WAIT_V(8); PG8_WAIT_L(0); PG8_BAR; PG8_MMA(1, 0, At, B0); PG8_MMA(1, 1, At, B1); PG8_BAR; PG8_SCHED;
            } else {
            PG8_LDB(B0, 0, 0); PG8_SCHED; PG8_LDA(At, 0, 0); PG8_STAGE(PG8_SA(1, 1), a1 + hstep, voffA);
            PG8_WAIT_L(8); PG8_BAR; PG8_WAIT_L(0); PG8_MMA(0, 0, At, B0); PG8_BAR; PG8_SCHED;
            PG8_LDB(B1, 0, 1); PG8_STAGE(PG8_SB(0, 0), b2, voffB);
            PG8_BAR; PG8_WAIT_L(0); PG8_MMA(0, 1, At, B1); PG8_BAR;
            PG8_LDA(At, 0, 1); PG8_STAGE(PG8_SA(0, 0), a2, voffA);
            PG8_BAR; PG8_WAIT_L(0); PG8_MMA(1, 0, At, B0); PG8_BAR; PG8_SCHED;
            PG8_STAGE(PG8_SB(0, 1), b2 + hstep, voffB);
            PG8_WAIT_V(6); PG8_BAR; PG8_MMA(1, 1, At, B1); PG8_BAR;
            PG8_LDB(B0, 1, 0); PG8_SCHED; PG8_LDA(At, 1, 0); PG8_STAGE(PG8_SA(0, 1), a2 + hstep, voffA);
            PG8_WAIT_L(8); PG8_BAR; PG8_WAIT_L(0); PG8_MMA(0, 0, At, B0); PG8_BAR; PG8_SCHED;
            PG8_LDB(B1, 1, 1); PG8_STAGE(PG8_SB(1, 0), b3, voffB);
            PG8_BAR; PG8_WAIT_L(0); PG8_MMA(0, 1, At, B1); PG8_BAR;
            PG8_LDA(At, 1, 1); PG8_STAGE(PG8_SA(1, 0), a3, voffA);
            PG8_BAR; PG8_WAIT_L(0); PG8_MMA(1, 0, At, B0); PG8_BAR; PG8_SCHED;
            PG8_STAGE(PG8_SB(1, 1), b3 + hstep, voffB);
            PG8_WAIT_V(6); PG8_BAR; PG8_MMA(1, 1, At, B1); PG8_BAR;
            }
        }
        if constexpr (ALIGN_EPI) { if (wr == 0) PG8_BAR; }
        if constexpr (!Epi::AFTER_DRAIN) { E(acc, cur, wr, wc, fr, fq); S.done(cur); }
        if (!has_next) break;
#pragma unroll
        for (int a = 0; a < 2; ++a)
#pragma unroll
            for (int b = 0; b < 2; ++b)
#pragma unroll
                for (int m = 0; m < 4; ++m)
#pragma unroll
                    for (int n = 0; n < 2; ++n) acc[a][b][m][n] = (f32x4){0.f, 0.f, 0.f, 0.f};
        cur = nxt; cA = nA; cB = nB; ++ui;
        if constexpr (ALIGN_EPI) { if (wr == 1) PG8_BAR; }
    }
    PG8_WAIT_V(0);
    if constexpr (!ALIGN_EPI) { if (wr == 0) PG8_BAR; }
    PG8_BAR;
    if constexpr (Epi::AFTER_DRAIN) { E.fused(acc, cur, wr, wc, fr, fq, lds, wid, lane); S.done(cur); }
#undef PG8_SA
#undef PG8_SB
#undef PG8_STAGE
#undef PG8_LDA
#undef PG8_LDB
#undef PG8_MMA
#undef PG8_WAIT_V
#undef PG8_WAIT_L
#undef PG8_BAR
#undef PG8_SCHED
}
}


struct TItem { const float* src; bf16* dst; int N, K; };
__device__ __forceinline__ TItem titem(const Args& a, unsigned char* ws, int it) {
    constexpr int I_IN = NL * 16 * 64, I_O = NL * 16 * 32, I_G = NL * NE * 16 * 16;
    TItem t; int r = it;
    if (r < I_IN) { const int l = r >> 10, kb = (r >> 6) & 15, nb = r & 63; t.N = DIN; t.K = DM; t.src = a.in[1] + (size_t)l * DM * DIN + (size_t)(kb * 64) * DIN + nb * 32; t.dst = (bf16*)(ws + WS_WIN) + (size_t)(l * DIN + nb * 32) * DM + kb * 64; return t; } r -= I_IN;
    if (r < I_O) { const int l = r >> 9, kb = (r >> 5) & 15, nb = r & 31; t.N = DM; t.K = DM; t.src = a.in[15] + (size_t)l * DM * DM + (size_t)(kb * 64) * DM + nb * 32; t.dst = (bf16*)(ws + WS_WO) + (size_t)(l * DM + nb * 32) * DM + kb * 64; return t; } r -= I_O;
    if (r < 2 * I_G) { const int up = r >= I_G; if (up) r -= I_G; const int le = r >> 8, kb = (r >> 4) & 15, nb = r & 15, n0 = nb * 32;
        t.N = DE; t.K = DM; t.src = a.in[up ? 21 : 20] + (size_t)le * DM * DE + (size_t)(kb * 64) * DE + n0; t.dst = (bf16*)(ws + WS_WGU) + (size_t)(le * 1024 + (n0 >> 7) * 256 + (n0 & 127) + up * 128) * DM + kb * 64; return t; } r -= 2 * I_G;
    { const int le = r >> 8, kb = (r >> 5) & 7, nb = r & 31; t.N = DM; t.K = DE; t.src = a.in[22] + (size_t)le * DE * DM + (size_t)(kb * 64) * DM + nb * 32; t.dst = (bf16*)(ws + WS_WD) + (size_t)(le * 1024 + nb * 32) * DE + kb * 64; }
    return t;
}
__device__ __forceinline__ void titem_load(const TItem& t, float (&tv)[32], int lane) {
#pragma unroll
    for (int i = 0; i < 32; ++i) tv[i] = t.src[(size_t)(2 * i + (lane >> 5)) * t.N + (lane & 31)];
}
__device__ __forceinline__ void titem_store(const TItem& t, const float (&tv)[32], LAS float* scr, int lane) {
#pragma unroll
    for (int i = 0; i < 32; ++i) scr[(2 * i + (lane >> 5)) * 33 + (lane & 31)] = tv[i];
    asm volatile("s_waitcnt lgkmcnt(0)" ::: "memory");
    const int cc = lane & 7;
#pragma unroll
    for (int j = 0; j < 4; ++j) { const int n = (lane >> 3) + 8 * j; const LAS float* s = scr + (8 * cc) * 33 + n;
        u32x4 o; o.x = pk2(s[0 * 33], s[1 * 33]); o.y = pk2(s[2 * 33], s[3 * 33]); o.z = pk2(s[4 * 33], s[5 * 33]); o.w = pk2(s[6 * 33], s[7 * 33]);
        *(u32x4*)(t.dst + (size_t)n * t.K + 8 * cc) = o; }
    asm volatile("s_waitcnt lgkmcnt(0)" ::: "memory");
}
__device__ __forceinline__ void weights_prologue(const Ctx& c, const Args& a, unsigned char* ws) {
    LAS float* scr = (LAS float*)(c.lds + c.wave * 16384);
    constexpr int NITEMS = NL * 16 * 64 + NL * 16 * 32 + 2 * NL * NE * 16 * 16 + NL * NE * 8 * 32;
    int it = c.gw;
    if (it >= NITEMS) return;
    float tvA[32], tvB[32];
    TItem A = titem(a, ws, it), B = A;
    titem_load(A, tvA, c.lane);
    for (;;) {
        const bool hasB = it + c.ngw < NITEMS;
        if (hasB) { B = titem(a, ws, it + c.ngw); titem_load(B, tvB, c.lane); }
        titem_store(A, tvA, scr, c.lane);
        if (!hasB) break;
        it += 2 * c.ngw;
        const bool hasA = it < NITEMS;
        if (hasA) { A = titem(a, ws, it); titem_load(A, tvA, c.lane); }
        titem_store(B, tvB, scr, c.lane);
        if (!hasA) break;
    }
}

constexpr int PH_PER_LAYER = 8, N_PHASES = 1 + NL * PH_PER_LAYER;
struct Ptrs { bf16 *Z, *XB, *YN, *XG, *YS, *H, *GMW, *PWT, *POOLT; float *U, *RTG; unsigned* RTE; int* RTP; };
__device__ __forceinline__ Ptrs make_ptrs(unsigned char* ws) {
    Ptrs p;
    p.Z = (bf16*)(ws + WS_Z); p.XB = (bf16*)(ws + WS_XB); p.YN = (bf16*)(ws + WS_YN); p.U = (float*)(ws + WS_U); p.XG = (bf16*)(ws + WS_A); p.YS = (bf16*)(ws + WS_A); p.H = (bf16*)(ws + WS_H);
    p.GMW = (bf16*)(ws + WS_GMW); p.PWT = (bf16*)(ws + WS_PWT); p.POOLT = (bf16*)(ws + WS_POOLT);
    p.RTE = (unsigned*)(ws + WS_RT); p.RTG = (float*)(ws + WS_RT + 256 * 1024); p.RTP = (int*)(ws + WS_RT + 512 * 1024);
    return p;
}
template <int L>
__device__ __forceinline__ void run_layer(const Args& args, const Ctx& c0, const XcdBarrier& bar, const bool one, const int lo, const int hi) {
    constexpr int PB = 1 + L * PH_PER_LAYER;
    unsigned char* ws = args.ws;
    const Ptrs P = make_ptrs(ws);
    const float* X = (L == 0) ? args.in[0] : args.out;
    unsigned* CNT = (unsigned*)ws + CW_CNT + 64 * L;
#define IN(k) (lo <= PB + (k) && PB + (k) < hi)
#define PHASE_CTX Ctx c = c0; asm volatile("" : "+v"(c.tid)); c.lane = c.tid & 63; c.gtid = blockIdx.x * NT + c.tid
#define SEAM(k) do { if (one && PB + (k) + 1 < hi) xcd_barrier(bar); } while (0)
    if (IN(0)) { PHASE_CTX; pg8::Gemm g{P.XB, (const bf16*)(ws + WS_WIN) + (size_t)L * DIN * DM, M, DIN, DM}; pg8::StaticOrder S; S.init(M, DIN, (int)gridDim.x, (int)blockIdx.x);
        pg8::EpiBf16<0> E{P.Z, DIN, nullptr, 0, 0, 1.f, 0xffff};
        pg8::gemm_phase<pg8::EpiBf16<0>, pg8::StaticOrder, true, true>(c.lds, g, S, E, c.tid); SEAM(0); }
    if (IN(1)) { PHASE_CTX; const Lw w = layer_weights(args, L); for (int r = 0; r < RPT_MIX; ++r) mixer_phase(c, w, L, P.Z, P.GMW, P.PWT, P.POOLT, P.YN); SEAM(1); }
    if (IN(2)) { PHASE_CTX; pg8::Gemm g{P.YN, (const bf16*)(ws + WS_WO) + (size_t)L * DM * DM, M, DM, DM}; pg8::StaticOrder S; S.init(M, DM, (int)gridDim.x, (int)blockIdx.x);
        pg8::EpiResF32 E{X, P.U, ALPHA};
        pg8::gemm_phase<pg8::EpiResF32, pg8::StaticOrder, true, true>(c.lds, g, S, E, c.tid); SEAM(2); }
    if (IN(3)) { PHASE_CTX; const Lw w = layer_weights(args, L); for (int r = 0; r < RPT_LN1; ++r) nv_ln1_router(c, w, P.U, args.out, P.RTE, P.RTG); moe_ranks(c, P.RTE, P.RTP, CNT); SEAM(3); }
    if (IN(4)) { PHASE_CTX; moe_gather(c, args.out, P.RTE, P.RTP, CNT, P.XG); SEAM(4); }
    if (IN(5)) { PHASE_CTX; moe_tiles(c, CNT); pg8::MoeOrder S{(const LAS int*)(c.lds + LDS_TAB_OFF), (int)gridDim.x, (int)blockIdx.x};
        pg8::Gemm g{P.XG, (const bf16*)(ws + WS_WGU) + (size_t)L * NE * 1024 * DM, 0, 0, DM};
        pg8::EpiSwiGLU E{P.H};
        pg8::gemm_phase<pg8::EpiSwiGLU, pg8::MoeOrder, true, true>(c.lds, g, S, E, c.tid); SEAM(5); }
    if (IN(6)) { PHASE_CTX; moe_tiles(c, CNT); pg8::MoeOrder S{(const LAS int*)(c.lds + LDS_TAB_OFF), (int)gridDim.x, (int)blockIdx.x};
        pg8::Gemm g{P.H, (const bf16*)(ws + WS_WD) + (size_t)L * NE * 1024 * DE, 0, 0, DE};
        pg8::EpiBf16<0> E{P.YS, DM, nullptr, 0, 0, 1.f, 3};
        pg8::gemm_phase<pg8::EpiBf16<0>, pg8::MoeOrder, true, true>(c.lds, g, S, E, c.tid); SEAM(6); }
    if (IN(7)) { PHASE_CTX; const Lw w = layer_weights(args, L); moe_combine_ln2(c, w, args.out, P.YS, P.RTG, P.RTP, args.out, P.XB); SEAM(7); }
#undef IN
#undef SEAM
#undef PHASE_CTX
}
__global__ void __launch_bounds__(NT, 2) fwd_kernel(Args args) {
    extern __shared__ __attribute__((aligned(16))) unsigned char lds_raw[];
    Ctx c;
    c.lds = (LAS unsigned char*)lds_raw;
    c.tid = threadIdx.x; c.lane = c.tid & 63; c.wave = __builtin_amdgcn_readfirstlane(c.tid >> 6);
    c.gtid = blockIdx.x * NT + c.tid; c.gsize = gridDim.x * NT; c.gw = blockIdx.x * NWAVES + c.wave; c.ngw = gridDim.x * NWAVES;
    volatile LAS unsigned* MISC = (volatile LAS unsigned*)(c.lds + LDS_BYTES - 64);
    if (c.tid < 16) MISC[c.tid] = 0u;
    __syncthreads();
    XcdBarrier bar; bar.bar = (unsigned*)args.ws + CW_BAR; bar.x = 0; bar.st = nullptr;
    const int lo = args.ph_lo, hi = args.ph_hi;
    const bool one = (hi - lo) > 1;
    if (one) bar = xcd_barrier_post((unsigned*)args.ws + CW_BAR, MISC + 8);
    if (lo <= 0 && 0 < hi) {
        const Ptrs P = make_ptrs(args.ws);
        Ctx c0 = c; asm volatile("" : "+v"(c.tid)); c.lane = c.tid & 63; c.gtid = blockIdx.x * NT + c.tid;
        for (int r = 0; r < RPT_PRO; ++r) { nv_prologue(c, args.in[0], P.XB); small_weights(c, args, P.GMW, P.PWT, P.POOLT); weights_prologue(c, args, args.ws); }
        if (one && 1 < hi) xcd_barrier(bar);
    }
    run_layer<0>(args, c, bar, one, lo, hi);
    run_layer<1>(args, c, bar, one, lo, hi);
}

extern "C" void kernel_launch(void* const* d_in, const int* in_sizes, int n_in, void* d_out, int out_size, void* d_ws, size_t ws_size, hipStream_t stream) {
    static int grid = 0;
    if (grid == 0) {
        if (n_in != 25 || in_sizes[0] != M * DM || out_size != M * DM || ws_size < WS_END) { fprintf(stderr, "kernel_launch: unexpected shapes/ws (n_in %d ws %zu)\n", n_in, ws_size); grid = -1; return; }
        int dev = 0, cus = 0;
        if (hipGetDevice(&dev) != hipSuccess || hipDeviceGetAttribute(&cus, hipDeviceAttributeMultiprocessorCount, dev) != hipSuccess) { grid = -1; return; }
        if (hipFuncSetAttribute((const void*)fwd_kernel, hipFuncAttributeMaxDynamicSharedMemorySize, LDS_BYTES) != hipSuccess) { grid = -1; return; }
        (void)hipGetLastError();
        grid = cus;
    }
    if (grid < 0) return;
    (void)hipMemsetAsync((char*)d_ws + WS_CTL, 0, CTL_ZERO_BYTES, stream);
    Args a{};
    for (int i = 0; i < 25; ++i) a.in[i] = (const float*)d_in[i];
    a.out = (float*)d_out; a.ws = (unsigned char*)d_ws;
#if MK_ONE_LAUNCH
    a.ph_lo = 0; a.ph_hi = N_PHASES;
    hipLaunchKernelGGL(fwd_kernel, dim3(grid), dim3(NT), LDS_BYTES, stream, a);
#else
    for (int ph = 0; ph < N_PHASES; ++ph) { a.ph_lo = ph; a.ph_hi = ph + 1; hipLaunchKernelGGL(fwd_kernel, dim3(grid), dim3(NT), LDS_BYTES, stream, a); }
#endif
}
```

```cpp
#include <hip/hip_runtime.h>
#include <cstdio>
#include <cstdint>

#ifndef RPT_PRO
#define RPT_PRO 1
#endif
#ifndef RPT_MIX
#define RPT_MIX 1
#endif
#ifndef RPT_LN1
#define RPT_LN1 1
#endif
#ifndef MK_ONE_LAUNCH
#define MK_ONE_LAUNCH 1
#endif

constexpr int NB = 4, SEQ = 4096, DM = 1024, M = NB * SEQ, DIN = 2048, NE = 16, DE = 512, NL = 2;
constexpr int DG = 256, CHUNK = 128, CONFK = 31;
constexpr float ALPHA = 1.41421356237309515f;
constexpr float LN_EPS = 1e-5f, RMS_EPS = 1e-6f;
constexpr int NWAVES = 8, NT = NWAVES * 64;
constexpr int LDS_BYTES = 147456;

typedef unsigned short bf16;
typedef float f32x4 __attribute__((ext_vector_type(4)));
typedef unsigned u32x4 __attribute__((ext_vector_type(4)));
typedef unsigned u32x2 __attribute__((ext_vector_type(2)));
#define LAS __attribute__((address_space(3)))
#define GAS __attribute__((address_space(1)))
typedef GAS unsigned gu32;
#define RLX_AGENT __ATOMIC_RELAXED, __HIP_MEMORY_SCOPE_AGENT

constexpr size_t MiB = 1u << 20;
constexpr size_t WS_CTL = 0, CTL_ZERO_BYTES = 1 * MiB;
constexpr size_t WS_WIN = 1 * MiB;
constexpr size_t WS_WO = 9 * MiB;
constexpr size_t WS_WGU = 13 * MiB;
constexpr size_t WS_WD = 77 * MiB;
constexpr size_t WS_SMALL = 109 * MiB;
constexpr size_t WS_GMW = WS_SMALL, WS_PWT = WS_SMALL + 256 * 1024, WS_POOLT = WS_SMALL + 512 * 1024;
constexpr size_t WS_R1 = 110 * MiB;
constexpr size_t WS_R2 = 182 * MiB;
constexpr size_t WS_RT = 254 * MiB;
constexpr size_t WS_END = 256 * MiB;
constexpr int CW_BAR = 4096;

__device__ __forceinline__ float bf2f(bf16 v) { return __uint_as_float(((unsigned)v) << 16); }
__device__ __forceinline__ unsigned f2bf(float f) { unsigned u = __float_as_uint(f); return (u + 0x7fffu + ((u >> 16) & 1u)) >> 16; }
__device__ __forceinline__ unsigned pk2(float lo, float hi) { return f2bf(lo) | (f2bf(hi) << 16); }
__device__ __forceinline__ float sigmoidf_(float x) { return __builtin_amdgcn_rcpf(1.0f + __builtin_amdgcn_exp2f(-1.44269504089f * x)); }
__device__ __forceinline__ float siluf_(float x) { return x * sigmoidf_(x); }
__device__ __forceinline__ float wave_sum(float v) {
#pragma unroll
    for (int o = 1; o < 64; o <<= 1) v += __shfl_xor(v, o);
    return v;
}

#define XB_TMO      128
#define XB_XCNT(j)  (256  + 64 * (j))
#define XB_XSUB(j)  (1280 + 64 * (j))
#define XB_XGEN(j)  (2304 + 64 * (j))
#define XB_TOP      3328
#define XB_TOPGEN   3392
#define XCD_BAR_WORDS 3456
#define XB_SPIN_CAP (1u << 18)
__device__ __forceinline__ unsigned xb_ld(unsigned* p)              { return __hip_atomic_load(p, __ATOMIC_RELAXED, __HIP_MEMORY_SCOPE_AGENT); }
__device__ __forceinline__ unsigned xb_add(unsigned* p, unsigned v) { return __hip_atomic_fetch_add(p, v, __ATOMIC_RELAXED, __HIP_MEMORY_SCOPE_AGENT); }
__device__ __forceinline__ unsigned xb_xcc_id() { return (unsigned)__builtin_amdgcn_s_getreg((3 << 11) | 20) & 0xFu; }
#define XB_SPIN(cond, bar) do { unsigned _sp = 0; while (cond) { __builtin_amdgcn_s_sleep(1); \
    if ((++_sp & 255u) == 0u) { if (xb_ld(&(bar)[XB_TMO])) break; if (_sp > XB_SPIN_CAP) { atomicAdd(&(bar)[XB_TMO], 1u); break; } } } } while (0)
struct XcdBarrier { unsigned* bar; unsigned x; volatile LAS unsigned* st; };
__device__ __forceinline__ XcdBarrier xcd_barrier_post(unsigned* bar, volatile LAS unsigned* st) {
    XcdBarrier b; b.bar = bar; b.x = xb_xcc_id(); b.st = st;
    if (threadIdx.x == 0) (void)xb_add(&bar[XB_XCNT(b.x)], 1u);
    return b;
}
__device__ __forceinline__ void xcd_barrier_complete(unsigned* bar, unsigned x, unsigned& nloc, unsigned& nx) {
    const unsigned G = gridDim.x * gridDim.y * gridDim.z;
    unsigned sum, cnt, mine, sp = 0u;
    for (;;) {
        sum = 0u; cnt = 0u; mine = 0u;
#pragma unroll
        for (unsigned j = 0; j < 16; ++j) { const unsigned c = xb_ld(&bar[XB_XCNT(j)]); sum += c; cnt += (c > 0u) ? 1u : 0u; mine = (j == x) ? c : mine; }
        if (sum == G) break;
        __builtin_amdgcn_s_sleep(1);
        if ((++sp & 255u) == 0u) { if (xb_ld(&bar[XB_TMO])) break; if (sp > XB_SPIN_CAP) { atomicAdd(&bar[XB_TMO], 1u); break; } }
    }
    nloc = mine > 0u ? mine : 1u; nx = cnt > 0u ? cnt : 1u;
}
__device__ __forceinline__ void xcd_barrier(const XcdBarrier& b) {
    asm volatile("s_waitcnt vmcnt(0)" ::: "memory");
    __syncthreads();
    if (threadIdx.x == 0) {
        unsigned* bar = b.bar;
        __builtin_amdgcn_s_waitcnt(0);
        unsigned nloc = b.st[0], nx = b.st[1];
        if (nloc == 0u) { xcd_barrier_complete(bar, b.x, nloc, nx); b.st[0] = nloc; b.st[1] = nx; }
        const unsigned old = xb_add(&bar[XB_XSUB(b.x)], 1u);
        const unsigned gen = old / nloc;
        if (old + 1u == (gen + 1u) * nloc) {
            __builtin_amdgcn_fence(__ATOMIC_RELEASE, "agent");
            asm volatile("s_waitcnt vmcnt(0)" ::: "memory");
            const unsigned og = xb_add(&bar[XB_TOP], 1u);
            const unsigned tg = og / nx;
            if (og + 1u == (tg + 1u) * nx) xb_add(&bar[XB_TOPGEN], 1u);
            else XB_SPIN(xb_ld(&bar[XB_TOPGEN]) == tg, bar);
            __builtin_amdgcn_fence(__ATOMIC_ACQUIRE, "agent");
            xb_add(&bar[XB_XGEN(b.x)], 1u);
            asm volatile("s_waitcnt vmcnt(0)" ::: "memory");
        } else {
            XB_SPIN(xb_ld(&bar[XB_XGEN(b.x)]) == gen, bar);
            __builtin_amdgcn_fence(__ATOMIC_ACQUIRE, "agent");
            asm volatile("s_waitcnt vmcnt(0)" ::: "memory");
        }
    }
    __syncthreads();
}

struct Args { const float* in[25]; float* out; unsigned char* ws; int ph_lo, ph_hi; };

struct Ctx {
    int tid, lane, wave, gtid, gsize, gw, ngw;
    LAS unsigned char* lds;
};

template <class Epi>
__device__ __forceinline__ void nv_gemm(const Ctx& c, const bf16* A, int lda, const float* W, int ldw, int Mr, int N, int K, const Epi& epi) {
    const int ntn = N / 4; const long total = (long)ntn * (Mr / 4);
    for (long i = c.gtid; i < total; i += c.gsize) {
        const int tn = (int)(i % ntn), tm = (int)(i / ntn);
        float acc[4][4];
#pragma unroll
        for (int r = 0; r < 4; ++r)
#pragma unroll
            for (int q = 0; q < 4; ++q) acc[r][q] = 0.f;
        const bf16* a0 = A + (size_t)(tm * 4) * lda;
        const float* w0 = W + tn * 4;
        for (int k = 0; k < K; k += 8) {
            u32x4 av[4];
#pragma unroll
            for (int r = 0; r < 4; ++r) av[r] = *(const u32x4*)(a0 + (size_t)r * lda + k);
#pragma unroll
            for (int kk = 0; kk < 8; ++kk) {
                const f32x4 w = *(const f32x4*)(w0 + (size_t)(k + kk) * ldw);
#pragma unroll
                for (int r = 0; r < 4; ++r) {
                    const unsigned pr = av[r][kk >> 1];
                    const float a = (kk & 1) ? __uint_as_float(pr & 0xffff0000u) : __uint_as_float(pr << 16);
#pragma unroll
                    for (int q = 0; q < 4; ++q) acc[r][q] += a * w[q];
                }
            }
        }
#pragma unroll
        for (int r = 0; r < 4; ++r) epi(tm * 4 + r, tn * 4, (f32x4){acc[r][0], acc[r][1], acc[r][2], acc[r][3]});
    }
}

__device__ __forceinline__ void ln256(f32x4& v, const float* g, const float* b, int lane) {
    const float mean = wave_sum((v[0] + v[1]) + (v[2] + v[3])) * (1.f / 256.f);
    v = v - mean;
    const float var = wave_sum((v[0] * v[0] + v[1] * v[1]) + (v[2] * v[2] + v[3] * v[3])) * (1.f / 256.f);
    const float rstd = __builtin_amdgcn_rsqf(var + LN_EPS);
    const f32x4 gg = *(const f32x4*)(g + lane * 4), bb = *(const f32x4*)(b + lane * 4);
    v = v * rstd * gg + bb;
}
__device__ __forceinline__ f32x4 ld_bf4(const bf16* p) { const u32x2 w = *(const u32x2*)p; return (f32x4){__uint_as_float(w.x << 16), __uint_as_float(w.x & 0xffff0000u), __uint_as_float(w.y << 16), __uint_as_float(w.y & 0xffff0000u)}; }
__device__ __forceinline__ void st_bf4(bf16* p, f32x4 v) { u32x2 w; w.x = pk2(v[0], v[1]); w.y = pk2(v[2], v[3]); *(u32x2*)p = w; }

struct Lw {
    const float *w_in, *gm_ln_g, *gm_ln_b, *gm_w_s, *gm_b_s, *cf_dw_w, *cf_dw_b, *cf_ln_g, *cf_ln_b, *cf_pw, *pool_w, *pool_scale, *sc_w, *mix_norm_g, *w_o, *ln1_g, *ln1_b,
        *router_w, *router_b, *wg, *wu, *wd, *ln2_g, *ln2_b;
};
__device__ __forceinline__ Lw layer_weights(const Args& a, int l) {
    Lw w;
    w.w_in = a.in[1] + (size_t)l * DM * DIN; w.gm_ln_g = a.in[2] + l * DG; w.gm_ln_b = a.in[3] + l * DG; w.gm_w_s = a.in[4] + (size_t)l * 4 * CHUNK * CHUNK; w.gm_b_s = a.in[5] + l * 4 * CHUNK;
    w.cf_dw_w = a.in[6] + l * CONFK * DG; w.cf_dw_b = a.in[7] + l * DG; w.cf_ln_g = a.in[8] + l * DG; w.cf_ln_b = a.in[9] + l * DG; w.cf_pw = a.in[10] + (size_t)l * DG * DG;
    w.pool_w = a.in[11] + l * 4 * 64 * 64; w.pool_scale = a.in[12] + l * DG; w.sc_w = a.in[13] + l * 3 * DG; w.mix_norm_g = a.in[14] + l * DM; w.w_o = a.in[15] + (size_t)l * DM * DM;
    w.ln1_g = a.in[16] + l * DM; w.ln1_b = a.in[17] + l * DM; w.router_w = a.in[18]; w.router_b = a.in[19];
    w.wg = a.in[20] + (size_t)l * NE * DM * DE; w.wu = a.in[21] + (size_t)l * NE * DM * DE; w.wd = a.in[22] + (size_t)l * NE * DE * DM;
    w.ln2_g = a.in[23] + l * DM; w.ln2_b = a.in[24] + l * DM;
    return w;
}

__device__ __forceinline__ void nv_prologue(const Ctx& c, const float* x, bf16* XB) {
    constexpr size_t N4 = (size_t)M * DM / 4;
    for (size_t i0 = (size_t)c.gtid; i0 < N4; i0 += (size_t)c.gsize * 8) {
        f32x4 v[8];
#pragma unroll
        for (int j = 0; j < 8; ++j) { const size_t i = i0 + (size_t)j * c.gsize; if (i < N4) v[j] = *(const f32x4*)(x + i * 4); }
#pragma unroll
        for (int j = 0; j < 8; ++j) { const size_t i = i0 + (size_t)j * c.gsize; if (i < N4) st_bf4(XB + i * 4, v[j]); }
    }
}
typedef short bf16x8 __attribute__((ext_vector_type(8)));
__device__ __forceinline__ bf16x8 as_bf16x8(u32x4 v) { return __builtin_bit_cast(bf16x8, v); }
#define MFMA16(a, b, c) __builtin_amdgcn_mfma_f32_16x16x32_bf16((a), (b), (c), 0, 0, 0)
constexpr int YT_LD = 260;
constexpr int AT_LD = 264;
constexpr int VT_RS = 260;

__device__ __forceinline__ void small_weights(const Ctx& c, const Args& a, bf16* GMW, bf16* PWT, bf16* POOLT) {
    for (int i = c.gtid; i < NL * 4 * CHUNK * CHUNK; i += c.gsize) { const int s = i & 127, t = (i >> 7) & 127; GMW[i] = (bf16)((s <= t) ? f2bf(a.in[4][i]) : 0u); }
    for (int i = c.gtid; i < NL * DG * DG; i += c.gsize) { const int cc = i & 255, n = (i >> 8) & 255, l = i >> 16; PWT[i] = (bf16)f2bf(a.in[10][((size_t)l * DG + cc) * DG + n]); }
    for (int i = c.gtid; i < NL * 4 * 64 * 64; i += c.gsize) { const int d = i & 63, e = (i >> 6) & 63, lg = i >> 12; POOLT[i] = (bf16)f2bf(a.in[11][((size_t)lg * 64 + d) * 64 + e]); }
}

template <bool UMUL>
__device__ __forceinline__ void mix_final(const Ctx& c, const Lw& w, int t0, int grp, bf16* YN, const bf16* Z = nullptr) {
    const LAS float* YT = (const LAS float*)c.lds;
    const f32x4 g = *(const f32x4*)(w.mix_norm_g + grp * DG + c.lane * 4);
    u32x2 uu[16];
    if (UMUL) {
#pragma unroll
        for (int i = 0; i < 16; ++i) uu[i] = *(const u32x2*)(Z + (size_t)(t0 + c.wave * 16 + i) * DIN + c.lane * 4);
    }
#pragma unroll
    for (int i = 0; i < 16; ++i) {
        const int t = c.wave * 16 + i;
        f32x4 v = *(const LAS f32x4*)(YT + t * YT_LD + c.lane * 4);
        if (UMUL) v = v * (f32x4){__uint_as_float(uu[i].x << 16), __uint_as_float(uu[i].x & 0xffff0000u), __uint_as_float(uu[i].y << 16), __uint_as_float(uu[i].y & 0xffff0000u)};
        const float ms = wave_sum((v[0] * v[0] + v[1] * v[1]) + (v[2] * v[2] + v[3] * v[3])) * (1.f / 256.f);
        const float r = __builtin_amdgcn_rsqf(ms + RMS_EPS);
        st_bf4(YN + (size_t)(t0 + t) * DM + grp * DG + c.lane * 4, v * r * g);
    }
}

__device__ __forceinline__ void mix_conformer(const Ctx& c, const Lw& w, const bf16* Z, const bf16* PWT, int t0, bf16* YN) {
    LAS unsigned char* lds = c.lds;
    const int pos0 = t0 % SEQ;
    {
        const int c8 = (c.tid & 31) * 8, r0 = c.tid >> 5;
        u32x4 av[10], gv[10];
#pragma unroll
        for (int it = 0; it < 10; ++it) {
            const int r = r0 + 16 * it;
            av[it] = (u32x4){0u, 0u, 0u, 0u}; gv[it] = (u32x4){0u, 0u, 0u, 0u};
            if (r < 158 && pos0 + r - 30 >= 0) { const size_t zr = (size_t)(t0 + r - 30) * DIN; av[it] = *(const u32x4*)(Z + zr + 512 + c8); gv[it] = *(const u32x4*)(Z + zr + 768 + c8); }
        }
#pragma unroll
        for (int it = 0; it < 10; ++it) {
            const int r = r0 + 16 * it;
            if (r < 158) {
                u32x4 o;
#pragma unroll
                for (int j = 0; j < 4; ++j) {
                    const float a0 = __uint_as_float(av[it][j] << 16), a1 = __uint_as_float(av[it][j] & 0xffff0000u), g0 = __uint_as_float(gv[it][j] << 16), g1 = __uint_as_float(gv[it][j] & 0xffff0000u);
                    o[j] = pk2(a0 * sigmoidf_(g0), a1 * sigmoidf_(g1));
                }
                *(LAS u32x4*)(lds + r * 512 + c8 * 2) = o;
            }
        }
    }
    __syncthreads();
    constexpr int CT_OFF = 80896;
    {
        const int ch = c.tid & 255, tg = c.tid >> 8;
        float wk[CONFK];
#pragma unroll
        for (int k = 0; k < CONFK; ++k) wk[k] = w.cf_dw_w[k * DG + ch];
        const float b0 = w.cf_dw_b[ch];
#pragma unroll 1
        for (int sb = 0; sb < 8; ++sb) {
            float acc[8];
#pragma unroll
            for (int j = 0; j < 8; ++j) acc[j] = b0;
            const int rb = tg * 64 + sb * 8;
#pragma unroll
            for (int r = 0; r < 38; ++r) {
                const float h0 = bf2f(*(const LAS bf16*)(lds + (rb + r) * 512 + ch * 2));
#pragma unroll
                for (int j = 0; j < 8; ++j) { const int k = r - j; if (k >= 0 && k < CONFK) acc[j] += wk[k] * h0; }
            }
#pragma unroll
            for (int j = 0; j < 8; ++j) *(LAS bf16*)(lds + CT_OFF + (rb + j) * 512 + ch * 2) = (bf16)f2bf(acc[j]);
        }
    }
    __syncthreads();
    {
        const f32x4 g = *(const f32x4*)(w.cf_ln_g + c.lane * 4), b = *(const f32x4*)(w.cf_ln_b + c.lane * 4);
#pragma unroll 4
        for (int i = 0; i < 16; ++i) {
            const int t = c.wave * 16 + i;
            const u32x2 pv = *(const LAS u32x2*)(lds + CT_OFF + t * 512 + c.lane * 8);
            f32x4 v = (f32x4){__uint_as_float(pv.x << 16), __uint_as_float(pv.x & 0xffff0000u), __uint_as_float(pv.y << 16), __uint_as_float(pv.y & 0xffff0000u)};
            const float mean = wave_sum((v[0] + v[1]) + (v[2] + v[3])) * (1.f / 256.f);
            v = v - mean;
            const float var = wave_sum((v[0] * v[0] + v[1] * v[1]) + (v[2] * v[2] + v[3] * v[3])) * (1.f / 256.f);
            v = v * (__builtin_amdgcn_rsqf(var + LN_EPS)) * g + b;
            u32x2 o; o.x = pk2(siluf_(v[0]), siluf_(v[1])); o.y = pk2(siluf_(v[2]), siluf_(v[3]));
            *(LAS u32x2*)(lds + t * (AT_LD * 2) + c.lane * 8) = o;
        }
    }
    __syncthreads();
    {
        const int fr = c.lane & 15, fq = c.lane >> 4;
        f32x4 C[8][2];
#pragma unroll
        for (int rt = 0; rt < 8; ++rt) { C[rt][0] = (f32x4){0.f, 0.f, 0.f, 0.f}; C[rt][1] = (f32x4){0.f, 0.f, 0.f, 0.f}; }
        bf16x8 Bf[2][8];
#pragma unroll
        for (int ct = 0; ct < 2; ++ct)
#pragma unroll
            for (int ks = 0; ks < 8; ++ks) Bf[ct][ks] = as_bf16x8(*(const u32x4*)(PWT + (size_t)(c.wave * 32 + ct * 16 + fr) * DG + ks * 32 + fq * 8));
#pragma unroll
        for (int rt = 0; rt < 8; ++rt)
#pragma unroll
            for (int ks = 0; ks < 8; ++ks) {
                const bf16x8 Af = as_bf16x8(*(const LAS u32x4*)(lds + (rt * 16 + fr) * (AT_LD * 2) + (ks * 32 + fq * 8) * 2));
                C[rt][0] = MFMA16(Af, Bf[0][ks], C[rt][0]); C[rt][1] = MFMA16(Af, Bf[1][ks], C[rt][1]);
            }
        __syncthreads();
        LAS float* YT = (LAS float*)lds;
#pragma unroll
        for (int rt = 0; rt < 8; ++rt)
#pragma unroll
            for (int ct = 0; ct < 2; ++ct)
#pragma unroll
                for (int j = 0; j < 4; ++j) YT[(rt * 16 + fq * 4 + j) * YT_LD + c.wave * 32 + ct * 16 + fr] = C[rt][ct][j];
    }
    __syncthreads();
    mix_final<false>(c, w, t0, 1, YN);
}

__device__ __forceinline__ void mix_gmlp(const Ctx& c, const Lw& w, const bf16* Z, const bf16* GMW, int t0, bf16* YN) {
    LAS unsigned char* lds = c.lds;
    {
        float g[4], b[4];
#pragma unroll
        for (int q = 0; q < 4; ++q) { g[q] = w.gm_ln_g[c.lane + 64 * q]; b[q] = w.gm_ln_b[c.lane + 64 * q]; }
        bf16 raw[16][4];
#pragma unroll
        for (int i = 0; i < 16; ++i)
#pragma unroll
            for (int q = 0; q < 4; ++q) raw[i][q] = Z[(size_t)(t0 + c.wave * 16 + i) * DIN + 256 + c.lane + 64 * q];
#pragma unroll
        for (int i = 0; i < 8; ++i) {
            const int s = c.wave * 16 + 2 * i;
            float v[2][4];
#pragma unroll
            for (int p = 0; p < 2; ++p) {
#pragma unroll
                for (int q = 0; q < 4; ++q) v[p][q] = bf2f(raw[2 * i + p][q]);
                const float mean = wave_sum((v[p][0] + v[p][1]) + (v[p][2] + v[p][3])) * (1.f / 256.f);
#pragma unroll
                for (int q = 0; q < 4; ++q) v[p][q] -= mean;
                const float var = wave_sum((v[p][0] * v[p][0] + v[p][1] * v[p][1]) + (v[p][2] * v[p][2] + v[p][3] * v[p][3])) * (1.f / 256.f);
                const float rstd = __builtin_amdgcn_rsqf(var + LN_EPS);
#pragma unroll
                for (int q = 0; q < 4; ++q) v[p][q] = v[p][q] * rstd * g[q] + b[q];
            }
#pragma unroll
            for (int q = 0; q < 4; ++q) *(LAS unsigned*)(lds + (c.lane + 64 * q) * VT_RS + s * 2) = pk2(v[0][q], v[1][q]);
        }
    }
    __syncthreads();
    const int fr = c.lane & 15, fq = c.lane >> 4, h = c.wave >> 1, par = c.wave & 1;
    bf16x8 Bf[4][4];
#pragma unroll
    for (int ct = 0; ct < 4; ++ct)
#pragma unroll
        for (int ks = 0; ks < 4; ++ks) {
            u32x4 t;
#pragma unroll
            for (int i = 0; i < 4; ++i) t[i] = *(const LAS unsigned*)(lds + (h * 64 + ct * 16 + fr) * VT_RS + (ks * 32 + fq * 8 + 2 * i) * 2);
            Bf[ct][ks] = as_bf16x8(t);
        }
    __syncthreads();
    LAS float* YT = (LAS float*)lds;
    bf16x8 Af[4][4];
#pragma unroll
    for (int i = 0; i < 4; ++i)
#pragma unroll
        for (int ks = 0; ks <= i; ++ks) Af[i][ks] = as_bf16x8(*(const u32x4*)(GMW + ((size_t)(h * CHUNK + 16 * (par + 2 * i) + fr)) * CHUNK + ks * 32 + fq * 8));
#pragma unroll
    for (int i = 0; i < 4; ++i) {
        const int R = par + 2 * i;
        f32x4 C[4];
#pragma unroll
        for (int ct = 0; ct < 4; ++ct) C[ct] = (f32x4){0.f, 0.f, 0.f, 0.f};
#pragma unroll
        for (int ks = 0; ks <= i; ++ks)
#pragma unroll
            for (int ct = 0; ct < 4; ++ct) C[ct] = MFMA16(Af[i][ks], Bf[ct][ks], C[ct]);
#pragma unroll
        for (int j = 0; j < 4; ++j) {
            const int t = 16 * R + fq * 4 + j; const float bs = w.gm_b_s[h * CHUNK + t];
#pragma unroll
            for (int ct = 0; ct < 4; ++ct) YT[t * YT_LD + h * 64 + ct * 16 + fr] = C[ct][j] + bs;
        }
    }
    __syncthreads();
    mix_final<true>(c, w, t0, 0, YN, Z);
}

__device__ __forceinline__ void mix_pool(const Ctx& c, const Lw& w, const bf16* Z, const bf16* POOLT, int t0, bf16* YN) {
    LAS unsigned char* lds = c.lds;
    const int pos0 = t0 % SEQ;
    constexpr int PA_OFF = 73728;
    {
        const int c8 = (c.tid & 31) * 8, r0 = c.tid >> 5;
        u32x4 zv[9];
#pragma unroll
        for (int it = 0; it < 9; ++it) { const int r = r0 + 16 * it; zv[it] = (u32x4){0u, 0u, 0u, 0u};
            if (r < 143 && pos0 + r - 15 >= 0) zv[it] = *(const u32x4*)(Z + (size_t)(t0 + r - 15) * DIN + 1024 + c8); }
#pragma unroll
        for (int it = 0; it < 9; ++it) { const int r = r0 + 16 * it; if (r < 143) *(LAS u32x4*)(lds + r * 512 + c8 * 2) = zv[it]; }
    }
    __syncthreads();
    {
        const int cp = c.tid & 127, tg = c.tid >> 7, W = 2 << (cp >> 5);
        float s0 = 0.f, s1 = 0.f;
        for (int i = 1; i < W; ++i) { const unsigned zv = *(const LAS unsigned*)(lds + (tg * 32 + 15 - i) * 512 + cp * 4); s0 += __uint_as_float(zv << 16); s1 += __uint_as_float(zv & 0xffff0000u); }
        for (int j = 0; j < 32; ++j) {
            const int tl = tg * 32 + j, pos = pos0 + tl;
            const unsigned zv = *(const LAS unsigned*)(lds + (tl + 15) * 512 + cp * 4);
            const float z0 = __uint_as_float(zv << 16), z1 = __uint_as_float(zv & 0xffff0000u);
            s0 += z0; s1 += z1;
            const float inv = __builtin_amdgcn_rcpf((float)((pos + 1 < W) ? pos + 1 : W));
            *(LAS unsigned*)(lds + PA_OFF + tl * (AT_LD * 2) + cp * 4) = pk2(s0 * inv - z0, s1 * inv - z1);
            const unsigned zo = *(const LAS unsigned*)(lds + (tl + 15 - (W - 1)) * 512 + cp * 4);
            s0 -= __uint_as_float(zo << 16); s1 -= __uint_as_float(zo & 0xffff0000u);
        }
    }
    __syncthreads();
    {
        const int fr = c.lane & 15, fq = c.lane >> 4, g = c.wave >> 1, cb = (c.wave & 1) * 2;
        f32x4 C[8][2];
#pragma unroll
        for (int rt = 0; rt < 8; ++rt) { C[rt][0] = (f32x4){0.f, 0.f, 0.f, 0.f}; C[rt][1] = (f32x4){0.f, 0.f, 0.f, 0.f}; }
        bf16x8 Bf[2][2];
#pragma unroll
        for (int ct = 0; ct < 2; ++ct)
#pragma unroll
            for (int ks = 0; ks < 2; ++ks) Bf[ct][ks] = as_bf16x8(*(const u32x4*)(POOLT + (size_t)(g * 64 + (cb + ct) * 16 + fr) * 64 + ks * 32 + fq * 8));
#pragma unroll
        for (int rt = 0; rt < 8; ++rt)
#pragma unroll
            for (int ks = 0; ks < 2; ++ks) {
                const bf16x8 Af = as_bf16x8(*(const LAS u32x4*)(lds + PA_OFF + (rt * 16 + fr) * (AT_LD * 2) + (g * 64 + ks * 32 + fq * 8) * 2));
                C[rt][0] = MFMA16(Af, Bf[0][ks], C[rt][0]); C[rt][1] = MFMA16(Af, Bf[1][ks], C[rt][1]);
            }
        __syncthreads();
        LAS float* YT = (LAS float*)lds;
#pragma unroll
        for (int ct = 0; ct < 2; ++ct) {
            const int ch = g * 64 + (cb + ct) * 16 + fr; const float sc = w.pool_scale[ch];
#pragma unroll
            for (int rt = 0; rt < 8; ++rt)
#pragma unroll
                for (int j = 0; j < 4; ++j) YT[(rt * 16 + fq * 4 + j) * YT_LD + ch] = C[rt][ct][j] * sc;
        }
    }
    __syncthreads();
    mix_final<false>(c, w, t0, 2, YN);
}

__device__ __forceinline__ void mix_sconv(const Ctx& c, const Lw& w, const bf16* Z, int t0, bf16* YN) {
    LAS float* YT = (LAS float*)c.lds;
    const int pos0 = t0 % SEQ;
#pragma unroll 1
    for (int task = c.tid; task < 1024; task += NT) {
        const int c8 = (task & 31) * 8, R0 = (task >> 5) * 4;
        u32x4 cv[6], hv[6], bv[4];
#pragma unroll
        for (int i = 0; i < 6; ++i) { cv[i] = (u32x4){0u, 0u, 0u, 0u}; hv[i] = (u32x4){0u, 0u, 0u, 0u};
            if (pos0 + R0 - 2 + i >= 0) { const size_t zr = (size_t)(t0 + R0 - 2 + i) * DIN; cv[i] = *(const u32x4*)(Z + zr + 1536 + c8); hv[i] = *(const u32x4*)(Z + zr + 1792 + c8); } }
#pragma unroll
        for (int j = 0; j < 4; ++j) bv[j] = *(const u32x4*)(Z + (size_t)(t0 + R0 + j) * DIN + 1280 + c8);
        float wk[3][8];
#pragma unroll
        for (int k = 0; k < 3; ++k) { const f32x4 w0 = *(const f32x4*)(w.sc_w + k * DG + c8), w1 = *(const f32x4*)(w.sc_w + k * DG + c8 + 4);
#pragma unroll
            for (int q = 0; q < 4; ++q) { wk[k][q] = w0[q]; wk[k][4 + q] = w1[q]; } }
        float p[6][8];
#pragma unroll
        for (int i = 0; i < 6; ++i)
#pragma unroll
            for (int q = 0; q < 4; ++q) { p[i][2 * q] = __uint_as_float(cv[i][q] << 16) * __uint_as_float(hv[i][q] << 16); p[i][2 * q + 1] = __uint_as_float(cv[i][q] & 0xffff0000u) * __uint_as_float(hv[i][q] & 0xffff0000u); }
#pragma unroll
        for (int j = 0; j < 4; ++j) {
            float o[8];
#pragma unroll
            for (int q = 0; q < 8; ++q) o[q] = wk[0][q] * p[j][q] + wk[1][q] * p[j + 1][q] + wk[2][q] * p[j + 2][q];
#pragma unroll
            for (int q = 0; q < 4; ++q) { o[2 * q] *= __uint_as_float(bv[j][q] << 16); o[2 * q + 1] *= __uint_as_float(bv[j][q] & 0xffff0000u); }
            *(LAS f32x4*)(YT + (R0 + j) * YT_LD + c8) = (f32x4){o[0], o[1], o[2], o[3]}; *(LAS f32x4*)(YT + (R0 + j) * YT_LD + c8 + 4) = (f32x4){o[4], o[5], o[6], o[7]};
        }
    }
    __syncthreads();
    mix_final<false>(c, w, t0, 3, YN);
}

__device__ __forceinline__ void mixer_phase(const Ctx& c0, const Lw& w, int l, const bf16* Z, const bf16* GMW, const bf16* PWT, const bf16* POOLT, bf16* YN) {
    for (int it = blockIdx.x; it < 512; it += gridDim.x) {
        Ctx c = c0; asm volatile("" : "+v"(c.tid)); c.lane = c.tid & 63;
        const int mx = it >> 7, t0 = (it & 127) * CHUNK;
        if (mx == 0) mix_conformer(c, w, Z, PWT + (size_t)l * DG * DG, t0, YN);
        else if (mx == 1) mix_gmlp(c, w, Z, GMW + (size_t)l * 4 * CHUNK * CHUNK, t0, YN);
        else if (mx == 2) mix_pool(c, w, Z, POOLT + (size_t)l * 4 * 64 * 64, t0, YN);
        else mix_sconv(c, w, Z, t0, YN);
        __syncthreads();
    }
}

struct EpiZ { bf16* Z; __device__ __forceinline__ void operator()(int r, int cc, f32x4 v) const { st_bf4(Z + (size_t)r * DIN + cc, v); } };
struct EpiU { float* U; const float* X; __device__ __forceinline__ void operator()(int r, int cc, f32x4 v) const { *(f32x4*)(U + (size_t)r * DM + cc) = v + ALPHA * *(const f32x4*)(X + (size_t)r * DM + cc); } };

__device__ __forceinline__ void ln1024(f32x4 (&v)[4], const float* g, const float* b, int lane) {
    float s = 0.f;
#pragma unroll
    for (int j = 0; j < 4; ++j) s += (v[j][0] + v[j][1]) + (v[j][2] + v[j][3]);
    const float mean = wave_sum(s) * (1.f / DM);
    float q = 0.f;
#pragma unroll
    for (int j = 0; j < 4; ++j) { v[j] = v[j] - mean; q += (v[j][0] * v[j][0] + v[j][1] * v[j][1]) + (v[j][2] * v[j][2] + v[j][3] * v[j][3]); }
    const float rstd = __builtin_amdgcn_rsqf(wave_sum(q) * (1.f / DM) + LN_EPS);
#pragma unroll
    for (int j = 0; j < 4; ++j) v[j] = v[j] * rstd * *(const f32x4*)(g + lane * 4 + 256 * j) + *(const f32x4*)(b + lane * 4 + 256 * j);
}
__device__ __forceinline__ void nv_ln1_router(const Ctx& c, const Lw& w, const float* U, float* X1, bf16* X1B, unsigned* RTE, float* RTG) {
    LAS float* RWt = (LAS float*)c.lds;
    __syncthreads();
#pragma unroll
    for (int h = 0; h < 2; ++h) { const int ch = c.tid + 512 * h;
#pragma unroll
        for (int e4 = 0; e4 < 4; ++e4) { const f32x4 ww = *(const f32x4*)(w.router_w + (size_t)ch * NE + e4 * 4);
#pragma unroll
            for (int q = 0; q < 4; ++q) RWt[(e4 * 4 + q) * DM + ch] = ww[q]; } }
    __syncthreads();
    for (int t = c.gw; t < M; t += c.ngw) {
        f32x4 v[4];
#pragma unroll
        for (int j = 0; j < 4; ++j) v[j] = *(const f32x4*)(U + (size_t)t * DM + c.lane * 4 + 256 * j);
        ln1024(v, w.ln1_g, w.ln1_b, c.lane);
#pragma unroll
        for (int j = 0; j < 4; ++j) { *(f32x4*)(X1 + (size_t)t * DM + c.lane * 4 + 256 * j) = v[j]; st_bf4(X1B + (size_t)t * DM + c.lane * 4 + 256 * j, v[j]); }
        float lg[16];
        int lo = c.lane * 4; asm volatile("" : "+v"(lo));
#pragma unroll
        for (int e = 0; e < 16; ++e) {
            float a = 0.f;
#pragma unroll
            for (int j = 0; j < 4; ++j) { const f32x4 ww = *(const LAS f32x4*)(RWt + e * DM + lo + 256 * j); a += (v[j][0] * ww[0] + v[j][1] * ww[1]) + (v[j][2] * ww[2] + v[j][3] * ww[3]); }
            lg[e] = a;
        }
#pragma unroll
        for (int e = 0; e < 16; ++e) lg[e] = wave_sum(lg[e]);
        float best_score = 0.f; int best = -1;
#pragma unroll
        for (int g = 0; g < 4; ++g) {
            float m1 = -INFINITY, m2 = -INFINITY;
#pragma unroll
            for (int j = 0; j < 4; ++j) { const float s = lg[g * 4 + j] + w.router_b[g * 4 + j]; if (s > m1) { m2 = m1; m1 = s; } else if (s > m2) m2 = s; }
            const float sc = m1 + m2;
            if (best < 0 || sc > best_score) { best_score = sc; best = g; }
        }
        float s1 = -INFINITY, s2 = -INFINITY, l1 = 0.f, l2 = 0.f; int i1 = 0, i2 = 0;
#pragma unroll
        for (int e = 0; e < 16; ++e) {
            if ((e >> 2) == best) { const float s = lg[e] + w.router_b[e];
                if (s > s1) { s2 = s1; i2 = i1; l2 = l1; s1 = s; i1 = e; l1 = lg[e]; } else if (s > s2) { s2 = s; i2 = e; l2 = lg[e]; } }
        }
        const float mx = fmaxf(l1, l2), e1 = __expf(l1 - mx), e2 = __expf(l2 - mx), inv = 1.0f / (e1 + e2);
        if (c.lane == 0) { RTE[t] = (unsigned)i1 | ((unsigned)i2 << 8); RTG[2 * t] = e1 * inv; RTG[2 * t + 1] = e2 * inv; }
    }
}
constexpr int CW_CNT = 8192;
__device__ __forceinline__ void moe_ranks(const Ctx& c, const unsigned* RTE, int* RTP, unsigned* CNT, int* LIST) {
    LAS int* LC = (LAS int*)c.lds;
    __syncthreads();
    if (c.tid < 32) LC[c.tid] = 0;
    __syncthreads();
    for (int t = c.gw; t < M; t += c.ngw) {
        if (c.lane == 0) { const unsigned ee = RTE[t]; RTP[2 * t] = __hip_atomic_fetch_add(&LC[ee & 0xff], 1, __ATOMIC_RELAXED, __HIP_MEMORY_SCOPE_WORKGROUP); RTP[2 * t + 1] = __hip_atomic_fetch_add(&LC[(ee >> 8) & 0xff], 1, __ATOMIC_RELAXED, __HIP_MEMORY_SCOPE_WORKGROUP); }
    }
    __syncthreads();
    if (c.tid < 16) LC[16 + c.tid] = (int)atomicAdd(&CNT[c.tid], (unsigned)LC[c.tid]);
    __syncthreads();
    for (int t = c.gw; t < M; t += c.ngw) {
        if (c.lane == 0) { const unsigned ee = RTE[t]; const int e0 = ee & 0xff, e1 = (ee >> 8) & 0xff; const int p0 = RTP[2 * t] + LC[16 + e0], p1 = RTP[2 * t + 1] + LC[16 + e1];
            RTP[2 * t] = p0; RTP[2 * t + 1] = p1; LIST[e0 * M + p0] = t; LIST[e1 * M + p1] = t; }
    }
}
constexpr int LDS_TAB_OFF = 131072;
__device__ __forceinline__ void moe_tiles(const Ctx& c, const unsigned* CNT) {
    LAS int* ts = (LAS int*)(c.lds + LDS_TAB_OFF);
    __syncthreads();
    if (c.tid < 17) { int s = 0; for (int e = 0; e < c.tid; ++e) s += (int)((CNT[e] + 255u) >> 8); ts[c.tid] = s; }
    __syncthreads();
}
constexpr int LDS_IDX_OFF = LDS_TAB_OFF + 256, MAX_UNITS = 15;
__device__ __forceinline__ void moe_combine_ln2(const Ctx& c, const Lw& w, const float* X1, const bf16* YS, const unsigned* RTE, const float* RTG, const int* RTP, float* X2, bf16* XB) {
    const LAS int* ts = (const LAS int*)(c.lds + LDS_TAB_OFF);
    for (int t = c.gw; t < M; t += c.ngw) {
        const unsigned ee = RTE[t];
        const int s0 = ts[ee & 0xff] * 256 + RTP[2 * t], s1 = ts[(ee >> 8) & 0xff] * 256 + RTP[2 * t + 1]; const float g0 = RTG[2 * t], g1 = RTG[2 * t + 1];
        f32x4 v[4];
#pragma unroll
        for (int j = 0; j < 4; ++j) {
            const int col = c.lane * 4 + 256 * j;
            v[j] = ALPHA * *(const f32x4*)(X1 + (size_t)t * DM + col) + g0 * ld_bf4(YS + (size_t)s0 * DM + col) + g1 * ld_bf4(YS + (size_t)s1 * DM + col);
        }
        ln1024(v, w.ln2_g, w.ln2_b, c.lane);
#pragma unroll
        for (int j = 0; j < 4; ++j) { *(f32x4*)(X2 + (size_t)t * DM + c.lane * 4 + 256 * j) = v[j]; st_bf4(XB + (size_t)t * DM + c.lane * 4 + 256 * j, v[j]); }
    }
}

__device__ __forceinline__ void nv_moe(const Ctx& c, const Lw& w, const float* X1, const unsigned* RTE, const float* RTG, float* F) {
    LAS float* xs = (LAS float*)c.lds; LAS float* hs = xs + DM;
    for (int t = blockIdx.x; t < M; t += gridDim.x) {
        __syncthreads();
        xs[c.tid] = X1[(size_t)t * DM + c.tid]; xs[c.tid + 512] = X1[(size_t)t * DM + c.tid + 512];
        __syncthreads();
        const unsigned ee = RTE[t]; float f0 = 0.f, f1 = 0.f;
        for (int k = 0; k < 2; ++k) {
            const int e = (ee >> (8 * k)) & 0xff; const float gk = RTG[2 * t + k];
            const float* wg = w.wg + (size_t)e * DM * DE + c.tid; const float* wu = w.wu + (size_t)e * DM * DE + c.tid;
            float ga = 0.f, ua = 0.f;
            for (int i = 0; i < DM; ++i) { const float xv = xs[i]; ga += xv * wg[(size_t)i * DE]; ua += xv * wu[(size_t)i * DE]; }
            __syncthreads();
            hs[c.tid] = siluf_(ga) * ua;
            __syncthreads();
            const float* wd = w.wd + (size_t)e * DE * DM + c.tid;
            float y0 = 0.f, y1 = 0.f;
            for (int i = 0; i < DE; ++i) { const float hv = hs[i]; y0 += hv * wd[(size_t)i * DM]; y1 += hv * wd[(size_t)i * DM + 512]; }
            f0 += gk * y0; f1 += gk * y1;
        }
        F[(size_t)t * DM + c.tid] = f0; F[(size_t)t * DM + c.tid + 512] = f1;
    }
}
__device__ __forceinline__ void nv_ln2(const Ctx& c, const Lw& w, const float* X1, const float* F, float* X2, bf16* XB) {
    for (int t = c.gw; t < M; t += c.ngw) {
        f32x4 v[4];
#pragma unroll
        for (int j = 0; j < 4; ++j) v[j] = ALPHA * *(const f32x4*)(X1 + (size_t)t * DM + c.lane * 4 + 256 * j) + *(const f32x4*)(F + (size_t)t * DM + c.lane * 4 + 256 * j);
        ln1024(v, w.ln2_g, w.ln2_b, c.lane);
#pragma unroll
        for (int j = 0; j < 4; ++j) { *(f32x4*)(X2 + (size_t)t * DM + c.lane * 4 + 256 * j) = v[j]; st_bf4(XB + (size_t)t * DM + c.lane * 4 + 256 * j, v[j]); }
    }
}

namespace pg8 {
#define PG8_LAS __attribute__((address_space(3)))
typedef unsigned short bf16_t;
typedef short bf16x8 __attribute__((ext_vector_type(8)));
typedef float f32x4 __attribute__((ext_vector_type(4)));
typedef unsigned u32x4 __attribute__((ext_vector_type(4)));
constexpr int BM = 256, BK = 64, HALF = 128, HTB = HALF * BK * 2  , STAGE_BYTES = 8 * HTB, NXCD = 8, WGM = 8;

__host__ __device__ __forceinline__ int lds_byte(int r, int c) { const int st = (r >> 4) * 2 + (c >> 5), rr = r & 15, cc = c & 31, ob = rr * 64 + cc * 2; return st * 1024 + (ob ^ (((ob >> 9) & 1) << 5)); }
__host__ __device__ __forceinline__ void stage_rc(int b, int& R, int& C) { const int st = b / 1024, sb = b % 1024, swz = sb ^ (((sb >> 9) & 1) << 5); R = (st >> 1) * 16 + swz / 64; C = (st & 1) * 32 + (swz % 64) / 2; }
__host__ __device__ __forceinline__ int perm32(int rho) { const int n = rho >> 4, i = rho & 15; return 8 * (i >> 2) + 4 * n + (i & 3); }

struct Unit { int pm, pn; };
struct Gemm { const bf16_t* A; const bf16_t* Bt; int M, N, K; };

struct StaticOrder {
    int nM, nN, nwg, G, c;
    __host__ __device__ void init(int M, int N, int G_, int c_) { nM = M / BM; nN = N / BM; nwg = nM * nN; G = G_; c = c_; }
    __host__ __device__ bool next(int i, Unit& u) const {
        const long L = (long)i * G + c; if (L >= nwg) return false;
        int wgid = (int)L; { const int q = nwg / NXCD, r = nwg % NXCD, xcd = wgid % NXCD, off = wgid / NXCD; wgid = (xcd < r ? xcd * (q + 1) : r * (q + 1) + (xcd - r) * q) + off; }
        const int nig = WGM * nN, gid = wgid / nig, fm = gid * WGM, gsz = (nM - fm) < WGM ? (nM - fm) : WGM;
        u.pm = fm + ((wgid % nig) % gsz); u.pn = (wgid % nig) / gsz; return true;
    }
    __device__ __forceinline__ void a_ready(const Unit&) const {}
    __device__ __forceinline__ void done(const Unit&) const {}
};

__device__ __forceinline__ unsigned cvt_pk_bf16(float lo, float hi) { unsigned r; asm volatile("v_cvt_pk_bf16_f32 %0, %1, %2" : "=v"(r) : "v"(lo), "v"(hi)); return r; }
typedef float f32x2 __attribute__((ext_vector_type(2)));
__device__ __forceinline__ f32x2 gelu_pk(f32x2 v) {
    const f32x2 av = __builtin_elementwise_abs(v), d = av * 0.2316418882f + 1.0f;
    f32x2 t; t.x = __builtin_amdgcn_rcpf(d.x); t.y = __builtin_amdgcn_rcpf(d.y);
    f32x2 q = t * 0.5307027145f + (-0.7265760135f); q = q * t + 0.7107068705f; q = q * t + (-0.142248368f); q = q * t + 0.127414796f; q = q * t;
    const f32x2 s = (v * v) * (-0.72134752044f);
    f32x2 e; e.x = __builtin_amdgcn_exp2f(s.x); e.y = __builtin_amdgcn_exp2f(s.y);
    const f32x2 m = v * (q * e), r = v - m;
    f32x2 o; o.x = v.x < 0.f ? m.x : r.x; o.y = v.y < 0.f ? m.y : r.y; return o;
}

template <int ACT  > struct EpiBf16 {
    static constexpr bool PERM = true, AFTER_DRAIN = false; static_assert(ACT == 0 || ACT == 1, "EpiBf16: ACT is 0 (none) or 1 (gelu_pk)");
    bf16_t* O; int ldc; const float* bias; int split_cols; size_t split_stride; float scale0; int pn_mask;
    __device__ __forceinline__ void operator()(const f32x4 (&acc)[2][2][4][2], const Unit& u, int wr, int wc, int fr, int fq) const {
        const int row0 = u.pm * BM + wr * 64 + fr; int colt = (u.pn & pn_mask) * BM; bf16_t* base = O;
        float sc = 1.f; if (split_cols) { const int t = colt / split_cols; base += (size_t)t * split_stride; colt -= t * split_cols; if (t == 0) sc = scale0; }
        const int col0 = colt + wc * 32 + 8 * fq, bcol0 = (u.pn & pn_mask) * BM + wc * 32 + 8 * fq;
        f32x4 bv[2][2];
#pragma unroll
        for (int bj = 0; bj < 2; ++bj)
#pragma unroll
            for (int n = 0; n < 2; ++n) bv[bj][n] = bias ? *(const f32x4*)(bias + bcol0 + bj * HALF + 4 * n) : (f32x4){0.f, 0.f, 0.f, 0.f};
#pragma unroll
        for (int ai = 0; ai < 2; ++ai)
#pragma unroll
            for (int m = 0; m < 4; ++m) { bf16_t* rowp = base + (size_t)(row0 + ai * HALF + m * 16) * ldc + col0;
#pragma unroll
                for (int bj = 0; bj < 2; ++bj) { f32x4 v0 = acc[ai][bj][m][0] + bv[bj][0], v1 = acc[ai][bj][m][1] + bv[bj][1];
                    if (ACT == 1) { f32x2 a = gelu_pk((f32x2){v0[0], v0[1]}), b = gelu_pk((f32x2){v0[2], v0[3]}), c = gelu_pk((f32x2){v1[0], v1[1]}), d = gelu_pk((f32x2){v1[2], v1[3]});
                        v0 = (f32x4){a.x, a.y, b.x, b.y}; v1 = (f32x4){c.x, c.y, d.x, d.y}; }
                    v0 = v0 * sc; v1 = v1 * sc; u32x4 w; w.x = cvt_pk_bf16(v0[0], v0[1]); w.y = cvt_pk_bf16(v0[2], v0[3]); w.z = cvt_pk_bf16(v1[0], v1[1]); w.w = cvt_pk_bf16(v1[2], v1[3]);
                    *(u32x4*)(rowp + bj * HALF) = w; } }
    }
};


struct EpiResF32 {
    static constexpr bool PERM = false, AFTER_DRAIN = false;
    const float* X; float* U; float alpha;
    __device__ __forceinline__ void operator()(const f32x4 (&acc)[2][2][4][2], const Unit& u, int wr, int wc, int fr, int fq) const {
        const int col0 = u.pn * BM + wc * 32 + 4 * fq;
#pragma unroll
        for (int ai = 0; ai < 2; ++ai)
#pragma unroll
            for (int m = 0; m < 4; ++m) { const size_t off = (size_t)(u.pm * BM + ai * HALF + wr * 64 + m * 16 + fr) * 1024 + col0;
#pragma unroll
                for (int bj = 0; bj < 2; ++bj)
#pragma unroll
                    for (int n = 0; n < 2; ++n) *(f32x4*)(U + off + bj * HALF + n * 16) = acc[ai][bj][m][n] + alpha * *(const f32x4*)(X + off + bj * HALF + n * 16); }
    }
};

struct MoeOrder {
    const PG8_LAS int* ts; int G, c;
    __device__ __forceinline__ bool next(int i, Unit& u) const {
        const int L = i * G + c; if (L >= __builtin_amdgcn_readfirstlane(ts[16]) * 4) return false;
        const int rt = L >> 2; int e = 0;
#pragma unroll
        for (int k = 1; k < 16; ++k) e += (rt >= ts[k]) ? 1 : 0;
        u.pm = rt; u.pn = __builtin_amdgcn_readfirstlane(e) * 4 + (L & 3); return true;
    }
    __device__ __forceinline__ void a_ready(const Unit&) const {}
    __device__ __forceinline__ void done(const Unit&) const {}
};
struct EpiSwiGLU {
    static constexpr bool PERM = true, AFTER_DRAIN = false;
    bf16_t* H;
    __device__ __forceinline__ void operator()(const f32x4 (&acc)[2][2][4][2], const Unit& u, int wr, int wc, int fr, int fq) const {
        const int row0 = u.pm * BM + wr * 64 + fr, col0 = (u.pn & 3) * HALF + wc * 32 + 8 * fq;
#pragma unroll
        for (int ai = 0; ai < 2; ++ai)
#pragma unroll
            for (int m = 0; m < 4; ++m) {
                u32x4 w4;
#pragma unroll
                for (int n = 0; n < 2; ++n) {
                    const f32x4 g = acc[ai][0][m][n], up = acc[ai][1][m][n]; f32x4 h;
#pragma unroll
                    for (int q = 0; q < 4; ++q) h[q] = g[q] * __builtin_amdgcn_rcpf(1.0f + __builtin_amdgcn_exp2f(-1.44269504089f * g[q])) * up[q];
                    w4[2 * n] = cvt_pk_bf16(h[0], h[1]); w4[2 * n + 1] = cvt_pk_bf16(h[2], h[3]);
                }
                *(u32x4*)(H + (size_t)(row0 + ai * HALF + m * 16) * 512 + col0) = w4;
            }
    }
};
template <class Epi, class Sched, bool ALIGN_EPI = false, bool SP2 = false, bool GATHER = false>
__device__ __forceinline__ void gemm_phase(PG8_LAS unsigned char* lds, const Gemm g, const Sched& S, const Epi& E, const int tid, const PG8_LAS int* idx = nullptr) {
    static_assert(!GATHER || SP2, "GATHER is implemented for the SP2 loop only");
    const int wid = __builtin_amdgcn_readfirstlane(tid >> 6), lane = tid & 63, wr = wid >> 2, wc = wid & 3, fr = lane & 15, fq = lane >> 4;
    const int K = g.K, nt = K / BK;
    unsigned voffA[2], voffB[2]; int RA[2], CA[2];
#pragma unroll
    for (int i = 0; i < 2; ++i) { int R, C; stage_rc(tid * 16 + i * 8192, R, C); const int Rb = Epi::PERM ? ((R & ~31) + perm32(R & 31)) : R; RA[i] = R; CA[i] = C;
        voffA[i] = (unsigned)(R * K + C) * 2u; voffB[i] = (unsigned)(Rb * K + C) * 2u; }
    unsigned gA[2][2], gN[2][2], gS[2][2];
#define PG8_GIDX(dst, u_) do { _Pragma("unroll") for (int _h = 0; _h < 2; ++_h) _Pragma("unroll") for (int _i = 0; _i < 2; ++_i) dst[_h][_i] = (unsigned)idx[(u_) * 256 + _h * HALF + RA[_i]] * (unsigned)(K * 2) + (unsigned)(CA[_i] * 2); } while (0)
#define PG8_STAGE_AC(bufoff, gbase, h) do { if constexpr (GATHER) PG8_STAGE(bufoff, gbase, gA[h]); else PG8_STAGE(bufoff, (gbase) + (h) * hstep, voffA); } while (0)
#define PG8_STAGE_AS(bufoff, gbase, h) do { if constexpr (GATHER) PG8_STAGE(bufoff, gbase, gS[h]); else PG8_STAGE(bufoff, (gbase) + (h) * hstep, voffA); } while (0)
    const size_t kstep = (size_t)(BK * 2);
    const size_t hstep = (size_t)HALF * K * 2;
    const size_t tstep = 2 * hstep;
    const unsigned ldsw = (unsigned)wid * 1024u;
    const int aoff = lds_byte(wr * 64 + fr, fq * 8), boff = lds_byte(wc * 32 + fr, fq * 8);
#define PG8_SA(b, h) (((b) * 2 + (h)) * HTB)
#define PG8_SB(b, h) ((4 + (b) * 2 + (h)) * HTB)
#define PG8_STAGE(bufoff, gbase, voff) do { _Pragma("unroll") for (int _i = 0; _i < 2; ++_i) \
        __builtin_amdgcn_global_load_lds((const unsigned*)((const char*)(gbase) + (voff)[_i]), (PG8_LAS unsigned*)(lds + (bufoff) + ldsw + _i * 8192), 16, 0, 0); } while (0)
#define PG8_LDA(dst, b, h) do { _Pragma("unroll") for (int m = 0; m < 4; ++m) _Pragma("unroll") for (int k = 0; k < 2; ++k) dst[m][k] = *(const PG8_LAS bf16x8*)(lds + PG8_SA(b, h) + aoff + m * 2048 + k * 1024); } while (0)
#define PG8_LDB(dst, b, h) do { _Pragma("unroll") for (int n = 0; n < 2; ++n) _Pragma("unroll") for (int k = 0; k < 2; ++k) dst[n][k] = *(const PG8_LAS bf16x8*)(lds + PG8_SB(b, h) + boff + n * 2048 + k * 1024); } while (0)
#define PG8_MMA(ai, bj, At, Bt) do { __builtin_amdgcn_s_setprio(1); _Pragma("unroll") for (int m = 0; m < 4; ++m) _Pragma("unroll") for (int n = 0; n < 2; ++n) _Pragma("unroll") for (int k = 0; k < 2; ++k) \
        acc[ai][bj][m][n] = __builtin_amdgcn_mfma_f32_16x16x32_bf16(Bt[n][k], At[m][k], acc[ai][bj][m][n], 0, 0, 0); __builtin_amdgcn_s_setprio(0); } while (0)
#define PG8_WAIT_V(n) asm volatile("s_waitcnt vmcnt(" #n ")" ::: "memory")
#define PG8_WAIT_L(n) asm volatile("s_waitcnt lgkmcnt(" #n ")" ::: "memory")
#define PG8_BAR __builtin_amdgcn_s_barrier()
#define PG8_SCHED __builtin_amdgcn_sched_barrier(0)
    Unit cur, nxt; int ui = 0;
    if (!S.next(0, cur)) return;
    f32x4 acc[2][2][4][2];
#pragma unroll
    for (int a = 0; a < 2; ++a)
#pragma unroll
        for (int b = 0; b < 2; ++b)
#pragma unroll
            for (int m = 0; m < 4; ++m)
#pragma unroll
                for (int n = 0; n < 2; ++n) acc[a][b][m][n] = (f32x4){0.f, 0.f, 0.f, 0.f};
    bf16x8 At[4][2], B0[2][2], B1[2][2];
    const char* cA = (const char*)g.A + (GATHER ? (size_t)0 : (size_t)cur.pm * tstep); const char* cB = (const char*)g.Bt + (size_t)cur.pn * tstep;
    if constexpr (GATHER) PG8_GIDX(gA, 0);
    S.a_ready(cur);
    if constexpr (SP2) {
        PG8_STAGE(PG8_SB(0, 0), cB, voffB); PG8_STAGE(PG8_SB(0, 1), cB + hstep, voffB); PG8_STAGE_AC(PG8_SA(0, 0), cA, 0); PG8_STAGE_AC(PG8_SA(0, 1), cA, 1);
        if (wr == 1) PG8_BAR;
        PG8_WAIT_V(2); PG8_BAR;
        PG8_STAGE(PG8_SB(1, 0), cB + kstep, voffB); PG8_STAGE_AC(PG8_SA(1, 0), cA + kstep, 0); PG8_STAGE(PG8_SB(1, 1), cB + hstep + kstep, voffB);
        PG8_WAIT_V(6); PG8_BAR;
    } else {
        PG8_STAGE(PG8_SB(0, 0), cB, voffB); PG8_STAGE(PG8_SA(0, 0), cA, voffA); PG8_STAGE(PG8_SB(0, 1), cB + hstep, voffB); PG8_STAGE(PG8_SA(0, 1), cA + hstep, voffA);
        if (wr == 1) PG8_BAR;
        PG8_WAIT_V(4); PG8_BAR;
        PG8_STAGE(PG8_SB(1, 0), cB + kstep, voffB); PG8_STAGE(PG8_SA(1, 0), cA + kstep, voffA); PG8_STAGE(PG8_SB(1, 1), cB + hstep + kstep, voffB);
        PG8_WAIT_V(6); PG8_BAR;
    }
    for (;;) {
        const bool has_next = S.next(ui + 1, nxt);
        if constexpr (GATHER) { if (has_next) PG8_GIDX(gN, ui + 1); else {
#pragma unroll
            for (int _h = 0; _h < 2; ++_h) { gN[_h][0] = gA[_h][0]; gN[_h][1] = gA[_h][1]; } } }
        const char* nA = (has_next && !GATHER) ? (const char*)g.A + (size_t)nxt.pm * tstep : cA; const char* nB = has_next ? (const char*)g.Bt + (size_t)nxt.pn * tstep : cB;
        for (int t = 0; t < nt; t += 2) {
            const bool last = (t == nt - 2);
            const char* a1 = cA + (size_t)(t + 1) * kstep;
            const char* a2 = last ? nA : cA + (size_t)(t + 2) * kstep; const char* b2 = last ? nB : cB + (size_t)(t + 2) * kstep;
            const char* a3 = a2 + kstep; const char* b3 = b2 + kstep;
            if (last && has_next) S.a_ready(nxt);
            if constexpr (GATHER) {
#pragma unroll
                for (int _h = 0; _h < 2; ++_h) { gS[_h][0] = last ? gN[_h][0] : gA[_h][0]; gS[_h][1] = last ? gN[_h][1] : gA[_h][1]; } }
            if constexpr (SP2) {
            PG8_LDB(B0, 0, 0); PG8_LDB(B1, 0, 1); PG8_SCHED; PG8_LDA(At, 0, 0); PG8_STAGE_AC(PG8_SA(1, 1), a1, 1);
            PG8_WAIT_V(8); PG8_WAIT_L(0); PG8_BAR; PG8_MMA(0, 0, At, B0); PG8_MMA(0, 1, At, B1); PG8_BAR; PG8_SCHED;
            PG8_LDA(At, 0, 1); PG8_STAGE(PG8_SB(0, 0), b2, voffB); PG8_STAGE(PG8_SB(0, 1), b2 + hstep, voffB); PG8_STAGE_AS(PG8_SA(0, 0), a2, 0);
            PG8_WAIT_V(8); PG8_WAIT_L(0); PG8_BAR; PG8_MMA(1, 0, At, B0); PG8_MMA(1, 1, At, B1); PG8_BAR; PG8_SCHED;
            PG8_LDB(B0, 1, 0); PG8_LDB(B1, 1, 1); PG8_SCHED; PG8_LDA(At, 1, 0); PG8_STAGE_AS(PG8_SA(0, 1), a2, 1);
            PG8_WAIT_V(8); PG8_WAIT_L(0); PG8_BAR; PG8_MMA(0, 0, At, B0); PG8_MMA(0, 1, At, B1); PG8_BAR; PG8_SCHED;
            PG8_LDA(At, 1, 1); PG8_STAGE(PG8_SB(1, 0), b3, voffB); PG8_STAGE(PG8_SB(1, 1), b3 + hstep, voffB); PG8_STAGE_AS(PG8_SA(1, 0), a3, 0);
            PG8_WAIT_V(8); PG8_WAIT_L(0); PG8_BAR; PG8_MMA(1, 0, At, B0); PG8_MMA(1, 1, At, B1); PG8_BAR; PG8_SCHED;
            } else {
            PG8_LDB(B0, 0, 0); PG8_SCHED; PG8_LDA(At, 0, 0); PG8_STAGE(PG8_SA(1, 1), a1 + hstep, voffA);
            PG8_WAIT_L(8); PG8_BAR; PG8_WAIT_L(0); PG8_MMA(0, 0, At, B0); PG8_BAR; PG8_SCHED;
            PG8_LDB(B1, 0, 1); PG8_STAGE(PG8_SB(0, 0), b2, voffB);
            PG8_BAR; PG8_WAIT_L(0); PG8_MMA(0, 1, At, B1); PG8_BAR;
            PG8_LDA(At, 0, 1); PG8_STAGE(PG8_SA(0, 0), a2, voffA);
            PG8_BAR; PG8_WAIT_L(0); PG8_MMA(1, 0, At, B0); PG8_BAR; PG8_SCHED;
            PG8_STAGE(PG8_SB(0, 1), b2 + hstep, voffB);
            PG8_WAIT_V(6); PG8_BAR; PG8_MMA(1, 1, At, B1); PG8_BAR;
            PG8_LDB(B0, 1, 0); PG8_SCHED; PG8_LDA(At, 1, 0); PG8_STAGE(PG8_SA(0, 1), a2 + hstep, voffA);
            PG8_WAIT_L(8); PG8_BAR; PG8_WAIT_L(0); PG8_MMA(0, 0, At, B0); PG8_BAR; PG8_SCHED;
            PG8_LDB(B1, 1, 1); PG8_STAGE(PG8_SB(1, 0), b3, voffB);
            PG8_BAR; PG8_WAIT_L(0); PG8_MMA(0, 1, At, B1); PG8_BAR;
            PG8_LDA(At, 1, 1); PG8_STAGE(PG8_SA(1, 0), a3, voffA);
            PG8_BAR; PG8_WAIT_L(0); PG8_MMA(1, 0, At, B0); PG8_BAR; PG8_SCHED;
            PG8_STAGE(PG8_SB(1, 1), b3 + hstep, voffB);
            PG8_WAIT_V(6); PG8_BAR; PG8_MMA(1, 1, At, B1); PG8_BAR;
            }
        }
        if constexpr (ALIGN_EPI) { if (wr == 0) PG8_BAR; }
        if constexpr (!Epi::AFTER_DRAIN) { E(acc, cur, wr, wc, fr, fq); S.done(cur); }
        if (!has_next) break;
#pragma unroll
        for (int a = 0; a < 2; ++a)
#pragma unroll
            for (int b = 0; b < 2; ++b)
#pragma unroll
                for (int m = 0; m < 4; ++m)
#pragma unroll
                    for (int n = 0; n < 2; ++n) acc[a][b][m][n] = (f32x4){0.f, 0.f, 0.f, 0.f};
        cur = nxt; cA = nA; cB = nB; ++ui;
        if constexpr (GATHER) {
#pragma unroll
            for (int _h = 0; _h < 2; ++_h) { gA[_h][0] = gN[_h][0]; gA[_h][1] = gN[_h][1]; } }
        if constexpr (ALIGN_EPI) { if (wr == 1) PG8_BAR; }
    }
    PG8_WAIT_V(0);
    if constexpr (!ALIGN_EPI) { if (wr == 0) PG8_BAR; }
    PG8_BAR;
    if constexpr (Epi::AFTER_DRAIN) { E.fused(acc, cur, wr, wc, fr, fq, lds, wid, lane); S.done(cur); }
#undef PG8_SA
#undef PG8_GIDX
#undef PG8_STAGE_AC
#undef PG8_STAGE_AS
#undef PG8_SB
#undef PG8_STAGE
#undef PG8_LDA
#undef PG8_LDB
#undef PG8_MMA
#undef PG8_WAIT_V
#undef PG8_WAIT_L
#undef PG8_BAR
#undef PG8_SCHED
}
}


template <class Sched>
__device__ __forceinline__ void moe_idx_tables(const Ctx& c, const Sched& S, const unsigned* CNT, const int* LIST) {
    const LAS int* ts = (const LAS int*)(c.lds + LDS_TAB_OFF); LAS int* idx = (LAS int*)(c.lds + LDS_IDX_OFF);
    for (int i = 0; i < MAX_UNITS; ++i) {
        pg8::Unit u; if (!S.next(i, u)) break;
        const int e = u.pn >> 2, lt = u.pm - ts[e]; const int cnt = (int)CNT[e];
        if (c.tid < 256) { const int p = lt * 256 + c.tid; idx[i * 256 + c.tid] = (p < cnt) ? LIST[e * M + p] : 0; }
    }
    __syncthreads();
}
struct TItem { const float* src; bf16* dst; int N, K; };
__device__ __forceinline__ TItem titem(const Args& a, unsigned char* ws, int it) {
    constexpr int I_IN = NL * 16 * 64, I_O = NL * 16 * 32, I_G = NL * NE * 16 * 16;
    TItem t; int r = it;
    if (r < I_IN) { const int l = r >> 10, kb = (r >> 6) & 15, nb = r & 63; t.N = DIN; t.K = DM; t.src = a.in[1] + (size_t)l * DM * DIN + (size_t)(kb * 64) * DIN + nb * 32; t.dst = (bf16*)(ws + WS_WIN) + (size_t)(l * DIN + nb * 32) * DM + kb * 64; return t; } r -= I_IN;
    if (r < I_O) { const int l = r >> 9, kb = (r >> 5) & 15, nb = r & 31; t.N = DM; t.K = DM; t.src = a.in[15] + (size_t)l * DM * DM + (size_t)(kb * 64) * DM + nb * 32; t.dst = (bf16*)(ws + WS_WO) + (size_t)(l * DM + nb * 32) * DM + kb * 64; return t; } r -= I_O;
    if (r < 2 * I_G) { const int up = r >= I_G; if (up) r -= I_G; const int le = r >> 8, kb = (r >> 4) & 15, nb = r & 15, n0 = nb * 32;
        t.N = DE; t.K = DM; t.src = a.in[up ? 21 : 20] + (size_t)le * DM * DE + (size_t)(kb * 64) * DE + n0; t.dst = (bf16*)(ws + WS_WGU) + (size_t)(le * 1024 + (n0 >> 7) * 256 + (n0 & 127) + up * 128) * DM + kb * 64; return t; } r -= 2 * I_G;
    { const int le = r >> 8, kb = (r >> 5) & 7, nb = r & 31; t.N = DM; t.K = DE; t.src = a.in[22] + (size_t)le * DE * DM + (size_t)(kb * 64) * DM + nb * 32; t.dst = (bf16*)(ws + WS_WD) + (size_t)(le * 1024 + nb * 32) * DE + kb * 64; }
    return t;
}
__device__ __forceinline__ void titem_load(const TItem& t, float (&tv)[32], int lane) {
#pragma unroll
    for (int i = 0; i < 32; ++i) tv[i] = t.src[(size_t)(2 * i + (lane >> 5)) * t.N + (lane & 31)];
}
__device__ __forceinline__ void titem_store(const TItem& t, const float (&tv)[32], LAS float* scr, int lane) {
#pragma unroll
    for (int i = 0; i < 32; ++i) scr[(2 * i + (lane >> 5)) * 33 + (lane & 31)] = tv[i];
    asm volatile("s_waitcnt lgkmcnt(0)" ::: "memory");
    const int cc = lane & 7;
#pragma unroll
    for (int j = 0; j < 4; ++j) { const int n = (lane >> 3) + 8 * j; const LAS float* s = scr + (8 * cc) * 33 + n;
        u32x4 o; o.x = pk2(s[0 * 33], s[1 * 33]); o.y = pk2(s[2 * 33], s[3 * 33]); o.z = pk2(s[4 * 33], s[5 * 33]); o.w = pk2(s[6 * 33], s[7 * 33]);
        *(u32x4*)(t.dst + (size_t)n * t.K + 8 * cc) = o; }
    asm volatile("s_waitcnt lgkmcnt(0)" ::: "memory");
}
__device__ __forceinline__ void weights_prologue(const Ctx& c, const Args& a, unsigned char* ws) {
    LAS float* scr = (LAS float*)(c.lds + c.wave * 16384);
    constexpr int NITEMS = NL * 16 * 64 + NL * 16 * 32 + 2 * NL * NE * 16 * 16 + NL * NE * 8 * 32;
    int it = c.gw;
    if (it >= NITEMS) return;
    float tvA[32], tvB[32];
    TItem A = titem(a, ws, it), B = A;
    titem_load(A, tvA, c.lane);
    for (;;) {
        const bool hasB = it + c.ngw < NITEMS;
        if (hasB) { B = titem(a, ws, it + c.ngw); titem_load(B, tvB, c.lane); }
        titem_store(A, tvA, scr, c.lane);
        if (!hasB) break;
        it += 2 * c.ngw;
        const bool hasA = it < NITEMS;
        if (hasA) { A = titem(a, ws, it); titem_load(A, tvA, c.lane); }
        titem_store(B, tvB, scr, c.lane);
        if (!hasA) break;
    }
}

constexpr int PH_PER_LAYER = 7, N_PHASES = 1 + NL * PH_PER_LAYER;
struct Ptrs { bf16 *XB, *Z, *YN, *X1B, *H, *YS, *XBn, *GMW, *PWT, *POOLT; float *U, *RTG; unsigned* RTE; int *RTP, *LIST; };
__device__ __forceinline__ Ptrs make_ptrs(unsigned char* ws, int L) {
    Ptrs p; unsigned char* Ra = ws + ((L & 1) ? WS_R2 : WS_R1); unsigned char* Rb = ws + ((L & 1) ? WS_R1 : WS_R2);
    p.XB = (bf16*)Ra; p.Z = (bf16*)Rb; p.YN = (bf16*)Ra; p.U = (float*)Rb; p.X1B = (bf16*)Ra; p.H = (bf16*)Rb; p.YS = (bf16*)Ra; p.XBn = (bf16*)Rb;
    p.GMW = (bf16*)(ws + WS_GMW); p.PWT = (bf16*)(ws + WS_PWT); p.POOLT = (bf16*)(ws + WS_POOLT);
    p.RTE = (unsigned*)(ws + WS_RT); p.RTG = (float*)(ws + WS_RT + 256 * 1024); p.RTP = (int*)(ws + WS_RT + 512 * 1024); p.LIST = (int*)(ws + WS_RT + MiB);
    return p;
}
template <int L>
__device__ __forceinline__ void run_layer(const Args& args, const Ctx& c0, const XcdBarrier& bar, const bool one, const int lo, const int hi) {
    constexpr int PB = 1 + L * PH_PER_LAYER;
    unsigned char* ws = args.ws;
    const Ptrs P = make_ptrs(ws, L);
    const float* X = (L == 0) ? args.in[0] : args.out;
    unsigned* CNT = (unsigned*)ws + CW_CNT + 64 * L;
#define IN(k) (lo <= PB + (k) && PB + (k) < hi)
#define PHASE_CTX Ctx c = c0; asm volatile("" : "+v"(c.tid)); c.lane = c.tid & 63; c.gtid = blockIdx.x * NT + c.tid
#define SEAM(k) do { if (one && PB + (k) + 1 < hi) xcd_barrier(bar); } while (0)
    if (IN(0)) { PHASE_CTX; pg8::Gemm g{P.XB, (const bf16*)(ws + WS_WIN) + (size_t)L * DIN * DM, M, DIN, DM}; pg8::StaticOrder S; S.init(M, DIN, (int)gridDim.x, (int)blockIdx.x);
        pg8::EpiBf16<0> E{P.Z, DIN, nullptr, 0, 0, 1.f, 0xffff};
        pg8::gemm_phase<pg8::EpiBf16<0>, pg8::StaticOrder, true, true>(c.lds, g, S, E, c.tid); SEAM(0); }
    if (IN(1)) { PHASE_CTX; const Lw w = layer_weights(args, L); for (int r = 0; r < RPT_MIX; ++r) mixer_phase(c, w, L, P.Z, P.GMW, P.PWT, P.POOLT, P.YN); SEAM(1); }
    if (IN(2)) { PHASE_CTX; pg8::Gemm g{P.YN, (const bf16*)(ws + WS_WO) + (size_t)L * DM * DM, M, DM, DM}; pg8::StaticOrder S; S.init(M, DM, (int)gridDim.x, (int)blockIdx.x);
        pg8::EpiResF32 E{X, P.U, ALPHA};
        pg8::gemm_phase<pg8::EpiResF32, pg8::StaticOrder, true, true>(c.lds, g, S, E, c.tid); SEAM(2); }
    if (IN(3)) { PHASE_CTX; const Lw w = layer_weights(args, L); for (int r = 0; r < RPT_LN1; ++r) nv_ln1_router(c, w, P.U, args.out, P.X1B, P.RTE, P.RTG); moe_ranks(c, P.RTE, P.RTP, CNT, P.LIST); SEAM(3); }
    if (IN(4)) { PHASE_CTX; moe_tiles(c, CNT); pg8::MoeOrder S{(const LAS int*)(c.lds + LDS_TAB_OFF), (int)gridDim.x, (int)blockIdx.x};
        moe_idx_tables(c, S, CNT, P.LIST);
        pg8::Gemm g{P.X1B, (const bf16*)(ws + WS_WGU) + (size_t)L * NE * 1024 * DM, 0, 0, DM};
        pg8::EpiSwiGLU E{P.H};
        pg8::gemm_phase<pg8::EpiSwiGLU, pg8::MoeOrder, true, true, true>(c.lds, g, S, E, c.tid, (const LAS int*)(c.lds + LDS_IDX_OFF)); SEAM(4); }
    if (IN(5)) { PHASE_CTX; moe_tiles(c, CNT); pg8::MoeOrder S{(const LAS int*)(c.lds + LDS_TAB_OFF), (int)gridDim.x, (int)blockIdx.x};
        pg8::Gemm g{P.H, (const bf16*)(ws + WS_WD) + (size_t)L * NE * 1024 * DE, 0, 0, DE};
        pg8::EpiBf16<0> E{P.YS, DM, nullptr, 0, 0, 1.f, 3};
        pg8::gemm_phase<pg8::EpiBf16<0>, pg8::MoeOrder, true, true>(c.lds, g, S, E, c.tid); SEAM(5); }
    if (IN(6)) { PHASE_CTX; const Lw w = layer_weights(args, L); moe_tiles(c, CNT); moe_combine_ln2(c, w, args.out, P.YS, P.RTE, P.RTG, P.RTP, args.out, P.XBn); SEAM(6); }
#undef IN
#undef SEAM
#undef PHASE_CTX
}
__global__ void __launch_bounds__(NT, 2) fwd_kernel(Args args) {
    extern __shared__ __attribute__((aligned(16))) unsigned char lds_raw[];
    Ctx c;
    c.lds = (LAS unsigned char*)lds_raw;
    c.tid = threadIdx.x; c.lane = c.tid & 63; c.wave = __builtin_amdgcn_readfirstlane(c.tid >> 6);
    c.gtid = blockIdx.x * NT + c.tid; c.gsize = gridDim.x * NT; c.gw = blockIdx.x * NWAVES + c.wave; c.ngw = gridDim.x * NWAVES;
    volatile LAS unsigned* MISC = (volatile LAS unsigned*)(c.lds + LDS_BYTES - 64);
    if (c.tid < 16) MISC[c.tid] = 0u;
    __syncthreads();
    XcdBarrier bar; bar.bar = (unsigned*)args.ws + CW_BAR; bar.x = 0; bar.st = nullptr;
    const int lo = args.ph_lo, hi = args.ph_hi;
    const bool one = (hi - lo) > 1;
    if (one) bar = xcd_barrier_post((unsigned*)args.ws + CW_BAR, MISC + 8);
    if (lo <= 0 && 0 < hi) {
        const Ptrs P = make_ptrs(args.ws, 0);
        Ctx c0 = c; asm volatile("" : "+v"(c.tid)); c.lane = c.tid & 63; c.gtid = blockIdx.x * NT + c.tid;
        for (int r = 0; r < RPT_PRO; ++r) { nv_prologue(c, args.in[0], P.XB); small_weights(c, args, P.GMW, P.PWT, P.POOLT); weights_prologue(c, args, args.ws); }
        if (one && 1 < hi) xcd_barrier(bar);
    }
    run_layer<0>(args, c, bar, one, lo, hi);
    run_layer<1>(args, c, bar, one, lo, hi);
}

extern "C" void kernel_launch(void* const* d_in, const int* in_sizes, int n_in, void* d_out, int out_size, void* d_ws, size_t ws_size, hipStream_t stream) {
    static int grid = 0;
    if (grid == 0) {
        if (n_in != 25 || in_sizes[0] != M * DM || out_size != M * DM || ws_size < WS_END) { fprintf(stderr, "kernel_launch: unexpected shapes/ws (n_in %d ws %zu)\n", n_in, ws_size); grid = -1; return; }
        int dev = 0, cus = 0;
        if (hipGetDevice(&dev) != hipSuccess || hipDeviceGetAttribute(&cus, hipDeviceAttributeMultiprocessorCount, dev) != hipSuccess) { grid = -1; return; }
        if (hipFuncSetAttribute((const void*)fwd_kernel, hipFuncAttributeMaxDynamicSharedMemorySize, LDS_BYTES) != hipSuccess) { grid = -1; return; }
        (void)hipGetLastError();
        grid = cus;
    }
    if (grid < 0) return;
    (void)hipMemsetAsync((char*)d_ws + WS_CTL, 0, CTL_ZERO_BYTES, stream);
    Args a{};
    for (int i = 0; i < 25; ++i) a.in[i] = (const float*)d_in[i];
    a.out = (float*)d_out; a.ws = (unsigned char*)d_ws;
#if MK_ONE_LAUNCH
    a.ph_lo = 0; a.ph_hi = N_PHASES;
    hipLaunchKernelGGL(fwd_kernel, dim3(grid), dim3(NT), LDS_BYTES, stream, a);
#else
    for (int ph = 0; ph < N_PHASES; ++ph) { a.ph_lo = ph; a.ph_hi = ph + 1; hipLaunchKernelGGL(fwd_kernel, dim3(grid), dim3(NT), LDS_BYTES, stream, a); }
#endif
}
```

```cpp
#include <hip/hip_runtime.h>
#include <cstdio>
#include <cstdint>

#ifndef RPT_PRO
#define RPT_PRO 1
#endif
#ifndef RPT_MIX
#define RPT_MIX 1
#endif
#ifndef RPT_LN1
#define RPT_LN1 1
#endif
#ifndef MK_ONE_LAUNCH
#define MK_ONE_LAUNCH 1
#endif

constexpr int NB = 4, SEQ = 4096, DM = 1024, M = NB * SEQ, DIN = 2048, NE = 16, DE = 512, NL = 2;
constexpr int DG = 256, CHUNK = 128, CONFK = 31;
constexpr float ALPHA = 1.41421356237309515f;
constexpr float LN_EPS = 1e-5f, RMS_EPS = 1e-6f;
constexpr int NWAVES = 8, NT = NWAVES * 64;
constexpr int LDS_BYTES = 147456;

typedef unsigned short bf16;
typedef float f32x4 __attribute__((ext_vector_type(4)));
typedef unsigned u32x4 __attribute__((ext_vector_type(4)));
typedef unsigned u32x2 __attribute__((ext_vector_type(2)));
#define LAS __attribute__((address_space(3)))
#define GAS __attribute__((address_space(1)))
typedef GAS unsigned gu32;
#define RLX_AGENT __ATOMIC_RELAXED, __HIP_MEMORY_SCOPE_AGENT

constexpr size_t MiB = 1u << 20;
constexpr size_t WS_CTL = 0, CTL_ZERO_BYTES = 1 * MiB;
constexpr size_t WS_WIN = 1 * MiB;
constexpr size_t WS_WO = 9 * MiB;
constexpr size_t WS_WGU = 13 * MiB;
constexpr size_t WS_WD = 77 * MiB;
constexpr size_t WS_SMALL = 109 * MiB;
constexpr size_t WS_GMW = WS_SMALL, WS_PWT = WS_SMALL + 256 * 1024, WS_POOLT = WS_SMALL + 512 * 1024;
constexpr size_t WS_R1 = 110 * MiB;
constexpr size_t WS_R2 = 182 * MiB;
constexpr size_t WS_RT = 254 * MiB;
constexpr size_t WS_END = 256 * MiB;
constexpr int CW_BAR = 4096;

__device__ __forceinline__ float bf2f(bf16 v) { return __uint_as_float(((unsigned)v) << 16); }
__device__ __forceinline__ unsigned f2bf(float f) { unsigned u = __float_as_uint(f); return (u + 0x7fffu + ((u >> 16) & 1u)) >> 16; }
__device__ __forceinline__ unsigned pk2(float lo, float hi) { return f2bf(lo) | (f2bf(hi) << 16); }
__device__ __forceinline__ float sigmoidf_(float x) { return __builtin_amdgcn_rcpf(1.0f + __builtin_amdgcn_exp2f(-1.44269504089f * x)); }
__device__ __forceinline__ float siluf_(float x) { return x * sigmoidf_(x); }
__device__ __forceinline__ float dpp_add(float v, const int ctrl_sel) {
    int t;
    if (ctrl_sel == 0) t = __builtin_amdgcn_update_dpp(0, __builtin_bit_cast(int, v), 0xB1, 0xf, 0xf, true);
    else if (ctrl_sel == 1) t = __builtin_amdgcn_update_dpp(0, __builtin_bit_cast(int, v), 0x4E, 0xf, 0xf, true);
    else if (ctrl_sel == 2) t = __builtin_amdgcn_update_dpp(0, __builtin_bit_cast(int, v), 0x141, 0xf, 0xf, true);
    else t = __builtin_amdgcn_update_dpp(0, __builtin_bit_cast(int, v), 0x140, 0xf, 0xf, true);
    return v + __builtin_bit_cast(float, t);
}
__device__ __forceinline__ float wave_sum(float v) {
    v = dpp_add(v, 0); v = dpp_add(v, 1); v = dpp_add(v, 2); v = dpp_add(v, 3);
    const int iv = __builtin_bit_cast(int, v);
    const float s0 = __builtin_bit_cast(float, __builtin_amdgcn_readlane(iv, 0)), s1 = __builtin_bit_cast(float, __builtin_amdgcn_readlane(iv, 16));
    const float s2 = __builtin_bit_cast(float, __builtin_amdgcn_readlane(iv, 32)), s3 = __builtin_bit_cast(float, __builtin_amdgcn_readlane(iv, 48));
    return (s0 + s1) + (s2 + s3);
}

#define XB_TMO      128
#define XB_XCNT(j)  (256  + 64 * (j))
#define XB_XSUB(j)  (1280 + 64 * (j))
#define XB_XGEN(j)  (2304 + 64 * (j))
#define XB_TOP      3328
#define XB_TOPGEN   3392
#define XCD_BAR_WORDS 3456
#define XB_SPIN_CAP (1u << 18)
__device__ __forceinline__ unsigned xb_ld(unsigned* p)              { return __hip_atomic_load(p, __ATOMIC_RELAXED, __HIP_MEMORY_SCOPE_AGENT); }
__device__ __forceinline__ unsigned xb_add(unsigned* p, unsigned v) { return __hip_atomic_fetch_add(p, v, __ATOMIC_RELAXED, __HIP_MEMORY_SCOPE_AGENT); }
__device__ __forceinline__ unsigned xb_xcc_id() { return (unsigned)__builtin_amdgcn_s_getreg((3 << 11) | 20) & 0xFu; }
#define XB_SPIN(cond, bar) do { unsigned _sp = 0; while (cond) { __builtin_amdgcn_s_sleep(1); \
    if ((++_sp & 255u) == 0u) { if (xb_ld(&(bar)[XB_TMO])) break; if (_sp > XB_SPIN_CAP) { atomicAdd(&(bar)[XB_TMO], 1u); break; } } } } while (0)
struct XcdBarrier { unsigned* bar; unsigned x; volatile LAS unsigned* st; };
__device__ __forceinline__ XcdBarrier xcd_barrier_post(unsigned* bar, volatile LAS unsigned* st) {
    XcdBarrier b; b.bar = bar; b.x = xb_xcc_id(); b.st = st;
    if (threadIdx.x == 0) (void)xb_add(&bar[XB_XCNT(b.x)], 1u);
    return b;
}
__device__ __forceinline__ void xcd_barrier_complete(unsigned* bar, unsigned x, unsigned& nloc, unsigned& nx) {
    const unsigned G = gridDim.x * gridDim.y * gridDim.z;
    unsigned sum, cnt, mine, sp = 0u;
    for (;;) {
        sum = 0u; cnt = 0u; mine = 0u;
#pragma unroll
        for (unsigned j = 0; j < 16; ++j) { const unsigned c = xb_ld(&bar[XB_XCNT(j)]); sum += c; cnt += (c > 0u) ? 1u : 0u; mine = (j == x) ? c : mine; }
        if (sum == G) break;
        __builtin_amdgcn_s_sleep(1);
        if ((++sp & 255u) == 0u) { if (xb_ld(&bar[XB_TMO])) break; if (sp > XB_SPIN_CAP) { atomicAdd(&bar[XB_TMO], 1u); break; } }
    }
    nloc = mine > 0u ? mine : 1u; nx = cnt > 0u ? cnt : 1u;
}
__device__ __forceinline__ void xcd_barrier(const XcdBarrier& b) {
    asm volatile("s_waitcnt vmcnt(0)" ::: "memory");
    __syncthreads();
    if (threadIdx.x == 0) {
        unsigned* bar = b.bar;
        __builtin_amdgcn_s_waitcnt(0);
        unsigned nloc = b.st[0], nx = b.st[1];
        if (nloc == 0u) { xcd_barrier_complete(bar, b.x, nloc, nx); b.st[0] = nloc; b.st[1] = nx; }
        const unsigned old = xb_add(&bar[XB_XSUB(b.x)], 1u);
        const unsigned gen = old / nloc;
        if (old + 1u == (gen + 1u) * nloc) {
            __builtin_amdgcn_fence(__ATOMIC_RELEASE, "agent");
            asm volatile("s_waitcnt vmcnt(0)" ::: "memory");
            const unsigned og = xb_add(&bar[XB_TOP], 1u);
            const unsigned tg = og / nx;
            if (og + 1u == (tg + 1u) * nx) xb_add(&bar[XB_TOPGEN], 1u);
            else XB_SPIN(xb_ld(&bar[XB_TOPGEN]) == tg, bar);
            __builtin_amdgcn_fence(__ATOMIC_ACQUIRE, "agent");
            xb_add(&bar[XB_XGEN(b.x)], 1u);
            asm volatile("s_waitcnt vmcnt(0)" ::: "memory");
        } else {
            XB_SPIN(xb_ld(&bar[XB_XGEN(b.x)]) == gen, bar);
            __builtin_amdgcn_fence(__ATOMIC_ACQUIRE, "agent");
            asm volatile("s_waitcnt vmcnt(0)" ::: "memory");
        }
    }
    __syncthreads();
}

struct Args { const float* in[25]; float* out; unsigned char* ws; int ph_lo, ph_hi; };

struct Ctx {
    int tid, lane, wave, gtid, gsize, gw, ngw;
    LAS unsigned char* lds;
};

template <class Epi>
__device__ __forceinline__ void nv_gemm(const Ctx& c, const bf16* A, int lda, const float* W, int ldw, int Mr, int N, int K, const Epi& epi) {
    const int ntn = N / 4; const long total = (long)ntn * (Mr / 4);
    for (long i = c.gtid; i < total; i += c.gsize) {
        const int tn = (int)(i % ntn), tm = (int)(i / ntn);
        float acc[4][4];
#pragma unroll
        for (int r = 0; r < 4; ++r)
#pragma unroll
            for (int q = 0; q < 4; ++q) acc[r][q] = 0.f;
        const bf16* a0 = A + (size_t)(tm * 4) * lda;
        const float* w0 = W + tn * 4;
        for (int k = 0; k < K; k += 8) {
            u32x4 av[4];
#pragma unroll
            for (int r = 0; r < 4; ++r) av[r] = *(const u32x4*)(a0 + (size_t)r * lda + k);
#pragma unroll
            for (int kk = 0; kk < 8; ++kk) {
                const f32x4 w = *(const f32x4*)(w0 + (size_t)(k + kk) * ldw);
#pragma unroll
                for (int r = 0; r < 4; ++r) {
                    const unsigned pr = av[r][kk >> 1];
                    const float a = (kk & 1) ? __uint_as_float(pr & 0xffff0000u) : __uint_as_float(pr << 16);
#pragma unroll
                    for (int q = 0; q < 4; ++q) acc[r][q] += a * w[q];
                }
            }
        }
#pragma unroll
        for (int r = 0; r < 4; ++r) epi(tm * 4 + r, tn * 4, (f32x4){acc[r][0], acc[r][1], acc[r][2], acc[r][3]});
    }
}

__device__ __forceinline__ void ln256(f32x4& v, const float* g, const float* b, int lane) {
    const float mean = wave_sum((v[0] + v[1]) + (v[2] + v[3])) * (1.f / 256.f);
    v = v - mean;
    const float var = wave_sum((v[0] * v[0] + v[1] * v[1]) + (v[2] * v[2] + v[3] * v[3])) * (1.f / 256.f);
    const float rstd = __builtin_amdgcn_rsqf(var + LN_EPS);
    const f32x4 gg = *(const f32x4*)(g + lane * 4), bb = *(const f32x4*)(b + lane * 4);
    v = v * rstd * gg + bb;
}
__device__ __forceinline__ f32x4 ld_bf4(const bf16* p) { const u32x2 w = *(const u32x2*)p; return (f32x4){__uint_as_float(w.x << 16), __uint_as_float(w.x & 0xffff0000u), __uint_as_float(w.y << 16), __uint_as_float(w.y & 0xffff0000u)}; }
__device__ __forceinline__ void st_bf4(bf16* p, f32x4 v) { u32x2 w; w.x = pk2(v[0], v[1]); w.y = pk2(v[2], v[3]); *(u32x2*)p = w; }

struct Lw {
    const float *w_in, *gm_ln_g, *gm_ln_b, *gm_w_s, *gm_b_s, *cf_dw_w, *cf_dw_b, *cf_ln_g, *cf_ln_b, *cf_pw, *pool_w, *pool_scale, *sc_w, *mix_norm_g, *w_o, *ln1_g, *ln1_b,
        *router_w, *router_b, *wg, *wu, *wd, *ln2_g, *ln2_b;
};
__device__ __forceinline__ Lw layer_weights(const Args& a, int l) {
    Lw w;
    w.w_in = a.in[1] + (size_t)l * DM * DIN; w.gm_ln_g = a.in[2] + l * DG; w.gm_ln_b = a.in[3] + l * DG; w.gm_w_s = a.in[4] + (size_t)l * 4 * CHUNK * CHUNK; w.gm_b_s = a.in[5] + l * 4 * CHUNK;
    w.cf_dw_w = a.in[6] + l * CONFK * DG; w.cf_dw_b = a.in[7] + l * DG; w.cf_ln_g = a.in[8] + l * DG; w.cf_ln_b = a.in[9] + l * DG; w.cf_pw = a.in[10] + (size_t)l * DG * DG;
    w.pool_w = a.in[11] + l * 4 * 64 * 64; w.pool_scale = a.in[12] + l * DG; w.sc_w = a.in[13] + l * 3 * DG; w.mix_norm_g = a.in[14] + l * DM; w.w_o = a.in[15] + (size_t)l * DM * DM;
    w.ln1_g = a.in[16] + l * DM; w.ln1_b = a.in[17] + l * DM; w.router_w = a.in[18]; w.router_b = a.in[19];
    w.wg = a.in[20] + (size_t)l * NE * DM * DE; w.wu = a.in[21] + (size_t)l * NE * DM * DE; w.wd = a.in[22] + (size_t)l * NE * DE * DM;
    w.ln2_g = a.in[23] + l * DM; w.ln2_b = a.in[24] + l * DM;
    return w;
}

__device__ __forceinline__ void nv_prologue(const Ctx& c, const float* x, bf16* XB) {
    constexpr size_t N4 = (size_t)M * DM / 4;
    for (size_t i0 = (size_t)c.gtid; i0 < N4; i0 += (size_t)c.gsize * 8) {
        f32x4 v[8];
#pragma unroll
        for (int j = 0; j < 8; ++j) { const size_t i = i0 + (size_t)j * c.gsize; if (i < N4) v[j] = *(const f32x4*)(x + i * 4); }
#pragma unroll
        for (int j = 0; j < 8; ++j) { const size_t i = i0 + (size_t)j * c.gsize; if (i < N4) st_bf4(XB + i * 4, v[j]); }
    }
}
typedef short bf16x8 __attribute__((ext_vector_type(8)));
__device__ __forceinline__ bf16x8 as_bf16x8(u32x4 v) { return __builtin_bit_cast(bf16x8, v); }
#define MFMA16(a, b, c) __builtin_amdgcn_mfma_f32_16x16x32_bf16((a), (b), (c), 0, 0, 0)
constexpr int YT_LD = 260;
constexpr int AT_LD = 264;
constexpr int VT_RS = 260;

__device__ __forceinline__ void small_weights(const Ctx& c, const Args& a, bf16* GMW, bf16* PWT, bf16* POOLT) {
    for (int i = c.gtid; i < NL * 4 * CHUNK * CHUNK; i += c.gsize) { const int s = i & 127, t = (i >> 7) & 127; GMW[i] = (bf16)((s <= t) ? f2bf(a.in[4][i]) : 0u); }
    for (int i = c.gtid; i < NL * DG * DG; i += c.gsize) { const int cc = i & 255, n = (i >> 8) & 255, l = i >> 16; PWT[i] = (bf16)f2bf(a.in[10][((size_t)l * DG + cc) * DG + n]); }
    for (int i = c.gtid; i < NL * 4 * 64 * 64; i += c.gsize) { const int d = i & 63, e = (i >> 6) & 63, lg = i >> 12; POOLT[i] = (bf16)f2bf(a.in[11][((size_t)lg * 64 + d) * 64 + e]); }
}

template <bool UMUL>
__device__ __forceinline__ void mix_final(const Ctx& c, const Lw& w, int t0, int grp, bf16* YN, const bf16* Z = nullptr) {
    const LAS float* YT = (const LAS float*)c.lds;
    const f32x4 g = *(const f32x4*)(w.mix_norm_g + grp * DG + c.lane * 4);
    u32x2 uu[16];
    if (UMUL) {
#pragma unroll
        for (int i = 0; i < 16; ++i) uu[i] = *(const u32x2*)(Z + (size_t)(t0 + c.wave * 16 + i) * DIN + c.lane * 4);
    }
#pragma unroll
    for (int i = 0; i < 16; ++i) {
        const int t = c.wave * 16 + i;
        f32x4 v = *(const LAS f32x4*)(YT + t * YT_LD + c.lane * 4);
        if (UMUL) v = v * (f32x4){__uint_as_float(uu[i].x << 16), __uint_as_float(uu[i].x & 0xffff0000u), __uint_as_float(uu[i].y << 16), __uint_as_float(uu[i].y & 0xffff0000u)};
        const float ms = wave_sum((v[0] * v[0] + v[1] * v[1]) + (v[2] * v[2] + v[3] * v[3])) * (1.f / 256.f);
        const float r = __builtin_amdgcn_rsqf(ms + RMS_EPS);
        st_bf4(YN + (size_t)(t0 + t) * DM + grp * DG + c.lane * 4, v * r * g);
    }
}

__device__ __forceinline__ void mix_conformer(const Ctx& c, const Lw& w, const bf16* Z, const bf16* PWT, int t0, bf16* YN) {
    LAS unsigned char* lds = c.lds;
    const int pos0 = t0 % SEQ;
    const int fr = c.lane & 15, fq = c.lane >> 4;
    bf16x8 Bf[2][8];
#pragma unroll
    for (int ct = 0; ct < 2; ++ct)
#pragma unroll
        for (int ks = 0; ks < 8; ++ks) Bf[ct][ks] = as_bf16x8(*(const u32x4*)(PWT + (size_t)(c.wave * 32 + ct * 16 + fr) * DG + ks * 32 + fq * 8));
    float wk[CONFK];
#pragma unroll
    for (int k = 0; k < CONFK; ++k) wk[k] = w.cf_dw_w[k * DG + (c.tid & 255)];
    const float b0 = w.cf_dw_b[c.tid & 255];
    const f32x4 lng = *(const f32x4*)(w.cf_ln_g + c.lane * 4), lnb = *(const f32x4*)(w.cf_ln_b + c.lane * 4);
    {
        const int c8 = (c.tid & 31) * 8, r0 = c.tid >> 5;
        u32x4 av[10], gv[10];
#pragma unroll
        for (int it = 0; it < 10; ++it) {
            const int r = r0 + 16 * it;
            av[it] = (u32x4){0u, 0u, 0u, 0u}; gv[it] = (u32x4){0u, 0u, 0u, 0u};
            if (r < 158 && pos0 + r - 30 >= 0) { const size_t zr = (size_t)(t0 + r - 30) * DIN; av[it] = *(const u32x4*)(Z + zr + 512 + c8); gv[it] = *(const u32x4*)(Z + zr + 768 + c8); }
        }
#pragma unroll
        for (int it = 0; it < 10; ++it) {
            const int r = r0 + 16 * it;
            if (r < 158) {
                u32x4 o;
#pragma unroll
                for (int j = 0; j < 4; ++j) {
                    const float a0 = __uint_as_float(av[it][j] << 16), a1 = __uint_as_float(av[it][j] & 0xffff0000u), g0 = __uint_as_float(gv[it][j] << 16), g1 = __uint_as_float(gv[it][j] & 0xffff0000u);
                    o[j] = pk2(a0 * sigmoidf_(g0), a1 * sigmoidf_(g1));
                }
                *(LAS u32x4*)(lds + r * 512 + c8 * 2) = o;
            }
        }
    }
    __syncthreads();
    constexpr int CT_OFF = 80896;
    {
        const int ch = c.tid & 255, tg = c.tid >> 8;
#pragma unroll 1
        for (int sb = 0; sb < 8; ++sb) {
            float acc[8];
#pragma unroll
            for (int j = 0; j < 8; ++j) acc[j] = b0;
            const int rb = tg * 64 + sb * 8;
#pragma unroll
            for (int r = 0; r < 38; ++r) {
                const float h0 = bf2f(*(const LAS bf16*)(lds + (rb + r) * 512 + ch * 2));
#pragma unroll
                for (int j = 0; j < 8; ++j) { const int k = r - j; if (k >= 0 && k < CONFK) acc[j] += wk[k] * h0; }
            }
#pragma unroll
            for (int j = 0; j < 8; ++j) *(LAS bf16*)(lds + CT_OFF + (rb + j) * 512 + ch * 2) = (bf16)f2bf(acc[j]);
        }
    }
    __syncthreads();
    {
        const f32x4 g = lng, b = lnb;
#pragma unroll 4
        for (int i = 0; i < 16; ++i) {
            const int t = c.wave * 16 + i;
            const u32x2 pv = *(const LAS u32x2*)(lds + CT_OFF + t * 512 + c.lane * 8);
            f32x4 v = (f32x4){__uint_as_float(pv.x << 16), __uint_as_float(pv.x & 0xffff0000u), __uint_as_float(pv.y << 16), __uint_as_float(pv.y & 0xffff0000u)};
            const float mean = wave_sum((v[0] + v[1]) + (v[2] + v[3])) * (1.f / 256.f);
            v = v - mean;
            const float var = wave_sum((v[0] * v[0] + v[1] * v[1]) + (v[2] * v[2] + v[3] * v[3])) * (1.f / 256.f);
            v = v * (__builtin_amdgcn_rsqf(var + LN_EPS)) * g + b;
            u32x2 o; o.x = pk2(siluf_(v[0]), siluf_(v[1])); o.y = pk2(siluf_(v[2]), siluf_(v[3]));
            *(LAS u32x2*)(lds + t * (AT_LD * 2) + c.lane * 8) = o;
        }
    }
    __syncthreads();
    {
        f32x4 C[8][2];
#pragma unroll
        for (int rt = 0; rt < 8; ++rt) { C[rt][0] = (f32x4){0.f, 0.f, 0.f, 0.f}; C[rt][1] = (f32x4){0.f, 0.f, 0.f, 0.f}; }
#pragma unroll
        for (int rt = 0; rt < 8; ++rt)
#pragma unroll
            for (int ks = 0; ks < 8; ++ks) {
                const bf16x8 Af = as_bf16x8(*(const LAS u32x4*)(lds + (rt * 16 + fr) * (AT_LD * 2) + (ks * 32 + fq * 8) * 2));
                C[rt][0] = MFMA16(Af, Bf[0][ks], C[rt][0]); C[rt][1] = MFMA16(Af, Bf[1][ks], C[rt][1]);
            }
        __syncthreads();
        LAS float* YT = (LAS float*)lds;
#pragma unroll
        for (int rt = 0; rt < 8; ++rt)
#pragma unroll
            for (int ct = 0; ct < 2; ++ct)
#pragma unroll
                for (int j = 0; j < 4; ++j) YT[(rt * 16 + fq * 4 + j) * YT_LD + c.wave * 32 + ct * 16 + fr] = C[rt][ct][j];
    }
    __syncthreads();
    mix_final<false>(c, w, t0, 1, YN);
}

__device__ __forceinline__ void mix_gmlp(const Ctx& c, const Lw& w, const bf16* Z, const bf16* GMW, int t0, bf16* YN) {
    LAS unsigned char* lds = c.lds;
    const int fr = c.lane & 15, fq = c.lane >> 4, h = c.wave >> 1, par = c.wave & 1;
    bf16x8 Af[4][4];
    float bsv[4][4];
#pragma unroll
    for (int i = 0; i < 4; ++i) {
#pragma unroll
        for (int ks = 0; ks <= i; ++ks) Af[i][ks] = as_bf16x8(*(const u32x4*)(GMW + ((size_t)(h * CHUNK + 16 * (par + 2 * i) + fr)) * CHUNK + ks * 32 + fq * 8));
#pragma unroll
        for (int j = 0; j < 4; ++j) bsv[i][j] = w.gm_b_s[h * CHUNK + 16 * (par + 2 * i) + fq * 4 + j];
    }
    {
        float g[4], b[4];
#pragma unroll
        for (int q = 0; q < 4; ++q) { g[q] = w.gm_ln_g[c.lane + 64 * q]; b[q] = w.gm_ln_b[c.lane + 64 * q]; }
        bf16 raw[16][4];
#pragma unroll
        for (int i = 0; i < 16; ++i)
#pragma unroll
            for (int q = 0; q < 4; ++q) raw[i][q] = Z[(size_t)(t0 + c.wave * 16 + i) * DIN + 256 + c.lane + 64 * q];
#pragma unroll
        for (int i = 0; i < 8; ++i) {
            const int s = c.wave * 16 + 2 * i;
            float v[2][4];
#pragma unroll
            for (int p = 0; p < 2; ++p) {
#pragma unroll
                for (int q = 0; q < 4; ++q) v[p][q] = bf2f(raw[2 * i + p][q]);
                const float mean = wave_sum((v[p][0] + v[p][1]) + (v[p][2] + v[p][3])) * (1.f / 256.f);
#pragma unroll
                for (int q = 0; q < 4; ++q) v[p][q] -= mean;
                const float var = wave_sum((v[p][0] * v[p][0] + v[p][1] * v[p][1]) + (v[p][2] * v[p][2] + v[p][3] * v[p][3])) * (1.f / 256.f);
                const float rstd = __builtin_amdgcn_rsqf(var + LN_EPS);
#pragma unroll
                for (int q = 0; q < 4; ++q) v[p][q] = v[p][q] * rstd * g[q] + b[q];
            }
#pragma unroll
            for (int q = 0; q < 4; ++q) *(LAS unsigned*)(lds + (c.lane + 64 * q) * VT_RS + s * 2) = pk2(v[0][q], v[1][q]);
        }
    }
    __syncthreads();
    bf16x8 Bf[4][4];
#pragma unroll
    for (int ct = 0; ct < 4; ++ct)
#pragma unroll
        for (int ks = 0; ks < 4; ++ks) {
            u32x4 t;
#pragma unroll
            for (int i = 0; i < 4; ++i) t[i] = *(const LAS unsigned*)(lds + (h * 64 + ct * 16 + fr) * VT_RS + (ks * 32 + fq * 8 + 2 * i) * 2);
            Bf[ct][ks] = as_bf16x8(t);
        }
    __syncthreads();
    LAS float* YT = (LAS float*)lds;
#pragma unroll
    for (int i = 0; i < 4; ++i) {
        const int R = par + 2 * i;
        f32x4 C[4];
#pragma unroll
        for (int ct = 0; ct < 4; ++ct) C[ct] = (f32x4){0.f, 0.f, 0.f, 0.f};
#pragma unroll
        for (int ks = 0; ks <= i; ++ks)
#pragma unroll
            for (int ct = 0; ct < 4; ++ct) C[ct] = MFMA16(Af[i][ks], Bf[ct][ks], C[ct]);
#pragma unroll
        for (int j = 0; j < 4; ++j) {
            const int t = 16 * R + fq * 4 + j; const float bs = bsv[i][j];
#pragma unroll
            for (int ct = 0; ct < 4; ++ct) YT[t * YT_LD + h * 64 + ct * 16 + fr] = C[ct][j] + bs;
        }
    }
    __syncthreads();
    mix_final<true>(c, w, t0, 0, YN, Z);
}

__device__ __forceinline__ void mix_pool(const Ctx& c, const Lw& w, const bf16* Z, const bf16* POOLT, int t0, bf16* YN) {
    LAS unsigned char* lds = c.lds;
    const int pos0 = t0 % SEQ;
    constexpr int PA_OFF = 73728;
    const int fr = c.lane & 15, fq = c.lane >> 4, g = c.wave >> 1, cb = (c.wave & 1) * 2;
    bf16x8 Bf[2][2]; float scv[2];
#pragma unroll
    for (int ct = 0; ct < 2; ++ct) { scv[ct] = w.pool_scale[g * 64 + (cb + ct) * 16 + fr];
#pragma unroll
        for (int ks = 0; ks < 2; ++ks) Bf[ct][ks] = as_bf16x8(*(const u32x4*)(POOLT + (size_t)(g * 64 + (cb + ct) * 16 + fr) * 64 + ks * 32 + fq * 8)); }
    {
        const int c8 = (c.tid & 31) * 8, r0 = c.tid >> 5;
        u32x4 zv[9];
#pragma unroll
        for (int it = 0; it < 9; ++it) { const int r = r0 + 16 * it; zv[it] = (u32x4){0u, 0u, 0u, 0u};
            if (r < 143 && pos0 + r - 15 >= 0) zv[it] = *(const u32x4*)(Z + (size_t)(t0 + r - 15) * DIN + 1024 + c8); }
#pragma unroll
        for (int it = 0; it < 9; ++it) { const int r = r0 + 16 * it; if (r < 143) *(LAS u32x4*)(lds + r * 512 + c8 * 2) = zv[it]; }
    }
    __syncthreads();
    {
        const int cp = c.tid & 127, tg = c.tid >> 7, W = 2 << (cp >> 5);
        float s0 = 0.f, s1 = 0.f;
        for (int i = 1; i < W; ++i) { const unsigned zv = *(const LAS unsigned*)(lds + (tg * 32 + 15 - i) * 512 + cp * 4); s0 += __uint_as_float(zv << 16); s1 += __uint_as_float(zv & 0xffff0000u); }
        for (int j = 0; j < 32; ++j) {
            const int tl = tg * 32 + j, pos = pos0 + tl;
            const unsigned zv = *(const LAS unsigned*)(lds + (tl + 15) * 512 + cp * 4);
            const float z0 = __uint_as_float(zv << 16), z1 = __uint_as_float(zv & 0xffff0000u);
            s0 += z0; s1 += z1;
            const float inv = __builtin_amdgcn_rcpf((float)((pos + 1 < W) ? pos + 1 : W));
            *(LAS unsigned*)(lds + PA_OFF + tl * (AT_LD * 2) + cp * 4) = pk2(s0 * inv - z0, s1 * inv - z1);
            const unsigned zo = *(const LAS unsigned*)(lds + (tl + 15 - (W - 1)) * 512 + cp * 4);
            s0 -= __uint_as_float(zo << 16); s1 -= __uint_as_float(zo & 0xffff0000u);
        }
    }
    __syncthreads();
    {
        f32x4 C[8][2];
#pragma unroll
        for (int rt = 0; rt < 8; ++rt) { C[rt][0] = (f32x4){0.f, 0.f, 0.f, 0.f}; C[rt][1] = (f32x4){0.f, 0.f, 0.f, 0.f}; }
#pragma unroll
        for (int rt = 0; rt < 8; ++rt)
#pragma unroll
            for (int ks = 0; ks < 2; ++ks) {
                const bf16x8 Af = as_bf16x8(*(const LAS u32x4*)(lds + PA_OFF + (rt * 16 + fr) * (AT_LD * 2) + (g * 64 + ks * 32 + fq * 8) * 2));
                C[rt][0] = MFMA16(Af, Bf[0][ks], C[rt][0]); C[rt][1] = MFMA16(Af, Bf[1][ks], C[rt][1]);
            }
        __syncthreads();
        LAS float* YT = (LAS float*)lds;
#pragma unroll
        for (int ct = 0; ct < 2; ++ct) {
            const int ch = g * 64 + (cb + ct) * 16 + fr; const float sc = scv[ct];
#pragma unroll
            for (int rt = 0; rt < 8; ++rt)
#pragma unroll
                for (int j = 0; j < 4; ++j) YT[(rt * 16 + fq * 4 + j) * YT_LD + ch] = C[rt][ct][j] * sc;
        }
    }
    __syncthreads();
    mix_final<false>(c, w, t0, 2, YN);
}

__device__ __forceinline__ void mix_sconv(const Ctx& c, const Lw& w, const bf16* Z, int t0, bf16* YN) {
    LAS float* YT = (LAS float*)c.lds;
    const int pos0 = t0 % SEQ;
#pragma unroll 1
    for (int task = c.tid; task < 1024; task += NT) {
        const int c8 = (task & 31) * 8, R0 = (task >> 5) * 4;
        u32x4 cv[6], hv[6], bv[4];
#pragma unroll
        for (int i = 0; i < 6; ++i) { cv[i] = (u32x4){0u, 0u, 0u, 0u}; hv[i] = (u32x4){0u, 0u, 0u, 0u};
            if (pos0 + R0 - 2 + i >= 0) { const size_t zr = (size_t)(t0 + R0 - 2 + i) * DIN; cv[i] = *(const u32x4*)(Z + zr + 1536 + c8); hv[i] = *(const u32x4*)(Z + zr + 1792 + c8); } }
#pragma unroll
        for (int j = 0; j < 4; ++j) bv[j] = *(const u32x4*)(Z + (size_t)(t0 + R0 + j) * DIN + 1280 + c8);
        float wk[3][8];
#pragma unroll
        for (int k = 0; k < 3; ++k) { const f32x4 w0 = *(const f32x4*)(w.sc_w + k * DG + c8), w1 = *(const f32x4*)(w.sc_w + k * DG + c8 + 4);
#pragma unroll
            for (int q = 0; q < 4; ++q) { wk[k][q] = w0[q]; wk[k][4 + q] = w1[q]; } }
        float p[6][8];
#pragma unroll
        for (int i = 0; i < 6; ++i)
#pragma unroll
            for (int q = 0; q < 4; ++q) { p[i][2 * q] = __uint_as_float(cv[i][q] << 16) * __uint_as_float(hv[i][q] << 16); p[i][2 * q + 1] = __uint_as_float(cv[i][q] & 0xffff0000u) * __uint_as_float(hv[i][q] & 0xffff0000u); }
#pragma unroll
        for (int j = 0; j < 4; ++j) {
            float o[8];
#pragma unroll
            for (int q = 0; q < 8; ++q) o[q] = wk[0][q] * p[j][q] + wk[1][q] * p[j + 1][q] + wk[2][q] * p[j + 2][q];
#pragma unroll
            for (int q = 0; q < 4; ++q) { o[2 * q] *= __uint_as_float(bv[j][q] << 16); o[2 * q + 1] *= __uint_as_float(bv[j][q] & 0xffff0000u); }
            *(LAS f32x4*)(YT + (R0 + j) * YT_LD + c8) = (f32x4){o[0], o[1], o[2], o[3]}; *(LAS f32x4*)(YT + (R0 + j) * YT_LD + c8 + 4) = (f32x4){o[4], o[5], o[6], o[7]};
        }
    }
    __syncthreads();
    mix_final<false>(c, w, t0, 3, YN);
}

__device__ __forceinline__ void mixer_phase(const Ctx& c0, const Lw& w, int l, const bf16* Z, const bf16* GMW, const bf16* PWT, const bf16* POOLT, bf16* YN) {
    for (int it = blockIdx.x; it < 512; it += gridDim.x) {
        Ctx c = c0; asm volatile("" : "+v"(c.tid)); c.lane = c.tid & 63;
        const int mx = it >> 7, t0 = (it & 127) * CHUNK;
        if (mx == 0) mix_conformer(c, w, Z, PWT + (size_t)l * DG * DG, t0, YN);
        else if (mx == 1) mix_gmlp(c, w, Z, GMW + (size_t)l * 4 * CHUNK * CHUNK, t0, YN);
        else if (mx == 2) mix_pool(c, w, Z, POOLT + (size_t)l * 4 * 64 * 64, t0, YN);
        else mix_sconv(c, w, Z, t0, YN);
        __syncthreads();
    }
}

struct EpiZ { bf16* Z; __device__ __forceinline__ void operator()(int r, int cc, f32x4 v) const { st_bf4(Z + (size_t)r * DIN + cc, v); } };
struct EpiU { float* U; const float* X; __device__ __forceinline__ void operator()(int r, int cc, f32x4 v) const { *(f32x4*)(U + (size_t)r * DM + cc) = v + ALPHA * *(const f32x4*)(X + (size_t)r * DM + cc); } };

struct GB { f32x4 g[4], b[4]; };
__device__ __forceinline__ GB load_gb(const float* g, const float* b, int lane) {
    GB r;
#pragma unroll
    for (int j = 0; j < 4; ++j) { r.g[j] = *(const f32x4*)(g + lane * 4 + 256 * j); r.b[j] = *(const f32x4*)(b + lane * 4 + 256 * j); }
    return r;
}
__device__ __forceinline__ void ln1024(f32x4 (&v)[4], const GB& gb) {
    float s = 0.f;
#pragma unroll
    for (int j = 0; j < 4; ++j) s += (v[j][0] + v[j][1]) + (v[j][2] + v[j][3]);
    const float mean = wave_sum(s) * (1.f / DM);
    float q = 0.f;
#pragma unroll
    for (int j = 0; j < 4; ++j) { v[j] = v[j] - mean; q += (v[j][0] * v[j][0] + v[j][1] * v[j][1]) + (v[j][2] * v[j][2] + v[j][3] * v[j][3]); }
    const float rstd = __builtin_amdgcn_rsqf(wave_sum(q) * (1.f / DM) + LN_EPS);
#pragma unroll
    for (int j = 0; j < 4; ++j) v[j] = v[j] * rstd * gb.g[j] + gb.b[j];
}
__device__ __forceinline__ void nv_ln1_router(const Ctx& c, const Lw& w, const float* U, float* X1, bf16* X1B, unsigned* RTE, float* RTG) {
    LAS float* RWt = (LAS float*)c.lds;
    __syncthreads();
#pragma unroll
    for (int h = 0; h < 2; ++h) { const int ch = c.tid + 512 * h;
#pragma unroll
        for (int e4 = 0; e4 < 4; ++e4) { const f32x4 ww = *(const f32x4*)(w.router_w + (size_t)ch * NE + e4 * 4);
#pragma unroll
            for (int q = 0; q < 4; ++q) RWt[(e4 * 4 + q) * DM + ch] = ww[q]; } }
    __syncthreads();
    const GB gb = load_gb(w.ln1_g, w.ln1_b, c.lane);
    float rb[16];
#pragma unroll
    for (int e = 0; e < 16; ++e) rb[e] = w.router_b[e];
    f32x4 vn[4];
    if (c.gw < M) {
#pragma unroll
        for (int j = 0; j < 4; ++j) vn[j] = *(const f32x4*)(U + (size_t)c.gw * DM + c.lane * 4 + 256 * j);
    }
    for (int t = c.gw; t < M; t += c.ngw) {
        f32x4 v[4];
#pragma unroll
        for (int j = 0; j < 4; ++j) v[j] = vn[j];
        if (t + c.ngw < M) {
#pragma unroll
            for (int j = 0; j < 4; ++j) vn[j] = *(const f32x4*)(U + (size_t)(t + c.ngw) * DM + c.lane * 4 + 256 * j);
        }
        ln1024(v, gb);
#pragma unroll
        for (int j = 0; j < 4; ++j) { *(f32x4*)(X1 + (size_t)t * DM + c.lane * 4 + 256 * j) = v[j]; st_bf4(X1B + (size_t)t * DM + c.lane * 4 + 256 * j, v[j]); }
        float lg[16];
        int lo = c.lane * 4; asm volatile("" : "+v"(lo));
#pragma unroll
        for (int e0 = 0; e0 < 16; e0 += 4) {
            f32x4 ww[4][4];
#pragma unroll
            for (int ee = 0; ee < 4; ++ee)
#pragma unroll
                for (int j = 0; j < 4; ++j) ww[ee][j] = *(const LAS f32x4*)(RWt + (e0 + ee) * DM + lo + 256 * j);
            __builtin_amdgcn_sched_barrier(0);
#pragma unroll
            for (int ee = 0; ee < 4; ++ee) {
                float a = 0.f;
#pragma unroll
                for (int j = 0; j < 4; ++j) a += (v[j][0] * ww[ee][j][0] + v[j][1] * ww[ee][j][1]) + (v[j][2] * ww[ee][j][2] + v[j][3] * ww[ee][j][3]);
                lg[e0 + ee] = a;
            }
        }
#pragma unroll
        for (int e = 0; e < 16; ++e) lg[e] = wave_sum(lg[e]);
        float sel[16];
#pragma unroll
        for (int e = 0; e < 16; ++e) sel[e] = lg[e] + rb[e];
        float gs[4];
#pragma unroll
        for (int g = 0; g < 4; ++g) {
            const float a = sel[4 * g], b = sel[4 * g + 1], cc = sel[4 * g + 2], d = sel[4 * g + 3];
            const float h1 = fmaxf(a, b), l1_ = fminf(a, b), h2 = fmaxf(cc, d), l2_ = fminf(cc, d);
            gs[g] = fmaxf(h1, h2) + fmaxf(fminf(h1, h2), fmaxf(l1_, l2_));
        }
        int best = 0; float bsc = gs[0];
#pragma unroll
        for (int g = 1; g < 4; ++g) { const bool gt = gs[g] > bsc; best = gt ? g : best; bsc = gt ? gs[g] : bsc; }
        float sv[4], lv[4];
#pragma unroll
        for (int k = 0; k < 4; ++k) { sv[k] = sel[k]; lv[k] = lg[k];
#pragma unroll
            for (int g = 1; g < 4; ++g) { sv[k] = (best == g) ? sel[4 * g + k] : sv[k]; lv[k] = (best == g) ? lg[4 * g + k] : lv[k]; } }
        int k1 = 0; float s1 = sv[0], l1 = lv[0];
#pragma unroll
        for (int k = 1; k < 4; ++k) { const bool gt = sv[k] > s1; k1 = gt ? k : k1; l1 = gt ? lv[k] : l1; s1 = gt ? sv[k] : s1; }
        int k2 = -1; float s2 = -INFINITY, l2 = 0.f;
#pragma unroll
        for (int k = 0; k < 4; ++k) { const bool gt = (k != k1) && (k2 < 0 || sv[k] > s2); k2 = gt ? k : k2; l2 = gt ? lv[k] : l2; s2 = gt ? sv[k] : s2; }
        const int i1 = best * 4 + k1, i2 = best * 4 + k2;
        const float mx = fmaxf(l1, l2), e1 = __expf(l1 - mx), e2 = __expf(l2 - mx), inv = 1.0f / (e1 + e2);
        if (c.lane == 0) { RTE[t] = (unsigned)i1 | ((unsigned)i2 << 8); RTG[2 * t] = e1 * inv; RTG[2 * t + 1] = e2 * inv; }
    }
}
constexpr int CW_CNT = 8192;
__device__ __forceinline__ void moe_ranks(const Ctx& c, const unsigned* RTE, int* RTP, unsigned* CNT, int* LIST) {
    LAS int* LC = (LAS int*)c.lds;
    __syncthreads();
    if (c.tid < 32) LC[c.tid] = 0;
    __syncthreads();
    for (int t = c.gw; t < M; t += c.ngw) {
        if (c.lane == 0) { const unsigned ee = RTE[t]; RTP[2 * t] = __hip_atomic_fetch_add(&LC[ee & 0xff], 1, __ATOMIC_RELAXED, __HIP_MEMORY_SCOPE_WORKGROUP); RTP[2 * t + 1] = __hip_atomic_fetch_add(&LC[(ee >> 8) & 0xff], 1, __ATOMIC_RELAXED, __HIP_MEMORY_SCOPE_WORKGROUP); }
    }
    __syncthreads();
    if (c.tid < 16) LC[16 + c.tid] = (int)atomicAdd(&CNT[c.tid], (unsigned)LC[c.tid]);
    __syncthreads();
    for (int t = c.gw; t < M; t += c.ngw) {
        if (c.lane == 0) { const unsigned ee = RTE[t]; const int e0 = ee & 0xff, e1 = (ee >> 8) & 0xff; const int p0 = RTP[2 * t] + LC[16 + e0], p1 = RTP[2 * t + 1] + LC[16 + e1];
            RTP[2 * t] = p0; RTP[2 * t + 1] = p1; LIST[e0 * M + p0] = t; LIST[e1 * M + p1] = t; }
    }
}
constexpr int LDS_TAB_OFF = 131072;
__device__ __forceinline__ void moe_tiles(const Ctx& c, const unsigned* CNT) {
    LAS int* ts = (LAS int*)(c.lds + LDS_TAB_OFF);
    __syncthreads();
    if (c.tid < 17) { int s = 0; for (int e = 0; e < c.tid; ++e) s += (int)((CNT[e] + 255u) >> 8); ts[c.tid] = s; }
    __syncthreads();
}
constexpr int LDS_IDX_OFF = LDS_TAB_OFF + 256, MAX_UNITS = 15;
struct CSc { int s0, s1; float g0, g1; };
__device__ __forceinline__ CSc comb_sc(const LAS int* ts, const unsigned* RTE, const float* RTG, const int* RTP, int t) {
    CSc r; const unsigned ee = RTE[t]; r.s0 = ts[ee & 0xff] * 256 + RTP[2 * t]; r.s1 = ts[(ee >> 8) & 0xff] * 256 + RTP[2 * t + 1]; r.g0 = RTG[2 * t]; r.g1 = RTG[2 * t + 1]; return r;
}
struct CRows { f32x4 x[4]; u32x2 a[4], b[4]; };
__device__ __forceinline__ void comb_rows(CRows& R, const float* X1, const bf16* YS, int t, const CSc& s, int lane) {
#pragma unroll
    for (int j = 0; j < 4; ++j) { const int col = lane * 4 + 256 * j; R.x[j] = *(const f32x4*)(X1 + (size_t)t * DM + col); R.a[j] = *(const u32x2*)(YS + (size_t)s.s0 * DM + col); R.b[j] = *(const u32x2*)(YS + (size_t)s.s1 * DM + col); }
}
__device__ __forceinline__ f32x4 bf4f(u32x2 w) { return (f32x4){__uint_as_float(w.x << 16), __uint_as_float(w.x & 0xffff0000u), __uint_as_float(w.y << 16), __uint_as_float(w.y & 0xffff0000u)}; }
__device__ __forceinline__ void moe_combine_ln2(const Ctx& c, const Lw& w, const float* X1, const bf16* YS, const unsigned* RTE, const float* RTG, const int* RTP, float* X2, bf16* XB) {
    const LAS int* ts = (const LAS int*)(c.lds + LDS_TAB_OFF);
    int t = c.gw; if (t >= M) return;
    const GB gb = load_gb(w.ln2_g, w.ln2_b, c.lane);
    CSc sA = comb_sc(ts, RTE, RTG, RTP, t), sB = sA; CRows Rn;
    comb_rows(Rn, X1, YS, t, sA, c.lane);
    if (t + c.ngw < M) sB = comb_sc(ts, RTE, RTG, RTP, t + c.ngw);
    for (; t < M; t += c.ngw) {
        const CRows R = Rn; const CSc cur = sA; sA = sB;
        if (t + c.ngw < M) comb_rows(Rn, X1, YS, t + c.ngw, sA, c.lane);
        if (t + 2 * c.ngw < M) sB = comb_sc(ts, RTE, RTG, RTP, t + 2 * c.ngw);
        f32x4 v[4];
#pragma unroll
        for (int j = 0; j < 4; ++j) v[j] = ALPHA * R.x[j] + cur.g0 * bf4f(R.a[j]) + cur.g1 * bf4f(R.b[j]);
        ln1024(v, gb);
#pragma unroll
        for (int j = 0; j < 4; ++j) { *(f32x4*)(X2 + (size_t)t * DM + c.lane * 4 + 256 * j) = v[j]; st_bf4(XB + (size_t)t * DM + c.lane * 4 + 256 * j, v[j]); }
    }
}

namespace pg8 {
#define PG8_LAS __attribute__((address_space(3)))
typedef unsigned short bf16_t;
typedef short bf16x8 __attribute__((ext_vector_type(8)));
typedef float f32x4 __attribute__((ext_vector_type(4)));
typedef unsigned u32x4 __attribute__((ext_vector_type(4)));
constexpr int BM = 256, BK = 64, HALF = 128, HTB = HALF * BK * 2  , STAGE_BYTES = 8 * HTB, NXCD = 8, WGM = 8;

__host__ __device__ __forceinline__ int lds_byte(int r, int c) { const int st = (r >> 4) * 2 + (c >> 5), rr = r & 15, cc = c & 31, ob = rr * 64 + cc * 2; return st * 1024 + (ob ^ (((ob >> 9) & 1) << 5)); }
__host__ __device__ __forceinline__ void stage_rc(int b, int& R, int& C) { const int st = b / 1024, sb = b % 1024, swz = sb ^ (((sb >> 9) & 1) << 5); R = (st >> 1) * 16 + swz / 64; C = (st & 1) * 32 + (swz % 64) / 2; }
__host__ __device__ __forceinline__ int perm32(int rho) { const int n = rho >> 4, i = rho & 15; return 8 * (i >> 2) + 4 * n + (i & 3); }

struct Unit { int pm, pn; };
struct Gemm { const bf16_t* A; const bf16_t* Bt; int M, N, K; };

struct StaticOrder {
    int nM, nN, nwg, G, c;
    __host__ __device__ void init(int M, int N, int G_, int c_) { nM = M / BM; nN = N / BM; nwg = nM * nN; G = G_; c = c_; }
    __host__ __device__ bool next(int i, Unit& u) const {
        const long L = (long)i * G + c; if (L >= nwg) return false;
        int wgid = (int)L; { const int q = nwg / NXCD, r = nwg % NXCD, xcd = wgid % NXCD, off = wgid / NXCD; wgid = (xcd < r ? xcd * (q + 1) : r * (q + 1) + (xcd - r) * q) + off; }
        const int nig = WGM * nN, gid = wgid / nig, fm = gid * WGM, gsz = (nM - fm) < WGM ? (nM - fm) : WGM;
        u.pm = fm + ((wgid % nig) % gsz); u.pn = (wgid % nig) / gsz; return true;
    }
    __device__ __forceinline__ void a_ready(const Unit&) const {}
    __device__ __forceinline__ void done(const Unit&) const {}
};

__device__ __forceinline__ unsigned cvt_pk_bf16(float lo, float hi) { unsigned r; asm volatile("v_cvt_pk_bf16_f32 %0, %1, %2" : "=v"(r) : "v"(lo), "v"(hi)); return r; }
typedef float f32x2 __attribute__((ext_vector_type(2)));
__device__ __forceinline__ f32x2 gelu_pk(f32x2 v) {
    const f32x2 av = __builtin_elementwise_abs(v), d = av * 0.2316418882f + 1.0f;
    f32x2 t; t.x = __builtin_amdgcn_rcpf(d.x); t.y = __builtin_amdgcn_rcpf(d.y);
    f32x2 q = t * 0.5307027145f + (-0.7265760135f); q = q * t + 0.7107068705f; q = q * t + (-0.142248368f); q = q * t + 0.127414796f; q = q * t;
    const f32x2 s = (v * v) * (-0.72134752044f);
    f32x2 e; e.x = __builtin_amdgcn_exp2f(s.x); e.y = __builtin_amdgcn_exp2f(s.y);
    const f32x2 m = v * (q * e), r = v - m;
    f32x2 o; o.x = v.x < 0.f ? m.x : r.x; o.y = v.y < 0.f ? m.y : r.y; return o;
}

template <int ACT  > struct EpiBf16 {
    static constexpr bool PERM = true, AFTER_DRAIN = false; static_assert(ACT == 0 || ACT == 1, "EpiBf16: ACT is 0 (none) or 1 (gelu_pk)");
    bf16_t* O; int ldc; const float* bias; int split_cols; size_t split_stride; float scale0; int pn_mask;
    __device__ __forceinline__ void operator()(const f32x4 (&acc)[2][2][4][2], const Unit& u, int wr, int wc, int fr, int fq) const {
        const int row0 = u.pm * BM + wr * 64 + fr; int colt = (u.pn & pn_mask) * BM; bf16_t* base = O;
        float sc = 1.f; if (split_cols) { const int t = colt / split_cols; base += (size_t)t * split_stride; colt -= t * split_cols; if (t == 0) sc = scale0; }
        const int col0 = colt + wc * 32 + 8 * fq, bcol0 = (u.pn & pn_mask) * BM + wc * 32 + 8 * fq;
        f32x4 bv[2][2];
#pragma unroll
        for (int bj = 0; bj < 2; ++bj)
#pragma unroll
            for (int n = 0; n < 2; ++n) bv[bj][n] = bias ? *(const f32x4*)(bias + bcol0 + bj * HALF + 4 * n) : (f32x4){0.f, 0.f, 0.f, 0.f};
#pragma unroll
        for (int ai = 0; ai < 2; ++ai)
#pragma unroll
            for (int m = 0; m < 4; ++m) { bf16_t* rowp = base + (size_t)(row0 + ai * HALF + m * 16) * ldc + col0;
#pragma unroll
                for (int bj = 0; bj < 2; ++bj) { f32x4 v0 = acc[ai][bj][m][0] + bv[bj][0], v1 = acc[ai][bj][m][1] + bv[bj][1];
                    if (ACT == 1) { f32x2 a = gelu_pk((f32x2){v0[0], v0[1]}), b = gelu_pk((f32x2){v0[2], v0[3]}), c = gelu_pk((f32x2){v1[0], v1[1]}), d = gelu_pk((f32x2){v1[2], v1[3]});
                        v0 = (f32x4){a.x, a.y, b.x, b.y}; v1 = (f32x4){c.x, c.y, d.x, d.y}; }
                    v0 = v0 * sc; v1 = v1 * sc; u32x4 w; w.x = cvt_pk_bf16(v0[0], v0[1]); w.y = cvt_pk_bf16(v0[2], v0[3]); w.z = cvt_pk_bf16(v1[0], v1[1]); w.w = cvt_pk_bf16(v1[2], v1[3]);
                    *(u32x4*)(rowp + bj * HALF) = w; } }
    }
};


struct EpiResF32 {
    static constexpr bool PERM = false, AFTER_DRAIN = false;
    const float* X; float* U; float alpha;
    __device__ __forceinline__ void operator()(const f32x4 (&acc)[2][2][4][2], const Unit& u, int wr, int wc, int fr, int fq) const {
        const int col0 = u.pn * BM + wc * 32 + 4 * fq;
#pragma unroll
        for (int ai = 0; ai < 2; ++ai)
#pragma unroll
            for (int m = 0; m < 4; ++m) { const size_t off = (size_t)(u.pm * BM + ai * HALF + wr * 64 + m * 16 + fr) * 1024 + col0;
#pragma unroll
                for (int bj = 0; bj < 2; ++bj)
#pragma unroll
                    for (int n = 0; n < 2; ++n) *(f32x4*)(U + off + bj * HALF + n * 16) = acc[ai][bj][m][n] + alpha * *(const f32x4*)(X + off + bj * HALF + n * 16); }
    }
};

struct MoeOrder {
    const PG8_LAS int* ts; int G, c;
    __device__ __forceinline__ bool next(int i, Unit& u) const {
        const int L = i * G + c; if (L >= __builtin_amdgcn_readfirstlane(ts[16]) * 4) return false;
        const int rt = L >> 2; int e = 0;
#pragma unroll
        for (int k = 1; k < 16; ++k) e += (rt >= ts[k]) ? 1 : 0;
        u.pm = rt; u.pn = __builtin_amdgcn_readfirstlane(e) * 4 + (L & 3); return true;
    }
    __device__ __forceinline__ void a_ready(const Unit&) const {}
    __device__ __forceinline__ void done(const Unit&) const {}
};
struct EpiSwiGLU {
    static constexpr bool PERM = true, AFTER_DRAIN = false;
    bf16_t* H;
    __device__ __forceinline__ void operator()(const f32x4 (&acc)[2][2][4][2], const Unit& u, int wr, int wc, int fr, int fq) const {
        const int row0 = u.pm * BM + wr * 64 + fr, col0 = (u.pn & 3) * HALF + wc * 32 + 8 * fq;
#pragma unroll
        for (int ai = 0; ai < 2; ++ai)
#pragma unroll
            for (int m = 0; m < 4; ++m) {
                u32x4 w4;
#pragma unroll
                for (int n = 0; n < 2; ++n) {
                    const f32x4 g = acc[ai][0][m][n], up = acc[ai][1][m][n]; f32x4 h;
#pragma unroll
                    for (int q = 0; q < 4; ++q) h[q] = g[q] * __builtin_amdgcn_rcpf(1.0f + __builtin_amdgcn_exp2f(-1.44269504089f * g[q])) * up[q];
                    w4[2 * n] = cvt_pk_bf16(h[0], h[1]); w4[2 * n + 1] = cvt_pk_bf16(h[2], h[3]);
                }
                *(u32x4*)(H + (size_t)(row0 + ai * HALF + m * 16) * 512 + col0) = w4;
            }
    }
};
template <class Epi, class Sched, bool ALIGN_EPI = false, bool SP2 = false, bool GATHER = false>
__device__ __forceinline__ void gemm_phase(PG8_LAS unsigned char* lds, const Gemm g, const Sched& S, const Epi& E, const int tid, const PG8_LAS int* idx = nullptr) {
    static_assert(!GATHER || SP2, "GATHER is implemented for the SP2 loop only");
    const int wid = __builtin_amdgcn_readfirstlane(tid >> 6), lane = tid & 63, wr = wid >> 2, wc = wid & 3, fr = lane & 15, fq = lane >> 4;
    const int K = g.K, nt = K / BK;
    unsigned voffA[2], voffB[2]; int RA[2], CA[2];
#pragma unroll
    for (int i = 0; i < 2; ++i) { int R, C; stage_rc(tid * 16 + i * 8192, R, C); const int Rb = Epi::PERM ? ((R & ~31) + perm32(R & 31)) : R; RA[i] = R; CA[i] = C;
        voffA[i] = (unsigned)(R * K + C) * 2u; voffB[i] = (unsigned)(Rb * K + C) * 2u; }
    unsigned gA[2][2], gN[2][2], gS[2][2];
#define PG8_GIDX(dst, u_) do { _Pragma("unroll") for (int _h = 0; _h < 2; ++_h) _Pragma("unroll") for (int _i = 0; _i < 2; ++_i) dst[_h][_i] = (unsigned)idx[(u_) * 256 + _h * HALF + RA[_i]] * (unsigned)(K * 2) + (unsigned)(CA[_i] * 2); } while (0)
#define PG8_STAGE_AC(bufoff, gbase, h) do { if constexpr (GATHER) PG8_STAGE(bufoff, gbase, gA[h]); else PG8_STAGE(bufoff, (gbase) + (h) * hstep, voffA); } while (0)
#define PG8_STAGE_AS(bufoff, gbase, h) do { if constexpr (GATHER) PG8_STAGE(bufoff, gbase, gS[h]); else PG8_STAGE(bufoff, (gbase) + (h) * hstep, voffA); } while (0)
    const size_t kstep = (size_t)(BK * 2);
    const size_t hstep = (size_t)HALF * K * 2;
    const size_t tstep = 2 * hstep;
    const unsigned ldsw = (unsigned)wid * 1024u;
    const int aoff = lds_byte(wr * 64 + fr, fq * 8), boff = lds_byte(wc * 32 + fr, fq * 8);
#define PG8_SA(b, h) (((b) * 2 + (h)) * HTB)
#define PG8_SB(b, h) ((4 + (b) * 2 + (h)) * HTB)
#define PG8_STAGE(bufoff, gbase, voff) do { _Pragma("unroll") for (int _i = 0; _i < 2; ++_i) \
        __builtin_amdgcn_global_load_lds((const unsigned*)((const char*)(gbase) + (voff)[_i]), (PG8_LAS unsigned*)(lds + (bufoff) + ldsw + _i * 8192), 16, 0, 0); } while (0)
#define PG8_LDA(dst, b, h) do { _Pragma("unroll") for (int m = 0; m < 4; ++m) _Pragma("unroll") for (int k = 0; k < 2; ++k) dst[m][k] = *(const PG8_LAS bf16x8*)(lds + PG8_SA(b, h) + aoff + m * 2048 + k * 1024); } while (0)
#define PG8_LDB(dst, b, h) do { _Pragma("unroll") for (int n = 0; n < 2; ++n) _Pragma("unroll") for (int k = 0; k < 2; ++k) dst[n][k] = *(const PG8_LAS bf16x8*)(lds + PG8_SB(b, h) + boff + n * 2048 + k * 1024); } while (0)
#define PG8_MMA(ai, bj, At, Bt) do { __builtin_amdgcn_s_setprio(1); _Pragma("unroll") for (int m = 0; m < 4; ++m) _Pragma("unroll") for (int n = 0; n < 2; ++n) _Pragma("unroll") for (int k = 0; k < 2; ++k) \
        acc[ai][bj][m][n] = __builtin_amdgcn_mfma_f32_16x16x32_bf16(Bt[n][k], At[m][k], acc[ai][bj][m][n], 0, 0, 0); __builtin_amdgcn_s_setprio(0); } while (0)
#define PG8_WAIT_V(n) asm volatile("s_waitcnt vmcnt(" #n ")" ::: "memory")
#define PG8_WAIT_L(n) asm volatile("s_waitcnt lgkmcnt(" #n ")" ::: "memory")
#define PG8_BAR __builtin_amdgcn_s_barrier()
#define PG8_SCHED __builtin_amdgcn_sched_barrier(0)
    Unit cur, nxt; int ui = 0;
    if (!S.next(0, cur)) return;
    f32x4 acc[2][2][4][2];
#pragma unroll
    for (int a = 0; a < 2; ++a)
#pragma unroll
        for (int b = 0; b < 2; ++b)
#pragma unroll
            for (int m = 0; m < 4; ++m)
#pragma unroll
                for (int n = 0; n < 2; ++n) acc[a][b][m][n] = (f32x4){0.f, 0.f, 0.f, 0.f};
    bf16x8 At[4][2], B0[2][2], B1[2][2];
    const char* cA = (const char*)g.A + (GATHER ? (size_t)0 : (size_t)cur.pm * tstep); const char* cB = (const char*)g.Bt + (size_t)cur.pn * tstep;
    if constexpr (GATHER) PG8_GIDX(gA, 0);
    S.a_ready(cur);
    if constexpr (SP2) {
        PG8_STAGE(PG8_SB(0, 0), cB, voffB); PG8_STAGE(PG8_SB(0, 1), cB + hstep, voffB); PG8_STAGE_AC(PG8_SA(0, 0), cA, 0); PG8_STAGE_AC(PG8_SA(0, 1), cA, 1);
        if (wr == 1) PG8_BAR;
        PG8_WAIT_V(2); PG8_BAR;
        PG8_STAGE(PG8_SB(1, 0), cB + kstep, voffB); PG8_STAGE_AC(PG8_SA(1, 0), cA + kstep, 0); PG8_STAGE(PG8_SB(1, 1), cB + hstep + kstep, voffB);
        PG8_WAIT_V(6); PG8_BAR;
    } else {
        PG8_STAGE(PG8_SB(0, 0), cB, voffB); PG8_STAGE(PG8_SA(0, 0), cA, voffA); PG8_STAGE(PG8_SB(0, 1), cB + hstep, voffB); PG8_STAGE(PG8_SA(0, 1), cA + hstep, voffA);
        if (wr == 1) PG8_BAR;
        PG8_WAIT_V(4); PG8_BAR;
        PG8_STAGE(PG8_SB(1, 0), cB + kstep, voffB); PG8_STAGE(PG8_SA(1, 0), cA + kstep, voffA); PG8_STAGE(PG8_SB(1, 1), cB + hstep + kstep, voffB);
        PG8_WAIT_V(6); PG8_BAR;
    }
    for (;;) {
        const bool has_next = S.next(ui + 1, nxt);
        if constexpr (GATHER) { if (has_next) PG8_GIDX(gN, ui + 1); else {
#pragma unroll
            for (int _h = 0; _h < 2; ++_h) { gN[_h][0] = gA[_h][0]; gN[_h][1] = gA[_h][1]; } } }
        const char* nA = (has_next && !GATHER) ? (const char*)g.A + (size_t)nxt.pm * tstep : cA; const char* nB = has_next ? (const char*)g.Bt + (size_t)nxt.pn * tstep : cB;
        for (int t = 0; t < nt; t += 2) {
            const bool last = (t == nt - 2);
            const char* a1 = cA + (size_t)(t + 1) * kstep;
            const char* a2 = last ? nA : cA + (size_t)(t + 2) * kstep; const char* b2 = last ? nB : cB + (size_t)(t + 2) * kstep;
            const char* a3 = a2 + kstep; const char* b3 = b2 + kstep;
            if (last && has_next) S.a_ready(nxt);
            if constexpr (GATHER) {
#pragma unroll
                for (int _h = 0; _h < 2; ++_h) { gS[_h][0] = last ? gN[_h][0] : gA[_h][0]; gS[_h][1] = last ? gN[_h][1] : gA[_h][1]; } }
            if constexpr (SP2) {
            PG8_LDB(B0, 0, 0); PG8_LDB(B1, 0, 1); PG8_SCHED; PG8_LDA(At, 0, 0); PG8_STAGE_AC(PG8_SA(1, 1), a1, 1);
            PG8_WAIT_V(8); PG8_WAIT_L(0); PG8_BAR; PG8_MMA(0, 0, At, B0); PG8_MMA(0, 1, At, B1); PG8_BAR; PG8_SCHED;
            PG8_LDA(At, 0, 1); PG8_STAGE(PG8_SB(0, 0), b2, voffB); PG8_STAGE(PG8_SB(0, 1), b2 + hstep, voffB); PG8_STAGE_AS(PG8_SA(0, 0), a2, 0);
            PG8_WAIT_V(8); PG8_WAIT_L(0); PG8_BAR; PG8_MMA(1, 0, At, B0); PG8_MMA(1, 1, At, B1); PG8_BAR; PG8_SCHED;
            PG8_LDB(B0, 1, 0); PG8_LDB(B1, 1, 1); PG8_SCHED; PG8_LDA(At, 1, 0); PG8_STAGE_AS(PG8_SA(0, 1), a2, 1);
            PG8_WAIT_V(8); PG8_WAIT_L(0); PG8_BAR; PG8_MMA(0, 0, At, B0); PG8_MMA(0, 1, At, B1); PG8_BAR; PG8_SCHED;
            PG8_LDA(At, 1, 1); PG8_STAGE(PG8_SB(1, 0), b3, voffB); PG8_STAGE(PG8_SB(1, 1), b3 + hstep, voffB); PG8_STAGE_AS(PG8_SA(1, 0), a3, 0);
            PG8_WAIT_V(8); PG8_WAIT_L(0); PG8_BAR; PG8_MMA(1, 0, At, B0); PG8_MMA(1, 1, At, B1); PG8_BAR; PG8_SCHED;
            } else {
            PG8_LDB(B0, 0, 0); PG8_SCHED; PG8_LDA(At, 0, 0); PG8_STAGE(PG8_SA(1, 1), a1 + hstep, voffA);
            PG8_WAIT_L(8); PG8_BAR; PG8_WAIT_L(0); PG8_MMA(0, 0, At, B0); PG8_BAR; PG8_SCHED;
            PG8_LDB(B1, 0, 1); PG8_STAGE(PG8_SB(0, 0), b2, voffB);
            PG8_BAR; PG8_WAIT_L(0); PG8_MMA(0, 1, At, B1); PG8_BAR;
            PG8_LDA(At, 0, 1); PG8_STAGE(PG8_SA(0, 0), a2, voffA);
            PG8_BAR; PG8_WAIT_L(0); PG8_MMA(1, 0, At, B0); PG8_BAR; PG8_SCHED;
            PG8_STAGE(PG8_SB(0, 1), b2 + hstep, voffB);
            PG8_WAIT_V(6); PG8_BAR; PG8_MMA(1, 1, At, B1); PG8_BAR;
            PG8_LDB(B0, 1, 0); PG8_SCHED; PG8_LDA(At, 1, 0); PG8_STAGE(PG8_SA(0, 1), a2 + hstep, voffA);
            PG8_WAIT_L(8); PG8_BAR; PG8_WAIT_L(0); PG8_MMA(0, 0, At, B0); PG8_BAR; PG8_SCHED;
            PG8_LDB(B1, 1, 1); PG8_STAGE(PG8_SB(1, 0), b3, voffB);
            PG8_BAR; PG8_WAIT_L(0); PG8_MMA(0, 1, At, B1); PG8_BAR;
            PG8_LDA(At, 1, 1); PG8_STAGE(PG8_SA(1, 0), a3, voffA);
            PG8_BAR; PG8_WAIT_L(0); PG8_MMA(1, 0, At, B0); PG8_BAR; PG8_SCHED;
            PG8_STAGE(PG8_SB(1, 1), b3 + hstep, voffB);
            PG8_WAIT_V(6); PG8_BAR; PG8_MMA(1, 1, At, B1); PG8_BAR;
            }
        }
        if constexpr (ALIGN_EPI) { if (wr == 0) PG8_BAR; }
        if constexpr (!Epi::AFTER_DRAIN) { E(acc, cur, wr, wc, fr, fq); S.done(cur); }
        if (!has_next) break;
#pragma unroll
        for (int a = 0; a < 2; ++a)
#pragma unroll
            for (int b = 0; b < 2; ++b)
#pragma unroll
                for (int m = 0; m < 4; ++m)
#pragma unroll
                    for (int n = 0; n < 2; ++n) acc[a][b][m][n] = (f32x4){0.f, 0.f, 0.f, 0.f};
        cur = nxt; cA = nA; cB = nB; ++ui;
        if constexpr (GATHER) {
#pragma unroll
            for (int _h = 0; _h < 2; ++_h) { gA[_h][0] = gN[_h][0]; gA[_h][1] = gN[_h][1]; } }
        if constexpr (ALIGN_EPI) { if (wr == 1) PG8_BAR; }
    }
    PG8_WAIT_V(0);
    if constexpr (!ALIGN_EPI) { if (wr == 0) PG8_BAR; }
    PG8_BAR;
    if constexpr (Epi::AFTER_DRAIN) { E.fused(acc, cur, wr, wc, fr, fq, lds, wid, lane); S.done(cur); }
#undef PG8_SA
#undef PG8_GIDX
#undef PG8_STAGE_AC
#undef PG8_STAGE_AS
#undef PG8_SB
#undef PG8_STAGE
#undef PG8_LDA
#undef PG8_LDB
#undef PG8_MMA
#undef PG8_WAIT_V
#undef PG8_WAIT_L
#undef PG8_BAR
#undef PG8_SCHED
}
}


template <class Sched>
__device__ __forceinline__ void moe_idx_tables(const Ctx& c, const Sched& S, const unsigned* CNT, const int* LIST) {
    const LAS int* ts = (const LAS int*)(c.lds + LDS_TAB_OFF); LAS int* idx = (LAS int*)(c.lds + LDS_IDX_OFF);
    for (int i = 0; i < MAX_UNITS; ++i) {
        pg8::Unit u; if (!S.next(i, u)) break;
        const int e = u.pn >> 2, lt = u.pm - ts[e]; const int cnt = (int)CNT[e];
        if (c.tid < 256) { const int p = lt * 256 + c.tid; idx[i * 256 + c.tid] = (p < cnt) ? LIST[e * M + p] : 0; }
    }
    __syncthreads();
}
struct TItem { const float* src; bf16* dst; int N, K; };
__device__ __forceinline__ TItem titem(const Args& a, unsigned char* ws, int it) {
    constexpr int I_IN = NL * 16 * 64, I_O = NL * 16 * 32, I_G = NL * NE * 16 * 16;
    TItem t; int r = it;
    if (r < I_IN) { const int l = r >> 10, kb = (r >> 6) & 15, nb = r & 63; t.N = DIN; t.K = DM; t.src = a.in[1] + (size_t)l * DM * DIN + (size_t)(kb * 64) * DIN + nb * 32; t.dst = (bf16*)(ws + WS_WIN) + (size_t)(l * DIN + nb * 32) * DM + kb * 64; return t; } r -= I_IN;
    if (r < I_O) { const int l = r >> 9, kb = (r >> 5) & 15, nb = r & 31; t.N = DM; t.K = DM; t.src = a.in[15] + (size_t)l * DM * DM + (size_t)(kb * 64) * DM + nb * 32; t.dst = (bf16*)(ws + WS_WO) + (size_t)(l * DM + nb * 32) * DM + kb * 64; return t; } r -= I_O;
    if (r < 2 * I_G) { const int up = r >= I_G; if (up) r -= I_G; const int le = r >> 8, kb = (r >> 4) & 15, nb = r & 15, n0 = nb * 32;
        t.N = DE; t.K = DM; t.src = a.in[up ? 21 : 20] + (size_t)le * DM * DE + (size_t)(kb * 64) * DE + n0; t.dst = (bf16*)(ws + WS_WGU) + (size_t)(le * 1024 + (n0 >> 7) * 256 + (n0 & 127) + up * 128) * DM + kb * 64; return t; } r -= 2 * I_G;
    { const int le = r >> 8, kb = (r >> 5) & 7, nb = r & 31; t.N = DM; t.K = DE; t.src = a.in[22] + (size_t)le * DE * DM + (size_t)(kb * 64) * DM + nb * 32; t.dst = (bf16*)(ws + WS_WD) + (size_t)(le * 1024 + nb * 32) * DE + kb * 64; }
    return t;
}
__device__ __forceinline__ void titem_load(const TItem& t, float (&tv)[32], int lane) {
#pragma unroll
    for (int i = 0; i < 32; ++i) tv[i] = t.src[(size_t)(2 * i + (lane >> 5)) * t.N + (lane & 31)];
}
__device__ __forceinline__ void titem_store(const TItem& t, const float (&tv)[32], LAS float* scr, int lane) {
#pragma unroll
    for (int i = 0; i < 32; ++i) scr[(2 * i + (lane >> 5)) * 33 + (lane & 31)] = tv[i];
    asm volatile("s_waitcnt lgkmcnt(0)" ::: "memory");
    const int cc = lane & 7;
#pragma unroll
    for (int j = 0; j < 4; ++j) { const int n = (lane >> 3) + 8 * j; const LAS float* s = scr + (8 * cc) * 33 + n;
        u32x4 o; o.x = pk2(s[0 * 33], s[1 * 33]); o.y = pk2(s[2 * 33], s[3 * 33]); o.z = pk2(s[4 * 33], s[5 * 33]); o.w = pk2(s[6 * 33], s[7 * 33]);
        *(u32x4*)(t.dst + (size_t)n * t.K + 8 * cc) = o; }
    asm volatile("s_waitcnt lgkmcnt(0)" ::: "memory");
}
__device__ __forceinline__ void weights_prologue(const Ctx& c, const Args& a, unsigned char* ws) {
    LAS float* scr = (LAS float*)(c.lds + c.wave * 16384);
    constexpr int NITEMS = NL * 16 * 64 + NL * 16 * 32 + 2 * NL * NE * 16 * 16 + NL * NE * 8 * 32;
    int it = c.gw;
    if (it >= NITEMS) return;
    float tvA[32], tvB[32];
    TItem A = titem(a, ws, it), B = A;
    titem_load(A, tvA, c.lane);
    for (;;) {
        const bool hasB = it + c.ngw < NITEMS;
        if (hasB) { B = titem(a, ws, it + c.ngw); titem_load(B, tvB, c.lane); }
        titem_store(A, tvA, scr, c.lane);
        if (!hasB) break;
        it += 2 * c.ngw;
        const bool hasA = it < NITEMS;
        if (hasA) { A = titem(a, ws, it); titem_load(A, tvA, c.lane); }
        titem_store(B, tvB, scr, c.lane);
        if (!hasA) break;
    }
}

constexpr int PH_PER_LAYER = 7, N_PHASES = 1 + NL * PH_PER_LAYER;
struct Ptrs { bf16 *XB, *Z, *YN, *X1B, *H, *YS, *XBn, *GMW, *PWT, *POOLT; float *U, *RTG; unsigned* RTE; int *RTP, *LIST; };
__device__ __forceinline__ Ptrs make_ptrs(unsigned char* ws, int L) {
    Ptrs p; unsigned char* Ra = ws + ((L & 1) ? WS_R2 : WS_R1); unsigned char* Rb = ws + ((L & 1) ? WS_R1 : WS_R2);
    p.XB = (bf16*)Ra; p.Z = (bf16*)Rb; p.YN = (bf16*)Ra; p.U = (float*)Rb; p.X1B = (bf16*)Ra; p.H = (bf16*)Rb; p.YS = (bf16*)Ra; p.XBn = (bf16*)Rb;
    p.GMW = (bf16*)(ws + WS_GMW); p.PWT = (bf16*)(ws + WS_PWT); p.POOLT = (bf16*)(ws + WS_POOLT);
    p.RTE = (unsigned*)(ws + WS_RT); p.RTG = (float*)(ws + WS_RT + 256 * 1024); p.RTP = (int*)(ws + WS_RT + 512 * 1024); p.LIST = (int*)(ws + WS_RT + MiB);
    return p;
}
template <int L>
__device__ __forceinline__ void run_layer(const Args& args, const Ctx& c0, const XcdBarrier& bar, const bool one, const int lo, const int hi) {
    constexpr int PB = 1 + L * PH_PER_LAYER;
    unsigned char* ws = args.ws;
    const Ptrs P = make_ptrs(ws, L);
    const float* X = (L == 0) ? args.in[0] : args.out;
    unsigned* CNT = (unsigned*)ws + CW_CNT + 64 * L;
#define IN(k) (lo <= PB + (k) && PB + (k) < hi)
#define PHASE_CTX Ctx c = c0; asm volatile("" : "+v"(c.tid)); c.lane = c.tid & 63; c.gtid = blockIdx.x * NT + c.tid
#define SEAM(k) do { if (one && PB + (k) + 1 < hi) xcd_barrier(bar); } while (0)
    if (IN(0)) { PHASE_CTX; pg8::Gemm g{P.XB, (const bf16*)(ws + WS_WIN) + (size_t)L * DIN * DM, M, DIN, DM}; pg8::StaticOrder S; S.init(M, DIN, (int)gridDim.x, (int)blockIdx.x);
        pg8::EpiBf16<0> E{P.Z, DIN, nullptr, 0, 0, 1.f, 0xffff};
        pg8::gemm_phase<pg8::EpiBf16<0>, pg8::StaticOrder, true, true>(c.lds, g, S, E, c.tid); SEAM(0); }
    if (IN(1)) { PHASE_CTX; const Lw w = layer_weights(args, L); for (int r = 0; r < RPT_MIX; ++r) mixer_phase(c, w, L, P.Z, P.GMW, P.PWT, P.POOLT, P.YN); SEAM(1); }
    if (IN(2)) { PHASE_CTX; pg8::Gemm g{P.YN, (const bf16*)(ws + WS_WO) + (size_t)L * DM * DM, M, DM, DM}; pg8::StaticOrder S; S.init(M, DM, (int)gridDim.x, (int)blockIdx.x);
        pg8::EpiResF32 E{X, P.U, ALPHA};
        pg8::gemm_phase<pg8::EpiResF32, pg8::StaticOrder, true, true>(c.lds, g, S, E, c.tid); SEAM(2); }
    if (IN(3)) { PHASE_CTX; const Lw w = layer_weights(args, L); for (int r = 0; r < RPT_LN1; ++r) nv_ln1_router(c, w, P.U, args.out, P.X1B, P.RTE, P.RTG); moe_ranks(c, P.RTE, P.RTP, CNT, P.LIST); SEAM(3); }
    if (IN(4)) { PHASE_CTX; moe_tiles(c, CNT); pg8::MoeOrder S{(const LAS int*)(c.lds + LDS_TAB_OFF), (int)gridDim.x, (int)blockIdx.x};
        moe_idx_tables(c, S, CNT, P.LIST);
        pg8::Gemm g{P.X1B, (const bf16*)(ws + WS_WGU) + (size_t)L * NE * 1024 * DM, 0, 0, DM};
        pg8::EpiSwiGLU E{P.H};
        pg8::gemm_phase<pg8::EpiSwiGLU, pg8::MoeOrder, true, true, true>(c.lds, g, S, E, c.tid, (const LAS int*)(c.lds + LDS_IDX_OFF)); SEAM(4); }
    if (IN(5)) { PHASE_CTX; moe_tiles(c, CNT); pg8::MoeOrder S{(const LAS int*)(c.lds + LDS_TAB_OFF), (int)gridDim.x, (int)blockIdx.x};
        pg8::Gemm g{P.H, (const bf16*)(ws + WS_WD) + (size_t)L * NE * 1024 * DE, 0, 0, DE};
        pg8::EpiBf16<0> E{P.YS, DM, nullptr, 0, 0, 1.f, 3};
        pg8::gemm_phase<pg8::EpiBf16<0>, pg8::MoeOrder, true, true>(c.lds, g, S, E, c.tid); SEAM(5); }
    if (IN(6)) { PHASE_CTX; const Lw w = layer_weights(args, L); moe_tiles(c, CNT); moe_combine_ln2(c, w, args.out, P.YS, P.RTE, P.RTG, P.RTP, args.out, P.XBn); SEAM(6); }
#undef IN
#undef SEAM
#undef PHASE_CTX
}
__global__ void __launch_bounds__(NT, 2) fwd_kernel(Args args) {
    extern __shared__ __attribute__((aligned(16))) unsigned char lds_raw[];
    Ctx c;
    c.lds = (LAS unsigned char*)lds_raw;
    c.tid = threadIdx.x; c.lane = c.tid & 63; c.wave = __builtin_amdgcn_readfirstlane(c.tid >> 6);
    c.gtid = blockIdx.x * NT + c.tid; c.gsize = gridDim.x * NT; c.gw = blockIdx.x * NWAVES + c.wave; c.ngw = gridDim.x * NWAVES;
    volatile LAS unsigned* MISC = (volatile LAS unsigned*)(c.lds + LDS_BYTES - 64);
    if (c.tid < 16) MISC[c.tid] = 0u;
    __syncthreads();
    XcdBarrier bar; bar.bar = (unsigned*)args.ws + CW_BAR; bar.x = 0; bar.st = nullptr;
    const int lo = args.ph_lo, hi = args.ph_hi;
    const bool one = (hi - lo) > 1;
    if (one) bar = xcd_barrier_post((unsigned*)args.ws + CW_BAR, MISC + 8);
    if (lo <= 0 && 0 < hi) {
        const Ptrs P = make_ptrs(args.ws, 0);
        Ctx c0 = c; asm volatile("" : "+v"(c.tid)); c.lane = c.tid & 63; c.gtid = blockIdx.x * NT + c.tid;
        for (int r = 0; r < RPT_PRO; ++r) { nv_prologue(c, args.in[0], P.XB); small_weights(c, args, P.GMW, P.PWT, P.POOLT); weights_prologue(c, args, args.ws); }
        if (one && 1 < hi) xcd_barrier(bar);
    }
    run_layer<0>(args, c, bar, one, lo, hi);
    run_layer<1>(args, c, bar, one, lo, hi);
}

extern "C" void kernel_launch(void* const* d_in, const int* in_sizes, int n_in, void* d_out, int out_size, void* d_ws, size_t ws_size, hipStream_t stream) {
    static int grid = 0;
    if (grid == 0) {
        if (n_in != 25 || in_sizes[0] != M * DM || out_size != M * DM || ws_size < WS_END) { fprintf(stderr, "kernel_launch: unexpected shapes/ws (n_in %d ws %zu)\n", n_in, ws_size); grid = -1; return; }
        int dev = 0, cus = 0;
        if (hipGetDevice(&dev) != hipSuccess || hipDeviceGetAttribute(&cus, hipDeviceAttributeMultiprocessorCount, dev) != hipSuccess) { grid = -1; return; }
        if (hipFuncSetAttribute((const void*)fwd_kernel, hipFuncAttributeMaxDynamicSharedMemorySize, LDS_BYTES) != hipSuccess) { grid = -1; return; }
        (void)hipGetLastError();
        grid = cus;
    }
    if (grid < 0) return;
    (void)hipMemsetAsync((char*)d_ws + WS_CTL, 0, CTL_ZERO_BYTES, stream);
    Args a{};
    for (int i = 0; i < 25; ++i) a.in[i] = (const float*)d_in[i];
    a.out = (float*)d_out; a.ws = (unsigned char*)d_ws;
#if MK_ONE_LAUNCH
    a.ph_lo = 0; a.ph_hi = N_PHASES;
    hipLaunchKernelGGL(fwd_kernel, dim3(grid), dim3(NT), LDS_BYTES, stream, a);
#else
    for (int ph = 0; ph < N_PHASES; ++ph) { a.ph_lo = ph; a.ph_hi = ph + 1; hipLaunchKernelGGL(fwd_kernel, dim3(grid), dim3(NT), LDS_BYTES, stream, a); }
#endif
}
```

```cpp
#include <hip/hip_runtime.h>
#include <cstdio>
#include <cstdint>

#ifndef RPT_PRO
#define RPT_PRO 1
#endif
#ifndef RPT_MIX
#define RPT_MIX 1
#endif
#ifndef RPT_LN1
#define RPT_LN1 1
#endif
#ifndef MK_ONE_LAUNCH
#define MK_ONE_LAUNCH 1
#endif

constexpr int NB = 4, SEQ = 4096, DM = 1024, M = NB * SEQ, DIN = 2048, NE = 16, DE = 512, NL = 2;
constexpr int DG = 256, CHUNK = 128, CONFK = 31;
constexpr float ALPHA = 1.41421356237309515f;
constexpr float LN_EPS = 1e-5f, RMS_EPS = 1e-6f;
constexpr int NWAVES = 8, NT = NWAVES * 64;
constexpr int LDS_BYTES = 147456;

typedef unsigned short bf16;
typedef float f32x4 __attribute__((ext_vector_type(4)));
typedef unsigned u32x4 __attribute__((ext_vector_type(4)));
typedef unsigned u32x2 __attribute__((ext_vector_type(2)));
#define LAS __attribute__((address_space(3)))
#define GAS __attribute__((address_space(1)))
typedef GAS unsigned gu32;
#define RLX_AGENT __ATOMIC_RELAXED, __HIP_MEMORY_SCOPE_AGENT

constexpr size_t MiB = 1u << 20;
constexpr size_t WS_CTL = 0, CTL_ZERO_BYTES = 1 * MiB;
constexpr size_t WS_WIN = 1 * MiB;
constexpr size_t WS_WO = 9 * MiB;
constexpr size_t WS_WGU = 13 * MiB;
constexpr size_t WS_WD = 77 * MiB;
constexpr size_t WS_SMALL = 109 * MiB;
constexpr size_t WS_GMW = WS_SMALL, WS_PWT = WS_SMALL + 256 * 1024, WS_POOLT = WS_SMALL + 512 * 1024;
constexpr size_t WS_RA = 110 * MiB;
constexpr size_t WS_RB = 146 * MiB;
constexpr size_t WS_XBR = 218 * MiB;
constexpr size_t WS_RT = 250 * MiB;
constexpr size_t WS_END = 252 * MiB;
constexpr int CW_BAR = 4096;

__device__ __forceinline__ float bf2f(bf16 v) { return __uint_as_float(((unsigned)v) << 16); }
__device__ __forceinline__ unsigned f2bf(float f) { unsigned u = __float_as_uint(f); return (u + 0x7fffu + ((u >> 16) & 1u)) >> 16; }
__device__ __forceinline__ unsigned pk2(float lo, float hi) { return f2bf(lo) | (f2bf(hi) << 16); }
__device__ __forceinline__ float sigmoidf_(float x) { return __builtin_amdgcn_rcpf(1.0f + __builtin_amdgcn_exp2f(-1.44269504089f * x)); }
__device__ __forceinline__ float siluf_(float x) { return x * sigmoidf_(x); }
__device__ __forceinline__ float dpp_add(float v, const int ctrl_sel) {
    int t;
    if (ctrl_sel == 0) t = __builtin_amdgcn_update_dpp(0, __builtin_bit_cast(int, v), 0xB1, 0xf, 0xf, true);
    else if (ctrl_sel == 1) t = __builtin_amdgcn_update_dpp(0, __builtin_bit_cast(int, v), 0x4E, 0xf, 0xf, true);
    else if (ctrl_sel == 2) t = __builtin_amdgcn_update_dpp(0, __builtin_bit_cast(int, v), 0x141, 0xf, 0xf, true);
    else t = __builtin_amdgcn_update_dpp(0, __builtin_bit_cast(int, v), 0x140, 0xf, 0xf, true);
    return v + __builtin_bit_cast(float, t);
}
__device__ __forceinline__ float wave_sum(float v) {
    v = dpp_add(v, 0); v = dpp_add(v, 1); v = dpp_add(v, 2); v = dpp_add(v, 3);
    const int iv = __builtin_bit_cast(int, v);
    const float s0 = __builtin_bit_cast(float, __builtin_amdgcn_readlane(iv, 0)), s1 = __builtin_bit_cast(float, __builtin_amdgcn_readlane(iv, 16));
    const float s2 = __builtin_bit_cast(float, __builtin_amdgcn_readlane(iv, 32)), s3 = __builtin_bit_cast(float, __builtin_amdgcn_readlane(iv, 48));
    return (s0 + s1) + (s2 + s3);
}

#define XB_TMO      128
#define XB_XCNT(j)  (256  + 64 * (j))
#define XB_XSUB(j)  (1280 + 64 * (j))
#define XB_XGEN(j)  (2304 + 64 * (j))
#define XB_TOP      3328
#define XB_TOPGEN   3392
#define XCD_BAR_WORDS 3456
#define XB_SPIN_CAP (1u << 18)
__device__ __forceinline__ unsigned xb_ld(unsigned* p)              { return __hip_atomic_load(p, __ATOMIC_RELAXED, __HIP_MEMORY_SCOPE_AGENT); }
__device__ __forceinline__ unsigned xb_add(unsigned* p, unsigned v) { return __hip_atomic_fetch_add(p, v, __ATOMIC_RELAXED, __HIP_MEMORY_SCOPE_AGENT); }
__device__ __forceinline__ unsigned xb_xcc_id() { return (unsigned)__builtin_amdgcn_s_getreg((3 << 11) | 20) & 0xFu; }
#define XB_SPIN(cond, bar) do { unsigned _sp = 0; while (cond) { __builtin_amdgcn_s_sleep(1); \
    if ((++_sp & 255u) == 0u) { if (xb_ld(&(bar)[XB_TMO])) break; if (_sp > XB_SPIN_CAP) { atomicAdd(&(bar)[XB_TMO], 1u); break; } } } } while (0)
struct XcdBarrier { unsigned* bar; unsigned x; volatile LAS unsigned* st; };
__device__ __forceinline__ XcdBarrier xcd_barrier_post(unsigned* bar, volatile LAS unsigned* st) {
    XcdBarrier b; b.bar = bar; b.x = xb_xcc_id(); b.st = st;
    if (threadIdx.x == 0) (void)xb_add(&bar[XB_XCNT(b.x)], 1u);
    return b;
}
__device__ __forceinline__ void xcd_barrier_complete(unsigned* bar, unsigned x, unsigned& nloc, unsigned& nx) {
    const unsigned G = gridDim.x * gridDim.y * gridDim.z;
    unsigned sum, cnt, mine, sp = 0u;
    for (;;) {
        sum = 0u; cnt = 0u; mine = 0u;
#pragma unroll
        for (unsigned j = 0; j < 16; ++j) { const unsigned c = xb_ld(&bar[XB_XCNT(j)]); sum += c; cnt += (c > 0u) ? 1u : 0u; mine = (j == x) ? c : mine; }
        if (sum == G) break;
        __builtin_amdgcn_s_sleep(1);
        if ((++sp & 255u) == 0u) { if (xb_ld(&bar[XB_TMO])) break; if (sp > XB_SPIN_CAP) { atomicAdd(&bar[XB_TMO], 1u); break; } }
    }
    nloc = mine > 0u ? mine : 1u; nx = cnt > 0u ? cnt : 1u;
}
__device__ __forceinline__ void xcd_barrier(const XcdBarrier& b) {
    asm volatile("s_waitcnt vmcnt(0)" ::: "memory");
    __syncthreads();
    if (threadIdx.x == 0) {
        unsigned* bar = b.bar;
        __builtin_amdgcn_s_waitcnt(0);
        unsigned nloc = b.st[0], nx = b.st[1];
        if (nloc == 0u) { xcd_barrier_complete(bar, b.x, nloc, nx); b.st[0] = nloc; b.st[1] = nx; }
        const unsigned old = xb_add(&bar[XB_XSUB(b.x)], 1u);
        const unsigned gen = old / nloc;
        if (old + 1u == (gen + 1u) * nloc) {
            __builtin_amdgcn_fence(__ATOMIC_RELEASE, "agent");
            asm volatile("s_waitcnt vmcnt(0)" ::: "memory");
            const unsigned og = xb_add(&bar[XB_TOP], 1u);
            const unsigned tg = og / nx;
            if (og + 1u == (tg + 1u) * nx) xb_add(&bar[XB_TOPGEN], 1u);
            else XB_SPIN(xb_ld(&bar[XB_TOPGEN]) == tg, bar);
            __builtin_amdgcn_fence(__ATOMIC_ACQUIRE, "agent");
            xb_add(&bar[XB_XGEN(b.x)], 1u);
            asm volatile("s_waitcnt vmcnt(0)" ::: "memory");
        } else {
            XB_SPIN(xb_ld(&bar[XB_XGEN(b.x)]) == gen, bar);
            __builtin_amdgcn_fence(__ATOMIC_ACQUIRE, "agent");
            asm volatile("s_waitcnt vmcnt(0)" ::: "memory");
        }
    }
    __syncthreads();
}

struct Args { const float* in[25]; float* out; unsigned char* ws; int ph_lo, ph_hi; };

struct Ctx {
    int tid, lane, wave, gtid, gsize, gw, ngw;
    LAS unsigned char* lds;
};

template <class Epi>
__device__ __forceinline__ void nv_gemm(const Ctx& c, const bf16* A, int lda, const float* W, int ldw, int Mr, int N, int K, const Epi& epi) {
    const int ntn = N / 4; const long total = (long)ntn * (Mr / 4);
    for (long i = c.gtid; i < total; i += c.gsize) {
        const int tn = (int)(i % ntn), tm = (int)(i / ntn);
        float acc[4][4];
#pragma unroll
        for (int r = 0; r < 4; ++r)
#pragma unroll
            for (int q = 0; q < 4; ++q) acc[r][q] = 0.f;
        const bf16* a0 = A + (size_t)(tm * 4) * lda;
        const float* w0 = W + tn * 4;
        for (int k = 0; k < K; k += 8) {
            u32x4 av[4];
#pragma unroll
            for (int r = 0; r < 4; ++r) av[r] = *(const u32x4*)(a0 + (size_t)r * lda + k);
#pragma unroll
            for (int kk = 0; kk < 8; ++kk) {
                const f32x4 w = *(const f32x4*)(w0 + (size_t)(k + kk) * ldw);
#pragma unroll
                for (int r = 0; r < 4; ++r) {
                    const unsigned pr = av[r][kk >> 1];
                    const float a = (kk & 1) ? __uint_as_float(pr & 0xffff0000u) : __uint_as_float(pr << 16);
#pragma unroll
                    for (int q = 0; q < 4; ++q) acc[r][q] += a * w[q];
                }
            }
        }
#pragma unroll
        for (int r = 0; r < 4; ++r) epi(tm * 4 + r, tn * 4, (f32x4){acc[r][0], acc[r][1], acc[r][2], acc[r][3]});
    }
}

__device__ __forceinline__ void ln256(f32x4& v, const float* g, const float* b, int lane) {
    const float mean = wave_sum((v[0] + v[1]) + (v[2] + v[3])) * (1.f / 256.f);
    v = v - mean;
    const float var = wave_sum((v[0] * v[0] + v[1] * v[1]) + (v[2] * v[2] + v[3] * v[3])) * (1.f / 256.f);
    const float rstd = __builtin_amdgcn_rsqf(var + LN_EPS);
    const f32x4 gg = *(const f32x4*)(g + lane * 4), bb = *(const f32x4*)(b + lane * 4);
    v = v * rstd * gg + bb;
}
__device__ __forceinline__ f32x4 ld_bf4(const bf16* p) { const u32x2 w = *(const u32x2*)p; return (f32x4){__uint_as_float(w.x << 16), __uint_as_float(w.x & 0xffff0000u), __uint_as_float(w.y << 16), __uint_as_float(w.y & 0xffff0000u)}; }
__device__ __forceinline__ void st_bf4(bf16* p, f32x4 v) { u32x2 w; w.x = pk2(v[0], v[1]); w.y = pk2(v[2], v[3]); *(u32x2*)p = w; }

struct Lw {
    const float *w_in, *gm_ln_g, *gm_ln_b, *gm_w_s, *gm_b_s, *cf_dw_w, *cf_dw_b, *cf_ln_g, *cf_ln_b, *cf_pw, *pool_w, *pool_scale, *sc_w, *mix_norm_g, *w_o, *ln1_g, *ln1_b,
        *router_w, *router_b, *wg, *wu, *wd, *ln2_g, *ln2_b;
};
__device__ __forceinline__ Lw layer_weights(const Args& a, int l) {
    Lw w;
    w.w_in = a.in[1] + (size_t)l * DM * DIN; w.gm_ln_g = a.in[2] + l * DG; w.gm_ln_b = a.in[3] + l * DG; w.gm_w_s = a.in[4] + (size_t)l * 4 * CHUNK * CHUNK; w.gm_b_s = a.in[5] + l * 4 * CHUNK;
    w.cf_dw_w = a.in[6] + l * CONFK * DG; w.cf_dw_b = a.in[7] + l * DG; w.cf_ln_g = a.in[8] + l * DG; w.cf_ln_b = a.in[9] + l * DG; w.cf_pw = a.in[10] + (size_t)l * DG * DG;
    w.pool_w = a.in[11] + l * 4 * 64 * 64; w.pool_scale = a.in[12] + l * DG; w.sc_w = a.in[13] + l * 3 * DG; w.mix_norm_g = a.in[14] + l * DM; w.w_o = a.in[15] + (size_t)l * DM * DM;
    w.ln1_g = a.in[16] + l * DM; w.ln1_b = a.in[17] + l * DM; w.router_w = a.in[18]; w.router_b = a.in[19];
    w.wg = a.in[20] + (size_t)l * NE * DM * DE; w.wu = a.in[21] + (size_t)l * NE * DM * DE; w.wd = a.in[22] + (size_t)l * NE * DE * DM;
    w.ln2_g = a.in[23] + l * DM; w.ln2_b = a.in[24] + l * DM;
    return w;
}

__device__ __forceinline__ void nv_prologue(const Ctx& c, const float* x, bf16* XB) {
    constexpr size_t N4 = (size_t)M * DM / 4;
    for (size_t i0 = (size_t)c.gtid; i0 < N4; i0 += (size_t)c.gsize * 8) {
        f32x4 v[8];
#pragma unroll
        for (int j = 0; j < 8; ++j) { const size_t i = i0 + (size_t)j * c.gsize; if (i < N4) v[j] = *(const f32x4*)(x + i * 4); }
#pragma unroll
        for (int j = 0; j < 8; ++j) { const size_t i = i0 + (size_t)j * c.gsize; if (i < N4) st_bf4(XB + i * 4, v[j]); }
    }
}
typedef short bf16x8 __attribute__((ext_vector_type(8)));
__device__ __forceinline__ bf16x8 as_bf16x8(u32x4 v) { return __builtin_bit_cast(bf16x8, v); }
#define MFMA16(a, b, c) __builtin_amdgcn_mfma_f32_16x16x32_bf16((a), (b), (c), 0, 0, 0)
constexpr int YT_LD = 260;
constexpr int AT_LD = 264;
constexpr int VT_RS = 260;

__device__ __forceinline__ void small_weights(const Ctx& c, const Args& a, bf16* GMW, bf16* PWT, bf16* POOLT) {
    for (int i = c.gtid; i < NL * 4 * CHUNK * CHUNK; i += c.gsize) { const int s = i & 127, t = (i >> 7) & 127; GMW[i] = (bf16)((s <= t) ? f2bf(a.in[4][i]) : 0u); }
    for (int i = c.gtid; i < NL * DG * DG; i += c.gsize) { const int cc = i & 255, n = (i >> 8) & 255, l = i >> 16; PWT[i] = (bf16)f2bf(a.in[10][((size_t)l * DG + cc) * DG + n]); }
    for (int i = c.gtid; i < NL * 4 * 64 * 64; i += c.gsize) { const int d = i & 63, e = (i >> 6) & 63, lg = i >> 12; POOLT[i] = (bf16)f2bf(a.in[11][((size_t)lg * 64 + d) * 64 + e]); }
}

template <bool UMUL>
__device__ __forceinline__ void mix_final(const Ctx& c, const Lw& w, int t0, int grp, bf16* YN, const bf16* Z = nullptr) {
    const LAS float* YT = (const LAS float*)c.lds;
    const f32x4 g = *(const f32x4*)(w.mix_norm_g + grp * DG + c.lane * 4);
    u32x2 uu[16];
    if (UMUL) {
#pragma unroll
        for (int i = 0; i < 16; ++i) uu[i] = *(const u32x2*)(Z + (size_t)(t0 + c.wave * 16 + i) * DIN + c.lane * 4);
    }
#pragma unroll
    for (int i = 0; i < 16; ++i) {
        const int t = c.wave * 16 + i;
        f32x4 v = *(const LAS f32x4*)(YT + t * YT_LD + c.lane * 4);
        if (UMUL) v = v * (f32x4){__uint_as_float(uu[i].x << 16), __uint_as_float(uu[i].x & 0xffff0000u), __uint_as_float(uu[i].y << 16), __uint_as_float(uu[i].y & 0xffff0000u)};
        const float ms = wave_sum((v[0] * v[0] + v[1] * v[1]) + (v[2] * v[2] + v[3] * v[3])) * (1.f / 256.f);
        const float r = __builtin_amdgcn_rsqf(ms + RMS_EPS);
        st_bf4(YN + (size_t)(t0 + t) * DM + grp * DG + c.lane * 4, v * r * g);
    }
}

__device__ __forceinline__ void mix_conformer(const Ctx& c, const Lw& w, const bf16* Z, const bf16* PWT, int t0, bf16* YN) {
    LAS unsigned char* lds = c.lds;
    const int pos0 = t0 % SEQ;
    const int fr = c.lane & 15, fq = c.lane >> 4;
    bf16x8 Bf[2][8];
#pragma unroll
    for (int ct = 0; ct < 2; ++ct)
#pragma unroll
        for (int ks = 0; ks < 8; ++ks) Bf[ct][ks] = as_bf16x8(*(const u32x4*)(PWT + (size_t)(c.wave * 32 + ct * 16 + fr) * DG + ks * 32 + fq * 8));
    float wk[CONFK];
#pragma unroll
    for (int k = 0; k < CONFK; ++k) wk[k] = w.cf_dw_w[k * DG + (c.tid & 255)];
    const float b0 = w.cf_dw_b[c.tid & 255];
    const f32x4 lng = *(const f32x4*)(w.cf_ln_g + c.lane * 4), lnb = *(const f32x4*)(w.cf_ln_b + c.lane * 4);
    {
        const int c8 = (c.tid & 31) * 8, r0 = c.tid >> 5;
        u32x4 av[10], gv[10];
#pragma unroll
        for (int it = 0; it < 10; ++it) {
            const int r = r0 + 16 * it;
            av[it] = (u32x4){0u, 0u, 0u, 0u}; gv[it] = (u32x4){0u, 0u, 0u, 0u};
            if (r < 158 && pos0 + r - 30 >= 0) { const size_t zr = (size_t)(t0 + r - 30) * DIN; av[it] = *(const u32x4*)(Z + zr + 512 + c8); gv[it] = *(const u32x4*)(Z + zr + 768 + c8); }
        }
#pragma unroll
        for (int it = 0; it < 10; ++it) {
            const int r = r0 + 16 * it;
            if (r < 158) {
                u32x4 o;
#pragma unroll
                for (int j = 0; j < 4; ++j) {
                    const float a0 = __uint_as_float(av[it][j] << 16), a1 = __uint_as_float(av[it][j] & 0xffff0000u), g0 = __uint_as_float(gv[it][j] << 16), g1 = __uint_as_float(gv[it][j] & 0xffff0000u);
                    o[j] = pk2(a0 * sigmoidf_(g0), a1 * sigmoidf_(g1));
                }
                *(LAS u32x4*)(lds + r * 512 + c8 * 2) = o;
            }
        }
    }
    __syncthreads();
    constexpr int CT_OFF = 80896;
    {
        const int ch = c.tid & 255, tg = c.tid >> 8;
#pragma unroll 1
        for (int sb = 0; sb < 8; ++sb) {
            float acc[8];
#pragma unroll
            for (int j = 0; j < 8; ++j) acc[j] = b0;
            const int rb = tg * 64 + sb * 8;
#pragma unroll
            for (int r = 0; r < 38; ++r) {
                const float h0 = bf2f(*(const LAS bf16*)(lds + (rb + r) * 512 + ch * 2));
#pragma unroll
                for (int j = 0; j < 8; ++j) { const int k = r - j; if (k >= 0 && k < CONFK) acc[j] += wk[k] * h0; }
            }
#pragma unroll
            for (int j = 0; j < 8; ++j) *(LAS bf16*)(lds + CT_OFF + (rb + j) * 512 + ch * 2) = (bf16)f2bf(acc[j]);
        }
    }
    __syncthreads();
    {
        const f32x4 g = lng, b = lnb;
#pragma unroll 4
        for (int i = 0; i < 16; ++i) {
            const int t = c.wave * 16 + i;
            const u32x2 pv = *(const LAS u32x2*)(lds + CT_OFF + t * 512 + c.lane * 8);
            f32x4 v = (f32x4){__uint_as_float(pv.x << 16), __uint_as_float(pv.x & 0xffff0000u), __uint_as_float(pv.y << 16), __uint_as_float(pv.y & 0xffff0000u)};
            const float mean = wave_sum((v[0] + v[1]) + (v[2] + v[3])) * (1.f / 256.f);
            v = v - mean;
            const float var = wave_sum((v[0] * v[0] + v[1] * v[1]) + (v[2] * v[2] + v[3] * v[3])) * (1.f / 256.f);
            v = v * (__builtin_amdgcn_rsqf(var + LN_EPS)) * g + b;
            u32x2 o; o.x = pk2(siluf_(v[0]), siluf_(v[1])); o.y = pk2(siluf_(v[2]), siluf_(v[3]));
            *(LAS u32x2*)(lds + t * (AT_LD * 2) + c.lane * 8) = o;
        }
    }
    __syncthreads();
    {
        f32x4 C[8][2];
#pragma unroll
        for (int rt = 0; rt < 8; ++rt) { C[rt][0] = (f32x4){0.f, 0.f, 0.f, 0.f}; C[rt][1] = (f32x4){0.f, 0.f, 0.f, 0.f}; }
#pragma unroll
        for (int rt = 0; rt < 8; ++rt)
#pragma unroll
            for (int ks = 0; ks < 8; ++ks) {
                const bf16x8 Af = as_bf16x8(*(const LAS u32x4*)(lds + (rt * 16 + fr) * (AT_LD * 2) + (ks * 32 + fq * 8) * 2));
                C[rt][0] = MFMA16(Af, Bf[0][ks], C[rt][0]); C[rt][1] = MFMA16(Af, Bf[1][ks], C[rt][1]);
            }
        __syncthreads();
        LAS float* YT = (LAS float*)lds;
#pragma unroll
        for (int rt = 0; rt < 8; ++rt)
#pragma unroll
            for (int ct = 0; ct < 2; ++ct)
#pragma unroll
                for (int j = 0; j < 4; ++j) YT[(rt * 16 + fq * 4 + j) * YT_LD + c.wave * 32 + ct * 16 + fr] = C[rt][ct][j];
    }
    __syncthreads();
    mix_final<false>(c, w, t0, 1, YN);
}

__device__ __forceinline__ void mix_gmlp(const Ctx& c, const Lw& w, const bf16* Z, const bf16* GMW, int t0, bf16* YN) {
    LAS unsigned char* lds = c.lds;
    const int fr = c.lane & 15, fq = c.lane >> 4, h = c.wave >> 1, par = c.wave & 1;
    bf16x8 Af[4][4];
    float bsv[4][4];
#pragma unroll
    for (int i = 0; i < 4; ++i) {
#pragma unroll
        for (int ks = 0; ks <= i; ++ks) Af[i][ks] = as_bf16x8(*(const u32x4*)(GMW + ((size_t)(h * CHUNK + 16 * (par + 2 * i) + fr)) * CHUNK + ks * 32 + fq * 8));
#pragma unroll
        for (int j = 0; j < 4; ++j) bsv[i][j] = w.gm_b_s[h * CHUNK + 16 * (par + 2 * i) + fq * 4 + j];
    }
    {
        float g[4], b[4];
#pragma unroll
        for (int q = 0; q < 4; ++q) { g[q] = w.gm_ln_g[c.lane + 64 * q]; b[q] = w.gm_ln_b[c.lane + 64 * q]; }
        bf16 raw[16][4];
#pragma unroll
        for (int i = 0; i < 16; ++i)
#pragma unroll
            for (int q = 0; q < 4; ++q) raw[i][q] = Z[(size_t)(t0 + c.wave * 16 + i) * DIN + 256 + c.lane + 64 * q];
#pragma unroll
        for (int i = 0; i < 8; ++i) {
            const int s = c.wave * 16 + 2 * i;
            float v[2][4];
#pragma unroll
            for (int p = 0; p < 2; ++p) {
#pragma unroll
                for (int q = 0; q < 4; ++q) v[p][q] = bf2f(raw[2 * i + p][q]);
                const float mean = wave_sum((v[p][0] + v[p][1]) + (v[p][2] + v[p][3])) * (1.f / 256.f);
#pragma unroll
                for (int q = 0; q < 4; ++q) v[p][q] -= mean;
                const float var = wave_sum((v[p][0] * v[p][0] + v[p][1] * v[p][1]) + (v[p][2] * v[p][2] + v[p][3] * v[p][3])) * (1.f / 256.f);
                const float rstd = __builtin_amdgcn_rsqf(var + LN_EPS);
#pragma unroll
                for (int q = 0; q < 4; ++q) v[p][q] = v[p][q] * rstd * g[q] + b[q];
            }
#pragma unroll
            for (int q = 0; q < 4; ++q) *(LAS unsigned*)(lds + (c.lane + 64 * q) * VT_RS + s * 2) = pk2(v[0][q], v[1][q]);
        }
    }
    __syncthreads();
    bf16x8 Bf[4][4];
#pragma unroll
    for (int ct = 0; ct < 4; ++ct)
#pragma unroll
        for (int ks = 0; ks < 4; ++ks) {
            u32x4 t;
#pragma unroll
            for (int i = 0; i < 4; ++i) t[i] = *(const LAS unsigned*)(lds + (h * 64 + ct * 16 + fr) * VT_RS + (ks * 32 + fq * 8 + 2 * i) * 2);
            Bf[ct][ks] = as_bf16x8(t);
        }
    __syncthreads();
    LAS float* YT = (LAS float*)lds;
#pragma unroll
    for (int i = 0; i < 4; ++i) {
        const int R = par + 2 * i;
        f32x4 C[4];
#pragma unroll
        for (int ct = 0; ct < 4; ++ct) C[ct] = (f32x4){0.f, 0.f, 0.f, 0.f};
#pragma unroll
        for (int ks = 0; ks <= i; ++ks)
#pragma unroll
            for (int ct = 0; ct < 4; ++ct) C[ct] = MFMA16(Af[i][ks], Bf[ct][ks], C[ct]);
#pragma unroll
        for (int j = 0; j < 4; ++j) {
            const int t = 16 * R + fq * 4 + j; const float bs = bsv[i][j];
#pragma unroll
            for (int ct = 0; ct < 4; ++ct) YT[t * YT_LD + h * 64 + ct * 16 + fr] = C[ct][j] + bs;
        }
    }
    __syncthreads();
    mix_final<true>(c, w, t0, 0, YN, Z);
}

__device__ __forceinline__ void mix_pool(const Ctx& c, const Lw& w, const bf16* Z, const bf16* POOLT, int t0, bf16* YN) {
    LAS unsigned char* lds = c.lds;
    const int pos0 = t0 % SEQ;
    constexpr int PA_OFF = 73728;
    const int fr = c.lane & 15, fq = c.lane >> 4, g = c.wave >> 1, cb = (c.wave & 1) * 2;
    bf16x8 Bf[2][2]; float scv[2];
#pragma unroll
    for (int ct = 0; ct < 2; ++ct) { scv[ct] = w.pool_scale[g * 64 + (cb + ct) * 16 + fr];
#pragma unroll
        for (int ks = 0; ks < 2; ++ks) Bf[ct][ks] = as_bf16x8(*(const u32x4*)(POOLT + (size_t)(g * 64 + (cb + ct) * 16 + fr) * 64 + ks * 32 + fq * 8)); }
    {
        const int c8 = (c.tid & 31) * 8, r0 = c.tid >> 5;
        u32x4 zv[9];
#pragma unroll
        for (int it = 0; it < 9; ++it) { const int r = r0 + 16 * it; zv[it] = (u32x4){0u, 0u, 0u, 0u};
            if (r < 143 && pos0 + r - 15 >= 0) zv[it] = *(const u32x4*)(Z + (size_t)(t0 + r - 15) * DIN + 1024 + c8); }
#pragma unroll
        for (int it = 0; it < 9; ++it) { const int r = r0 + 16 * it; if (r < 143) *(LAS u32x4*)(lds + r * 512 + c8 * 2) = zv[it]; }
    }
    __syncthreads();
    {
        const int cp = c.tid & 127, tg = c.tid >> 7, W = 2 << (cp >> 5);
        float s0 = 0.f, s1 = 0.f;
        for (int i = 1; i < W; ++i) { const unsigned zv = *(const LAS unsigned*)(lds + (tg * 32 + 15 - i) * 512 + cp * 4); s0 += __uint_as_float(zv << 16); s1 += __uint_as_float(zv & 0xffff0000u); }
        for (int j = 0; j < 32; ++j) {
            const int tl = tg * 32 + j, pos = pos0 + tl;
            const unsigned zv = *(const LAS unsigned*)(lds + (tl + 15) * 512 + cp * 4);
            const float z0 = __uint_as_float(zv << 16), z1 = __uint_as_float(zv & 0xffff0000u);
            s0 += z0; s1 += z1;
            const float inv = __builtin_amdgcn_rcpf((float)((pos + 1 < W) ? pos + 1 : W));
            *(LAS unsigned*)(lds + PA_OFF + tl * (AT_LD * 2) + cp * 4) = pk2(s0 * inv - z0, s1 * inv - z1);
            const unsigned zo = *(const LAS unsigned*)(lds + (tl + 15 - (W - 1)) * 512 + cp * 4);
            s0 -= __uint_as_float(zo << 16); s1 -= __uint_as_float(zo & 0xffff0000u);
        }
    }
    __syncthreads();
    {
        f32x4 C[8][2];
#pragma unroll
        for (int rt = 0; rt < 8; ++rt) { C[rt][0] = (f32x4){0.f, 0.f, 0.f, 0.f}; C[rt][1] = (f32x4){0.f, 0.f, 0.f, 0.f}; }
#pragma unroll
        for (int rt = 0; rt < 8; ++rt)
#pragma unroll
            for (int ks = 0; ks < 2; ++ks) {
                const bf16x8 Af = as_bf16x8(*(const LAS u32x4*)(lds + PA_OFF + (rt * 16 + fr) * (AT_LD * 2) + (g * 64 + ks * 32 + fq * 8) * 2));
                C[rt][0] = MFMA16(Af, Bf[0][ks], C[rt][0]); C[rt][1] = MFMA16(Af, Bf[1][ks], C[rt][1]);
            }
        __syncthreads();
        LAS float* YT = (LAS float*)lds;
#pragma unroll
        for (int ct = 0; ct < 2; ++ct) {
            const int ch = g * 64 + (cb + ct) * 16 + fr; const float sc = scv[ct];
#pragma unroll
            for (int rt = 0; rt < 8; ++rt)
#pragma unroll
                for (int j = 0; j < 4; ++j) YT[(rt * 16 + fq * 4 + j) * YT_LD + ch] = C[rt][ct][j] * sc;
        }
    }
    __syncthreads();
    mix_final<false>(c, w, t0, 2, YN);
}

__device__ __forceinline__ void mix_sconv(const Ctx& c, const Lw& w, const bf16* Z, int t0, bf16* YN) {
    LAS float* YT = (LAS float*)c.lds;
    const int pos0 = t0 % SEQ;
#pragma unroll 1
    for (int task = c.tid; task < 1024; task += NT) {
        const int c8 = (task & 31) * 8, R0 = (task >> 5) * 4;
        u32x4 cv[6], hv[6], bv[4];
#pragma unroll
        for (int i = 0; i < 6; ++i) { cv[i] = (u32x4){0u, 0u, 0u, 0u}; hv[i] = (u32x4){0u, 0u, 0u, 0u};
            if (pos0 + R0 - 2 + i >= 0) { const size_t zr = (size_t)(t0 + R0 - 2 + i) * DIN; cv[i] = *(const u32x4*)(Z + zr + 1536 + c8); hv[i] = *(const u32x4*)(Z + zr + 1792 + c8); } }
#pragma unroll
        for (int j = 0; j < 4; ++j) bv[j] = *(const u32x4*)(Z + (size_t)(t0 + R0 + j) * DIN + 1280 + c8);
        float wk[3][8];
#pragma unroll
        for (int k = 0; k < 3; ++k) { const f32x4 w0 = *(const f32x4*)(w.sc_w + k * DG + c8), w1 = *(const f32x4*)(w.sc_w + k * DG + c8 + 4);
#pragma unroll
            for (int q = 0; q < 4; ++q) { wk[k][q] = w0[q]; wk[k][4 + q] = w1[q]; } }
        float p[6][8];
#pragma unroll
        for (int i = 0; i < 6; ++i)
#pragma unroll
            for (int q = 0; q < 4; ++q) { p[i][2 * q] = __uint_as_float(cv[i][q] << 16) * __uint_as_float(hv[i][q] << 16); p[i][2 * q + 1] = __uint_as_float(cv[i][q] & 0xffff0000u) * __uint_as_float(hv[i][q] & 0xffff0000u); }
#pragma unroll
        for (int j = 0; j < 4; ++j) {
            float o[8];
#pragma unroll
            for (int q = 0; q < 8; ++q) o[q] = wk[0][q] * p[j][q] + wk[1][q] * p[j + 1][q] + wk[2][q] * p[j + 2][q];
#pragma unroll
            for (int q = 0; q < 4; ++q) { o[2 * q] *= __uint_as_float(bv[j][q] << 16); o[2 * q + 1] *= __uint_as_float(bv[j][q] & 0xffff0000u); }
            *(LAS f32x4*)(YT + (R0 + j) * YT_LD + c8) = (f32x4){o[0], o[1], o[2], o[3]}; *(LAS f32x4*)(YT + (R0 + j) * YT_LD + c8 + 4) = (f32x4){o[4], o[5], o[6], o[7]};
        }
    }
    __syncthreads();
    mix_final<false>(c, w, t0, 3, YN);
}

__device__ __forceinline__ void mixer_phase(const Ctx& c0, const Lw& w, int l, const bf16* Z, const bf16* GMW, const bf16* PWT, const bf16* POOLT, bf16* YN) {
    for (int it = blockIdx.x; it < 512; it += gridDim.x) {
        Ctx c = c0; asm volatile("" : "+v"(c.tid)); c.lane = c.tid & 63;
        const int mx = it >> 7, t0 = (it & 127) * CHUNK;
        if (mx == 0) mix_conformer(c, w, Z, PWT + (size_t)l * DG * DG, t0, YN);
        else if (mx == 1) mix_gmlp(c, w, Z, GMW + (size_t)l * 4 * CHUNK * CHUNK, t0, YN);
        else if (mx == 2) mix_pool(c, w, Z, POOLT + (size_t)l * 4 * 64 * 64, t0, YN);
        else mix_sconv(c, w, Z, t0, YN);
        __syncthreads();
    }
}

struct EpiZ { bf16* Z; __device__ __forceinline__ void operator()(int r, int cc, f32x4 v) const { st_bf4(Z + (size_t)r * DIN + cc, v); } };
struct EpiU { float* U; const float* X; __device__ __forceinline__ void operator()(int r, int cc, f32x4 v) const { *(f32x4*)(U + (size_t)r * DM + cc) = v + ALPHA * *(const f32x4*)(X + (size_t)r * DM + cc); } };

struct GB { f32x4 g[4], b[4]; };
__device__ __forceinline__ GB load_gb(const float* g, const float* b, int lane) {
    GB r;
#pragma unroll
    for (int j = 0; j < 4; ++j) { r.g[j] = *(const f32x4*)(g + lane * 4 + 256 * j); r.b[j] = *(const f32x4*)(b + lane * 4 + 256 * j); }
    return r;
}
__device__ __forceinline__ void ln1024(f32x4 (&v)[4], const GB& gb) {
    float s = 0.f;
#pragma unroll
    for (int j = 0; j < 4; ++j) s += (v[j][0] + v[j][1]) + (v[j][2] + v[j][3]);
    const float mean = wave_sum(s) * (1.f / DM);
    float q = 0.f;
#pragma unroll
    for (int j = 0; j < 4; ++j) { v[j] = v[j] - mean; q += (v[j][0] * v[j][0] + v[j][1] * v[j][1]) + (v[j][2] * v[j][2] + v[j][3] * v[j][3]); }
    const float rstd = __builtin_amdgcn_rsqf(wave_sum(q) * (1.f / DM) + LN_EPS);
#pragma unroll
    for (int j = 0; j < 4; ++j) v[j] = v[j] * rstd * gb.g[j] + gb.b[j];
}
__device__ __forceinline__ void nv_ln1_router(const Ctx& c, const Lw& w, const float* U, bf16* X1B, unsigned* RTE, float* RTG) {
    LAS float* RWt = (LAS float*)c.lds;
    __syncthreads();
#pragma unroll
    for (int h = 0; h < 2; ++h) { const int ch = c.tid + 512 * h;
#pragma unroll
        for (int e4 = 0; e4 < 4; ++e4) { const f32x4 ww = *(const f32x4*)(w.router_w + (size_t)ch * NE + e4 * 4);
#pragma unroll
            for (int q = 0; q < 4; ++q) RWt[(e4 * 4 + q) * DM + ch] = ww[q]; } }
    __syncthreads();
    const GB gb = load_gb(w.ln1_g, w.ln1_b, c.lane);
    float rb[16];
#pragma unroll
    for (int e = 0; e < 16; ++e) rb[e] = w.router_b[e];
    f32x4 vn[4];
    if (c.gw < M) {
#pragma unroll
        for (int j = 0; j < 4; ++j) vn[j] = *(const f32x4*)(U + (size_t)c.gw * DM + c.lane * 4 + 256 * j);
    }
    for (int t = c.gw; t < M; t += c.ngw) {
        f32x4 v[4];
#pragma unroll
        for (int j = 0; j < 4; ++j) v[j] = vn[j];
        if (t + c.ngw < M) {
#pragma unroll
            for (int j = 0; j < 4; ++j) vn[j] = *(const f32x4*)(U + (size_t)(t + c.ngw) * DM + c.lane * 4 + 256 * j);
        }
        ln1024(v, gb);
#pragma unroll
        for (int j = 0; j < 4; ++j) st_bf4(X1B + (size_t)t * DM + c.lane * 4 + 256 * j, v[j]);
        float lg[16];
        int lo = c.lane * 4; asm volatile("" : "+v"(lo));
#pragma unroll
        for (int e0 = 0; e0 < 16; e0 += 4) {
            f32x4 ww[4][4];
#pragma unroll
            for (int ee = 0; ee < 4; ++ee)
#pragma unroll
                for (int j = 0; j < 4; ++j) ww[ee][j] = *(const LAS f32x4*)(RWt + (e0 + ee) * DM + lo + 256 * j);
            __builtin_amdgcn_sched_barrier(0);
#pragma unroll
            for (int ee = 0; ee < 4; ++ee) {
                float a = 0.f;
#pragma unroll
                for (int j = 0; j < 4; ++j) a += (v[j][0] * ww[ee][j][0] + v[j][1] * ww[ee][j][1]) + (v[j][2] * ww[ee][j][2] + v[j][3] * ww[ee][j][3]);
                lg[e0 + ee] = a;
            }
        }
#pragma unroll
        for (int e = 0; e < 16; ++e) lg[e] = wave_sum(lg[e]);
        float sel[16];
#pragma unroll
        for (int e = 0; e < 16; ++e) sel[e] = lg[e] + rb[e];
        float gs[4];
#pragma unroll
        for (int g = 0; g < 4; ++g) {
            const float a = sel[4 * g], b = sel[4 * g + 1], cc = sel[4 * g + 2], d = sel[4 * g + 3];
            const float h1 = fmaxf(a, b), l1_ = fminf(a, b), h2 = fmaxf(cc, d), l2_ = fminf(cc, d);
            gs[g] = fmaxf(h1, h2) + fmaxf(fminf(h1, h2), fmaxf(l1_, l2_));
        }
        int best = 0; float bsc = gs[0];
#pragma unroll
        for (int g = 1; g < 4; ++g) { const bool gt = gs[g] > bsc; best = gt ? g : best; bsc = gt ? gs[g] : bsc; }
        float sv[4], lv[4];
#pragma unroll
        for (int k = 0; k < 4; ++k) { sv[k] = sel[k]; lv[k] = lg[k];
#pragma unroll
            for (int g = 1; g < 4; ++g) { sv[k] = (best == g) ? sel[4 * g + k] : sv[k]; lv[k] = (best == g) ? lg[4 * g + k] : lv[k]; } }
        int k1 = 0; float s1 = sv[0], l1 = lv[0];
#pragma unroll
        for (int k = 1; k < 4; ++k) { const bool gt = sv[k] > s1; k1 = gt ? k : k1; l1 = gt ? lv[k] : l1; s1 = gt ? sv[k] : s1; }
        int k2 = -1; float s2 = -INFINITY, l2 = 0.f;
#pragma unroll
        for (int k = 0; k < 4; ++k) { const bool gt = (k != k1) && (k2 < 0 || sv[k] > s2); k2 = gt ? k : k2; l2 = gt ? lv[k] : l2; s2 = gt ? sv[k] : s2; }
        const int i1 = best * 4 + k1, i2 = best * 4 + k2;
        const float mx = fmaxf(l1, l2), e1 = __expf(l1 - mx), e2 = __expf(l2 - mx), inv = 1.0f / (e1 + e2);
        if (c.lane == 0) { RTE[t] = (unsigned)i1 | ((unsigned)i2 << 8); RTG[2 * t] = e1 * inv; RTG[2 * t + 1] = e2 * inv; }
    }
}
constexpr int CW_CNT = 8192;
__device__ __forceinline__ void moe_ranks(const Ctx& c, const unsigned* RTE, int* RTP, unsigned* CNT, int* LIST) {
    LAS int* LC = (LAS int*)c.lds;
    __syncthreads();
    if (c.tid < 32) LC[c.tid] = 0;
    __syncthreads();
    for (int t = c.gw; t < M; t += c.ngw) {
        if (c.lane == 0) { const unsigned ee = RTE[t]; RTP[2 * t] = __hip_atomic_fetch_add(&LC[ee & 0xff], 1, __ATOMIC_RELAXED, __HIP_MEMORY_SCOPE_WORKGROUP); RTP[2 * t + 1] = __hip_atomic_fetch_add(&LC[(ee >> 8) & 0xff], 1, __ATOMIC_RELAXED, __HIP_MEMORY_SCOPE_WORKGROUP); }
    }
    __syncthreads();
    if (c.tid < 16) LC[16 + c.tid] = (int)atomicAdd(&CNT[c.tid], (unsigned)LC[c.tid]);
    __syncthreads();
    for (int t = c.gw; t < M; t += c.ngw) {
        if (c.lane == 0) { const unsigned ee = RTE[t]; const int e0 = ee & 0xff, e1 = (ee >> 8) & 0xff; const int p0 = RTP[2 * t] + LC[16 + e0], p1 = RTP[2 * t + 1] + LC[16 + e1];
            RTP[2 * t] = p0; RTP[2 * t + 1] = p1; LIST[e0 * M + p0] = t; LIST[e1 * M + p1] = t; }
    }
}
constexpr int LDS_TAB_OFF = 131072;
__device__ __forceinline__ void moe_tiles(const Ctx& c, const unsigned* CNT) {
    LAS int* ts = (LAS int*)(c.lds + LDS_TAB_OFF);
    __syncthreads();
    if (c.tid < 17) { int s = 0; for (int e = 0; e < c.tid; ++e) s += (int)((CNT[e] + 255u) >> 8); ts[c.tid] = s; }
    __syncthreads();
}
constexpr int LDS_IDX_OFF = LDS_TAB_OFF + 256, MAX_UNITS = 15;
struct CSc { int s0, s1; float g0, g1; };
__device__ __forceinline__ CSc comb_sc(const LAS int* ts, const unsigned* RTE, const float* RTG, const int* RTP, int t) {
    CSc r; const unsigned ee = RTE[t]; r.s0 = ts[ee & 0xff] * 256 + RTP[2 * t]; r.s1 = ts[(ee >> 8) & 0xff] * 256 + RTP[2 * t + 1]; r.g0 = RTG[2 * t]; r.g1 = RTG[2 * t + 1]; return r;
}
struct CRows { u32x2 x[4], a[4], b[4]; };
__device__ __forceinline__ void comb_rows(CRows& R, const bf16* X1, const bf16* YS, int t, const CSc& s, int lane) {
#pragma unroll
    for (int j = 0; j < 4; ++j) { const int col = lane * 4 + 256 * j; R.x[j] = *(const u32x2*)(X1 + (size_t)t * DM + col); R.a[j] = *(const u32x2*)(YS + (size_t)s.s0 * DM + col); R.b[j] = *(const u32x2*)(YS + (size_t)s.s1 * DM + col); }
}
__device__ __forceinline__ f32x4 bf4f(u32x2 w) { return (f32x4){__uint_as_float(w.x << 16), __uint_as_float(w.x & 0xffff0000u), __uint_as_float(w.y << 16), __uint_as_float(w.y & 0xffff0000u)}; }
__device__ __forceinline__ void moe_combine_ln2(const Ctx& c, const Lw& w, const bf16* X1, const bf16* YS, const unsigned* RTE, const float* RTG, const int* RTP, float* X2, bf16* XB) {
    const LAS int* ts = (const LAS int*)(c.lds + LDS_TAB_OFF);
    int t = c.gw; if (t >= M) return;
    const GB gb = load_gb(w.ln2_g, w.ln2_b, c.lane);
    CSc sA = comb_sc(ts, RTE, RTG, RTP, t), sB = sA; CRows Rn;
    comb_rows(Rn, X1, YS, t, sA, c.lane);
    if (t + c.ngw < M) sB = comb_sc(ts, RTE, RTG, RTP, t + c.ngw);
    for (; t < M; t += c.ngw) {
        const CRows R = Rn; const CSc cur = sA; sA = sB;
        if (t + c.ngw < M) comb_rows(Rn, X1, YS, t + c.ngw, sA, c.lane);
        if (t + 2 * c.ngw < M) sB = comb_sc(ts, RTE, RTG, RTP, t + 2 * c.ngw);
        f32x4 v[4];
#pragma unroll
        for (int j = 0; j < 4; ++j) v[j] = ALPHA * bf4f(R.x[j]) + cur.g0 * bf4f(R.a[j]) + cur.g1 * bf4f(R.b[j]);
        ln1024(v, gb);
#pragma unroll
        for (int j = 0; j < 4; ++j) { *(f32x4*)(X2 + (size_t)t * DM + c.lane * 4 + 256 * j) = v[j]; st_bf4(XB + (size_t)t * DM + c.lane * 4 + 256 * j, v[j]); }
    }
}

namespace pg8 {
#define PG8_LAS __attribute__((address_space(3)))
typedef unsigned short bf16_t;
typedef short bf16x8 __attribute__((ext_vector_type(8)));
typedef float f32x4 __attribute__((ext_vector_type(4)));
typedef unsigned u32x4 __attribute__((ext_vector_type(4)));
constexpr int BM = 256, BK = 64, HALF = 128, HTB = HALF * BK * 2  , STAGE_BYTES = 8 * HTB, NXCD = 8, WGM = 8;

__host__ __device__ __forceinline__ int lds_byte(int r, int c) { const int st = (r >> 4) * 2 + (c >> 5), rr = r & 15, cc = c & 31, ob = rr * 64 + cc * 2; return st * 1024 + (ob ^ (((ob >> 9) & 1) << 5)); }
__host__ __device__ __forceinline__ void stage_rc(int b, int& R, int& C) { const int st = b / 1024, sb = b % 1024, swz = sb ^ (((sb >> 9) & 1) << 5); R = (st >> 1) * 16 + swz / 64; C = (st & 1) * 32 + (swz % 64) / 2; }
__host__ __device__ __forceinline__ int perm32(int rho) { const int n = rho >> 4, i = rho & 15; return 8 * (i >> 2) + 4 * n + (i & 3); }

struct Unit { int pm, pn; };
struct Gemm { const bf16_t* A; const bf16_t* Bt; int M, N, K; };

struct StaticOrder {
    int nM, nN, nwg, G, c;
    __host__ __device__ void init(int M, int N, int G_, int c_) { nM = M / BM; nN = N / BM; nwg = nM * nN; G = G_; c = c_; }
    __host__ __device__ bool next(int i, Unit& u) const {
        const long L = (long)i * G + c; if (L >= nwg) return false;
        int wgid = (int)L; { const int q = nwg / NXCD, r = nwg % NXCD, xcd = wgid % NXCD, off = wgid / NXCD; wgid = (xcd < r ? xcd * (q + 1) : r * (q + 1) + (xcd - r) * q) + off; }
        const int nig = WGM * nN, gid = wgid / nig, fm = gid * WGM, gsz = (nM - fm) < WGM ? (nM - fm) : WGM;
        u.pm = fm + ((wgid % nig) % gsz); u.pn = (wgid % nig) / gsz; return true;
    }
    __device__ __forceinline__ void a_ready(const Unit&) const {}
    __device__ __forceinline__ void done(const Unit&) const {}
};

__device__ __forceinline__ unsigned cvt_pk_bf16(float lo, float hi) { unsigned r; asm volatile("v_cvt_pk_bf16_f32 %0, %1, %2" : "=v"(r) : "v"(lo), "v"(hi)); return r; }
typedef float f32x2 __attribute__((ext_vector_type(2)));
__device__ __forceinline__ f32x2 gelu_pk(f32x2 v) {
    const f32x2 av = __builtin_elementwise_abs(v), d = av * 0.2316418882f + 1.0f;
    f32x2 t; t.x = __builtin_amdgcn_rcpf(d.x); t.y = __builtin_amdgcn_rcpf(d.y);
    f32x2 q = t * 0.5307027145f + (-0.7265760135f); q = q * t + 0.7107068705f; q = q * t + (-0.142248368f); q = q * t + 0.127414796f; q = q * t;
    const f32x2 s = (v * v) * (-0.72134752044f);
    f32x2 e; e.x = __builtin_amdgcn_exp2f(s.x); e.y = __builtin_amdgcn_exp2f(s.y);
    const f32x2 m = v * (q * e), r = v - m;
    f32x2 o; o.x = v.x < 0.f ? m.x : r.x; o.y = v.y < 0.f ? m.y : r.y; return o;
}

template <int ACT  > struct EpiBf16 {
    static constexpr bool PERM = true, AFTER_DRAIN = false; static_assert(ACT == 0 || ACT == 1, "EpiBf16: ACT is 0 (none) or 1 (gelu_pk)");
    bf16_t* O; int ldc; const float* bias; int split_cols; size_t split_stride; float scale0; int pn_mask;
    __device__ __forceinline__ void operator()(const f32x4 (&acc)[2][2][4][2], const Unit& u, int wr, int wc, int fr, int fq) const {
        const int row0 = u.pm * BM + wr * 64 + fr; int colt = (u.pn & pn_mask) * BM; bf16_t* base = O;
        float sc = 1.f; if (split_cols) { const int t = colt / split_cols; base += (size_t)t * split_stride; colt -= t * split_cols; if (t == 0) sc = scale0; }
        const int col0 = colt + wc * 32 + 8 * fq, bcol0 = (u.pn & pn_mask) * BM + wc * 32 + 8 * fq;
        f32x4 bv[2][2];
#pragma unroll
        for (int bj = 0; bj < 2; ++bj)
#pragma unroll
            for (int n = 0; n < 2; ++n) bv[bj][n] = bias ? *(const f32x4*)(bias + bcol0 + bj * HALF + 4 * n) : (f32x4){0.f, 0.f, 0.f, 0.f};
#pragma unroll
        for (int ai = 0; ai < 2; ++ai)
#pragma unroll
            for (int m = 0; m < 4; ++m) { bf16_t* rowp = base + (size_t)(row0 + ai * HALF + m * 16) * ldc + col0;
#pragma unroll
                for (int bj = 0; bj < 2; ++bj) { f32x4 v0 = acc[ai][bj][m][0] + bv[bj][0], v1 = acc[ai][bj][m][1] + bv[bj][1];
                    if (ACT == 1) { f32x2 a = gelu_pk((f32x2){v0[0], v0[1]}), b = gelu_pk((f32x2){v0[2], v0[3]}), c = gelu_pk((f32x2){v1[0], v1[1]}), d = gelu_pk((f32x2){v1[2], v1[3]});
                        v0 = (f32x4){a.x, a.y, b.x, b.y}; v1 = (f32x4){c.x, c.y, d.x, d.y}; }
                    v0 = v0 * sc; v1 = v1 * sc; u32x4 w; w.x = cvt_pk_bf16(v0[0], v0[1]); w.y = cvt_pk_bf16(v0[2], v0[3]); w.z = cvt_pk_bf16(v1[0], v1[1]); w.w = cvt_pk_bf16(v1[2], v1[3]);
                    *(u32x4*)(rowp + bj * HALF) = w; } }
    }
};


struct EpiResF32 {
    static constexpr bool PERM = false, AFTER_DRAIN = false;
    const float* X; float* U; float alpha;
    __device__ __forceinline__ void operator()(const f32x4 (&acc)[2][2][4][2], const Unit& u, int wr, int wc, int fr, int fq) const {
        const int col0 = u.pn * BM + wc * 32 + 4 * fq;
#pragma unroll
        for (int ai = 0; ai < 2; ++ai)
#pragma unroll
            for (int m = 0; m < 4; ++m) { const size_t off = (size_t)(u.pm * BM + ai * HALF + wr * 64 + m * 16 + fr) * 1024 + col0;
#pragma unroll
                for (int bj = 0; bj < 2; ++bj)
#pragma unroll
                    for (int n = 0; n < 2; ++n) *(f32x4*)(U + off + bj * HALF + n * 16) = acc[ai][bj][m][n] + alpha * *(const f32x4*)(X + off + bj * HALF + n * 16); }
    }
};

struct MoeOrder {
    const PG8_LAS int* ts; int G, c;
    __device__ __forceinline__ bool next(int i, Unit& u) const {
        const int L = i * G + c; if (L >= __builtin_amdgcn_readfirstlane(ts[16]) * 4) return false;
        const int rt = L >> 2; int e = 0;
#pragma unroll
        for (int k = 1; k < 16; ++k) e += (rt >= ts[k]) ? 1 : 0;
        u.pm = rt; u.pn = __builtin_amdgcn_readfirstlane(e) * 4 + (L & 3); return true;
    }
    __device__ __forceinline__ void a_ready(const Unit&) const {}
    __device__ __forceinline__ void done(const Unit&) const {}
};
struct EpiSwiGLU {
    static constexpr bool PERM = true, AFTER_DRAIN = false;
    bf16_t* H;
    __device__ __forceinline__ void operator()(const f32x4 (&acc)[2][2][4][2], const Unit& u, int wr, int wc, int fr, int fq) const {
        const int row0 = u.pm * BM + wr * 64 + fr, col0 = (u.pn & 3) * HALF + wc * 32 + 8 * fq;
#pragma unroll
        for (int ai = 0; ai < 2; ++ai)
#pragma unroll
            for (int m = 0; m < 4; ++m) {
                u32x4 w4;
#pragma unroll
                for (int n = 0; n < 2; ++n) {
                    const f32x4 g = acc[ai][0][m][n], up = acc[ai][1][m][n]; f32x4 h;
#pragma unroll
                    for (int q = 0; q < 4; ++q) h[q] = g[q] * __builtin_amdgcn_rcpf(1.0f + __builtin_amdgcn_exp2f(-1.44269504089f * g[q])) * up[q];
                    w4[2 * n] = cvt_pk_bf16(h[0], h[1]); w4[2 * n + 1] = cvt_pk_bf16(h[2], h[3]);
                }
                *(u32x4*)(H + (size_t)(row0 + ai * HALF + m * 16) * 512 + col0) = w4;
            }
    }
};
template <class Epi, class Sched, bool ALIGN_EPI = false, bool SP2 = false, bool GATHER = false>
__device__ __forceinline__ void gemm_phase(PG8_LAS unsigned char* lds, const Gemm g, const Sched& S, const Epi& E, const int tid, const PG8_LAS int* idx = nullptr) {
    static_assert(!GATHER || SP2, "GATHER is implemented for the SP2 loop only");
    const int wid = __builtin_amdgcn_readfirstlane(tid >> 6), lane = tid & 63, wr = wid >> 2, wc = wid & 3, fr = lane & 15, fq = lane >> 4;
    const int K = g.K, nt = K / BK;
    unsigned voffA[2], voffB[2]; int RA[2], CA[2];
#pragma unroll
    for (int i = 0; i < 2; ++i) { int R, C; stage_rc(tid * 16 + i * 8192, R, C); const int Rb = Epi::PERM ? ((R & ~31) + perm32(R & 31)) : R; RA[i] = R; CA[i] = C;
        voffA[i] = (unsigned)(R * K + C) * 2u; voffB[i] = (unsigned)(Rb * K + C) * 2u; }
    unsigned gA[2][2], gN[2][2], gS[2][2];
#define PG8_GIDX(dst, u_) do { _Pragma("unroll") for (int _h = 0; _h < 2; ++_h) _Pragma("unroll") for (int _i = 0; _i < 2; ++_i) dst[_h][_i] = (unsigned)idx[(u_) * 256 + _h * HALF + RA[_i]] * (unsigned)(K * 2) + (unsigned)(CA[_i] * 2); } while (0)
#define PG8_STAGE_AC(bufoff, gbase, h) do { if constexpr (GATHER) PG8_STAGE(bufoff, gbase, gA[h]); else PG8_STAGE(bufoff, (gbase) + (h) * hstep, voffA); } while (0)
#define PG8_STAGE_AS(bufoff, gbase, h) do { if constexpr (GATHER) PG8_STAGE(bufoff, gbase, gS[h]); else PG8_STAGE(bufoff, (gbase) + (h) * hstep, voffA); } while (0)
    const size_t kstep = (size_t)(BK * 2);
    const size_t hstep = (size_t)HALF * K * 2;
    const size_t tstep = 2 * hstep;
    const unsigned ldsw = (unsigned)wid * 1024u;
    const int aoff = lds_byte(wr * 64 + fr, fq * 8), boff = lds_byte(wc * 32 + fr, fq * 8);
#define PG8_SA(b, h) (((b) * 2 + (h)) * HTB)
#define PG8_SB(b, h) ((4 + (b) * 2 + (h)) * HTB)
#define PG8_STAGE(bufoff, gbase, voff) do { _Pragma("unroll") for (int _i = 0; _i < 2; ++_i) \
        __builtin_amdgcn_global_load_lds((const unsigned*)((const char*)(gbase) + (voff)[_i]), (PG8_LAS unsigned*)(lds + (bufoff) + ldsw + _i * 8192), 16, 0, 0); } while (0)
#define PG8_LDA(dst, b, h) do { _Pragma("unroll") for (int m = 0; m < 4; ++m) _Pragma("unroll") for (int k = 0; k < 2; ++k) dst[m][k] = *(const PG8_LAS bf16x8*)(lds + PG8_SA(b, h) + aoff + m * 2048 + k * 1024); } while (0)
#define PG8_LDB(dst, b, h) do { _Pragma("unroll") for (int n = 0; n < 2; ++n) _Pragma("unroll") for (int k = 0; k < 2; ++k) dst[n][k] = *(const PG8_LAS bf16x8*)(lds + PG8_SB(b, h) + boff + n * 2048 + k * 1024); } while (0)
#define PG8_MMA(ai, bj, At, Bt) do { __builtin_amdgcn_s_setprio(1); _Pragma("unroll") for (int m = 0; m < 4; ++m) _Pragma("unroll") for (int n = 0; n < 2; ++n) _Pragma("unroll") for (int k = 0; k < 2; ++k) \
        acc[ai][bj][m][n] = __builtin_amdgcn_mfma_f32_16x16x32_bf16(Bt[n][k], At[m][k], acc[ai][bj][m][n], 0, 0, 0); __builtin_amdgcn_s_setprio(0); } while (0)
#define PG8_WAIT_V(n) asm volatile("s_waitcnt vmcnt(" #n ")" ::: "memory")
#define PG8_WAIT_L(n) asm volatile("s_waitcnt lgkmcnt(" #n ")" ::: "memory")
#define PG8_BAR __builtin_amdgcn_s_barrier()
#define PG8_SCHED __builtin_amdgcn_sched_barrier(0)
    Unit cur, nxt; int ui = 0;
    if (!S.next(0, cur)) return;
    f32x4 acc[2][2][4][2];
#pragma unroll
    for (int a = 0; a < 2; ++a)
#pragma unroll
        for (int b = 0; b < 2; ++b)
#pragma unroll
            for (int m = 0; m < 4; ++m)
#pragma unroll
                for (int n = 0; n < 2; ++n) acc[a][b][m][n] = (f32x4){0.f, 0.f, 0.f, 0.f};
    bf16x8 At[4][2], B0[2][2], B1[2][2];
    const char* cA = (const char*)g.A + (GATHER ? (size_t)0 : (size_t)cur.pm * tstep); const char* cB = (const char*)g.Bt + (size_t)cur.pn * tstep;
    if constexpr (GATHER) PG8_GIDX(gA, 0);
    S.a_ready(cur);
    if constexpr (SP2) {
        PG8_STAGE(PG8_SB(0, 0), cB, voffB); PG8_STAGE(PG8_SB(0, 1), cB + hstep, voffB); PG8_STAGE_AC(PG8_SA(0, 0), cA, 0); PG8_STAGE_AC(PG8_SA(0, 1), cA, 1);
        if (wr == 1) PG8_BAR;
        PG8_WAIT_V(2); PG8_BAR;
        PG8_STAGE(PG8_SB(1, 0), cB + kstep, voffB); PG8_STAGE_AC(PG8_SA(1, 0), cA + kstep, 0); PG8_STAGE(PG8_SB(1, 1), cB + hstep + kstep, voffB);
        PG8_WAIT_V(6); PG8_BAR;
    } else {
        PG8_STAGE(PG8_SB(0, 0), cB, voffB); PG8_STAGE(PG8_SA(0, 0), cA, voffA); PG8_STAGE(PG8_SB(0, 1), cB + hstep, voffB); PG8_STAGE(PG8_SA(0, 1), cA + hstep, voffA);
        if (wr == 1) PG8_BAR;
        PG8_WAIT_V(4); PG8_BAR;
        PG8_STAGE(PG8_SB(1, 0), cB + kstep, voffB); PG8_STAGE(PG8_SA(1, 0), cA + kstep, voffA); PG8_STAGE(PG8_SB(1, 1), cB + hstep + kstep, voffB);
        PG8_WAIT_V(6); PG8_BAR;
    }
    for (;;) {
        const bool has_next = S.next(ui + 1, nxt);
        if constexpr (GATHER) { if (has_next) PG8_GIDX(gN, ui + 1); else {
#pragma unroll
            for (int _h = 0; _h < 2; ++_h) { gN[_h][0] = gA[_h][0]; gN[_h][1] = gA[_h][1]; } } }
        const char* nA = (has_next && !GATHER) ? (const char*)g.A + (size_t)nxt.pm * tstep : cA; const char* nB = has_next ? (const char*)g.Bt + (size_t)nxt.pn * tstep : cB;
        for (int t = 0; t < nt; t += 2) {
            const bool last = (t == nt - 2);
            const char* a1 = cA + (size_t)(t + 1) * kstep;
            const char* a2 = last ? nA : cA + (size_t)(t + 2) * kstep; const char* b2 = last ? nB : cB + (size_t)(t + 2) * kstep;
            const char* a3 = a2 + kstep; const char* b3 = b2 + kstep;
            if (last && has_next) S.a_ready(nxt);
            if constexpr (GATHER) {
#pragma unroll
                for (int _h = 0; _h < 2; ++_h) { gS[_h][0] = last ? gN[_h][0] : gA[_h][0]; gS[_h][1] = last ? gN[_h][1] : gA[_h][1]; } }
            if constexpr (SP2) {
            PG8_LDB(B0, 0, 0); PG8_LDB(B1, 0, 1); PG8_SCHED; PG8_LDA(At, 0, 0); PG8_STAGE_AC(PG8_SA(1, 1), a1, 1);
            PG8_WAIT_V(8); PG8_WAIT_L(0); PG8_BAR; PG8_MMA(0, 0, At, B0); PG8_MMA(0, 1, At, B1); PG8_BAR; PG8_SCHED;
            PG8_LDA(At, 0, 1); PG8_STAGE(PG8_SB(0, 0), b2, voffB); PG8_STAGE(PG8_SB(0, 1), b2 + hstep, voffB); PG8_STAGE_AS(PG8_SA(0, 0), a2, 0);
            PG8_WAIT_V(8); PG8_WAIT_L(0); PG8_BAR; PG8_MMA(1, 0, At, B0); PG8_MMA(1, 1, At, B1); PG8_BAR; PG8_SCHED;
            PG8_LDB(B0, 1, 0); PG8_LDB(B1, 1, 1); PG8_SCHED; PG8_LDA(At, 1, 0); PG8_STAGE_AS(PG8_SA(0, 1), a2, 1);
            PG8_WAIT_V(8); PG8_WAIT_L(0); PG8_BAR; PG8_MMA(0, 0, At, B0); PG8_MMA(0, 1, At, B1); PG8_BAR; PG8_SCHED;
            PG8_LDA(At, 1, 1); PG8_STAGE(PG8_SB(1, 0), b3, voffB); PG8_STAGE(PG8_SB(1, 1), b3 + hstep, voffB); PG8_STAGE_AS(PG8_SA(1, 0), a3, 0);
            PG8_WAIT_V(8); PG8_WAIT_L(0); PG8_BAR; PG8_MMA(1, 0, At, B0); PG8_MMA(1, 1, At, B1); PG8_BAR; PG8_SCHED;
            } else {
            PG8_LDB(B0, 0, 0); PG8_SCHED; PG8_LDA(At, 0, 0); PG8_STAGE(PG8_SA(1, 1), a1 + hstep, voffA);
            PG8_WAIT_L(8); PG8_BAR; PG8_WAIT_L(0); PG8_MMA(0, 0, At, B0); PG8_BAR; PG8_SCHED;
            PG8_LDB(B1, 0, 1); PG8_STAGE(PG8_SB(0, 0), b2, voffB);
            PG8_BAR; PG8_WAIT_L(0); PG8_MMA(0, 1, At, B1); PG8_BAR;
            PG8_LDA(At, 0, 1); PG8_STAGE(PG8_SA(0, 0), a2, voffA);
            PG8_BAR; PG8_WAIT_L(0); PG8_MMA(1, 0, At, B0); PG8_BAR; PG8_SCHED;
            PG8_STAGE(PG8_SB(0, 1), b2 + hstep, voffB);
            PG8_WAIT_V(6); PG8_BAR; PG8_MMA(1, 1, At, B1); PG8_BAR;
            PG8_LDB(B0, 1, 0); PG8_SCHED; PG8_LDA(At, 1, 0); PG8_STAGE(PG8_SA(0, 1), a2 + hstep, voffA);
            PG8_WAIT_L(8); PG8_BAR; PG8_WAIT_L(0); PG8_MMA(0, 0, At, B0); PG8_BAR; PG8_SCHED;
            PG8_LDB(B1, 1, 1); PG8_STAGE(PG8_SB(1, 0), b3, voffB);
            PG8_BAR; PG8_WAIT_L(0); PG8_MMA(0, 1, At, B1); PG8_BAR;
            PG8_LDA(At, 1, 1); PG8_STAGE(PG8_SA(1, 0), a3, voffA);
            PG8_BAR; PG8_WAIT_L(0); PG8_MMA(1, 0, At, B0); PG8_BAR; PG8_SCHED;
            PG8_STAGE(PG8_SB(1, 1), b3 + hstep, voffB);
            PG8_WAIT_V(6); PG8_BAR; PG8_MMA(1, 1, At, B1); PG8_BAR;
            }
        }
        if constexpr (ALIGN_EPI) { if (wr == 0) PG8_BAR; }
        if constexpr (!Epi::AFTER_DRAIN) { E(acc, cur, wr, wc, fr, fq); S.done(cur); }
        if (!has_next) break;
#pragma unroll
        for (int a = 0; a < 2; ++a)
#pragma unroll
            for (int b = 0; b < 2; ++b)
#pragma unroll
                for (int m = 0; m < 4; ++m)
#pragma unroll
                    for (int n = 0; n < 2; ++n) acc[a][b][m][n] = (f32x4){0.f, 0.f, 0.f, 0.f};
        cur = nxt; cA = nA; cB = nB; ++ui;
        if constexpr (GATHER) {
#pragma unroll
            for (int _h = 0; _h < 2; ++_h) { gA[_h][0] = gN[_h][0]; gA[_h][1] = gN[_h][1]; } }
        if constexpr (ALIGN_EPI) { if (wr == 1) PG8_BAR; }
    }
    PG8_WAIT_V(0);
    if constexpr (!ALIGN_EPI) { if (wr == 0) PG8_BAR; }
    PG8_BAR;
    if constexpr (Epi::AFTER_DRAIN) { E.fused(acc, cur, wr, wc, fr, fq, lds, wid, lane); S.done(cur); }
#undef PG8_SA
#undef PG8_GIDX
#undef PG8_STAGE_AC
#undef PG8_STAGE_AS
#undef PG8_SB
#undef PG8_STAGE
#undef PG8_LDA
#undef PG8_LDB
#undef PG8_MMA
#undef PG8_WAIT_V
#undef PG8_WAIT_L
#undef PG8_BAR
#undef PG8_SCHED
}
}


template <class Sched>
__device__ __forceinline__ void moe_idx_tables(const Ctx& c, const Sched& S, const unsigned* CNT, const int* LIST) {
    const LAS int* ts = (const LAS int*)(c.lds + LDS_TAB_OFF); LAS int* idx = (LAS int*)(c.lds + LDS_IDX_OFF);
    for (int i = 0; i < MAX_UNITS; ++i) {
        pg8::Unit u; if (!S.next(i, u)) break;
        const int e = u.pn >> 2, lt = u.pm - ts[e]; const int cnt = (int)CNT[e];
        if (c.tid < 256) { const int p = lt * 256 + c.tid; idx[i * 256 + c.tid] = (p < cnt) ? LIST[e * M + p] : 0; }
    }
    __syncthreads();
}
struct TItem { const float* src; bf16* dst; int N, K; };
__device__ __forceinline__ TItem titem(const Args& a, unsigned char* ws, int it) {
    constexpr int I_IN = NL * 16 * 64, I_O = NL * 16 * 32, I_G = NL * NE * 16 * 16;
    TItem t; int r = it;
    if (r < I_IN) { const int l = r >> 10, kb = (r >> 6) & 15, nb = r & 63; t.N = DIN; t.K = DM; t.src = a.in[1] + (size_t)l * DM * DIN + (size_t)(kb * 64) * DIN + nb * 32; t.dst = (bf16*)(ws + WS_WIN) + (size_t)(l * DIN + nb * 32) * DM + kb * 64; return t; } r -= I_IN;
    if (r < I_O) { const int l = r >> 9, kb = (r >> 5) & 15, nb = r & 31; t.N = DM; t.K = DM; t.src = a.in[15] + (size_t)l * DM * DM + (size_t)(kb * 64) * DM + nb * 32; t.dst = (bf16*)(ws + WS_WO) + (size_t)(l * DM + nb * 32) * DM + kb * 64; return t; } r -= I_O;
    if (r < 2 * I_G) { const int up = r >= I_G; if (up) r -= I_G; const int le = r >> 8, kb = (r >> 4) & 15, nb = r & 15, n0 = nb * 32;
        t.N = DE; t.K = DM; t.src = a.in[up ? 21 : 20] + (size_t)le * DM * DE + (size_t)(kb * 64) * DE + n0; t.dst = (bf16*)(ws + WS_WGU) + (size_t)(le * 1024 + (n0 >> 7) * 256 + (n0 & 127) + up * 128) * DM + kb * 64; return t; } r -= 2 * I_G;
    { const int le = r >> 8, kb = (r >> 5) & 7, nb = r & 31; t.N = DM; t.K = DE; t.src = a.in[22] + (size_t)le * DE * DM + (size_t)(kb * 64) * DM + nb * 32; t.dst = (bf16*)(ws + WS_WD) + (size_t)(le * 1024 + nb * 32) * DE + kb * 64; }
    return t;
}
__device__ __forceinline__ void titem_load(const TItem& t, float (&tv)[32], int lane) {
#pragma unroll
    for (int i = 0; i < 32; ++i) tv[i] = t.src[(size_t)(2 * i + (lane >> 5)) * t.N + (lane & 31)];
}
__device__ __forceinline__ void titem_store(const TItem& t, const float (&tv)[32], LAS float* scr, int lane) {
#pragma unroll
    for (int i = 0; i < 32; ++i) scr[(2 * i + (lane >> 5)) * 33 + (lane & 31)] = tv[i];
    asm volatile("s_waitcnt lgkmcnt(0)" ::: "memory");
    const int cc = lane & 7;
#pragma unroll
    for (int j = 0; j < 4; ++j) { const int n = (lane >> 3) + 8 * j; const LAS float* s = scr + (8 * cc) * 33 + n;
        u32x4 o; o.x = pk2(s[0 * 33], s[1 * 33]); o.y = pk2(s[2 * 33], s[3 * 33]); o.z = pk2(s[4 * 33], s[5 * 33]); o.w = pk2(s[6 * 33], s[7 * 33]);
        *(u32x4*)(t.dst + (size_t)n * t.K + 8 * cc) = o; }
    asm volatile("s_waitcnt lgkmcnt(0)" ::: "memory");
}
__device__ __forceinline__ void weights_prologue(const Ctx& c, const Args& a, unsigned char* ws) {
    LAS float* scr = (LAS float*)(c.lds + c.wave * 16384);
    constexpr int NITEMS = NL * 16 * 64 + NL * 16 * 32 + 2 * NL * NE * 16 * 16 + NL * NE * 8 * 32;
    int it = c.gw;
    if (it >= NITEMS) return;
    float tvA[32], tvB[32];
    TItem A = titem(a, ws, it), B = A;
    titem_load(A, tvA, c.lane);
    for (;;) {
        const bool hasB = it + c.ngw < NITEMS;
        if (hasB) { B = titem(a, ws, it + c.ngw); titem_load(B, tvB, c.lane); }
        titem_store(A, tvA, scr, c.lane);
        if (!hasB) break;
        it += 2 * c.ngw;
        const bool hasA = it < NITEMS;
        if (hasA) { A = titem(a, ws, it); titem_load(A, tvA, c.lane); }
        titem_store(B, tvB, scr, c.lane);
        if (!hasA) break;
    }
}

constexpr int PH_PER_LAYER = 7, N_PHASES = 1 + NL * PH_PER_LAYER;
struct Ptrs { bf16 *XB, *Z, *YN, *X1B, *H, *YS, *XBn, *GMW, *PWT, *POOLT; float *U, *RTG; unsigned* RTE; int *RTP, *LIST; };
__device__ __forceinline__ Ptrs make_ptrs(unsigned char* ws, int L) {
    Ptrs p; unsigned char* Ra = ws + WS_RA; unsigned char* Rb = ws + WS_RB; unsigned char* Xr = ws + WS_XBR; (void)L;
    p.XB = (bf16*)Xr; p.Z = (bf16*)Rb; p.YN = (bf16*)Ra; p.U = (float*)Rb; p.X1B = (bf16*)Xr; p.H = (bf16*)Ra; p.YS = (bf16*)Rb; p.XBn = (bf16*)Xr;
    p.GMW = (bf16*)(ws + WS_GMW); p.PWT = (bf16*)(ws + WS_PWT); p.POOLT = (bf16*)(ws + WS_POOLT);
    p.RTE = (unsigned*)(ws + WS_RT); p.RTG = (float*)(ws + WS_RT + 256 * 1024); p.RTP = (int*)(ws + WS_RT + 512 * 1024); p.LIST = (int*)(ws + WS_RT + MiB);
    return p;
}
template <int L>
__device__ __forceinline__ void run_layer(const Args& args, const Ctx& c0, const XcdBarrier& bar, const bool one, const int lo, const int hi) {
    constexpr int PB = 1 + L * PH_PER_LAYER;
    unsigned char* ws = args.ws;
    const Ptrs P = make_ptrs(ws, L);
    const float* X = (L == 0) ? args.in[0] : args.out;
    unsigned* CNT = (unsigned*)ws + CW_CNT + 64 * L;
#define IN(k) (lo <= PB + (k) && PB + (k) < hi)
#define PHASE_CTX Ctx c = c0; asm volatile("" : "+v"(c.tid)); c.lane = c.tid & 63; c.gtid = blockIdx.x * NT + c.tid
#define SEAM(k) do { if (one && PB + (k) + 1 < hi) xcd_barrier(bar); } while (0)
    if (IN(0)) { PHASE_CTX; pg8::Gemm g{P.XB, (const bf16*)(ws + WS_WIN) + (size_t)L * DIN * DM, M, DIN, DM}; pg8::StaticOrder S; S.init(M, DIN, (int)gridDim.x, (int)blockIdx.x);
        pg8::EpiBf16<0> E{P.Z, DIN, nullptr, 0, 0, 1.f, 0xffff};
        pg8::gemm_phase<pg8::EpiBf16<0>, pg8::StaticOrder, true, true>(c.lds, g, S, E, c.tid); SEAM(0); }
    if (IN(1)) { PHASE_CTX; const Lw w = layer_weights(args, L); for (int r = 0; r < RPT_MIX; ++r) mixer_phase(c, w, L, P.Z, P.GMW, P.PWT, P.POOLT, P.YN); SEAM(1); }
    if (IN(2)) { PHASE_CTX; pg8::Gemm g{P.YN, (const bf16*)(ws + WS_WO) + (size_t)L * DM * DM, M, DM, DM}; pg8::StaticOrder S; S.init(M, DM, (int)gridDim.x, (int)blockIdx.x);
        pg8::EpiResF32 E{X, P.U, ALPHA};
        pg8::gemm_phase<pg8::EpiResF32, pg8::StaticOrder, true, true>(c.lds, g, S, E, c.tid); SEAM(2); }
    if (IN(3)) { PHASE_CTX; const Lw w = layer_weights(args, L); for (int r = 0; r < RPT_LN1; ++r) nv_ln1_router(c, w, P.U, P.X1B, P.RTE, P.RTG); moe_ranks(c, P.RTE, P.RTP, CNT, P.LIST); SEAM(3); }
    if (IN(4)) { PHASE_CTX; moe_tiles(c, CNT); pg8::MoeOrder S{(const LAS int*)(c.lds + LDS_TAB_OFF), (int)gridDim.x, (int)blockIdx.x};
        moe_idx_tables(c, S, CNT, P.LIST);
        pg8::Gemm g{P.X1B, (const bf16*)(ws + WS_WGU) + (size_t)L * NE * 1024 * DM, 0, 0, DM};
        pg8::EpiSwiGLU E{P.H};
        pg8::gemm_phase<pg8::EpiSwiGLU, pg8::MoeOrder, true, true, true>(c.lds, g, S, E, c.tid, (const LAS int*)(c.lds + LDS_IDX_OFF)); SEAM(4); }
    if (IN(5)) { PHASE_CTX; moe_tiles(c, CNT); pg8::MoeOrder S{(const LAS int*)(c.lds + LDS_TAB_OFF), (int)gridDim.x, (int)blockIdx.x};
        pg8::Gemm g{P.H, (const bf16*)(ws + WS_WD) + (size_t)L * NE * 1024 * DE, 0, 0, DE};
        pg8::EpiBf16<0> E{P.YS, DM, nullptr, 0, 0, 1.f, 3};
        pg8::gemm_phase<pg8::EpiBf16<0>, pg8::MoeOrder, true, true>(c.lds, g, S, E, c.tid); SEAM(5); }
    if (IN(6)) { PHASE_CTX; const Lw w = layer_weights(args, L); moe_tiles(c, CNT); moe_combine_ln2(c, w, P.X1B, P.YS, P.RTE, P.RTG, P.RTP, args.out, P.XBn); SEAM(6); }
#undef IN
#undef SEAM
#undef PHASE_CTX
}
__global__ void __launch_bounds__(NT, 2) fwd_kernel(Args args) {
    extern __shared__ __attribute__((aligned(16))) unsigned char lds_raw[];
    Ctx c;
    c.lds = (LAS unsigned char*)lds_raw;
    c.tid = threadIdx.x; c.lane = c.tid & 63; c.wave = __builtin_amdgcn_readfirstlane(c.tid >> 6);
    c.gtid = blockIdx.x * NT + c.tid; c.gsize = gridDim.x * NT; c.gw = blockIdx.x * NWAVES + c.wave; c.ngw = gridDim.x * NWAVES;
    volatile LAS unsigned* MISC = (volatile LAS unsigned*)(c.lds + LDS_BYTES - 64);
    if (c.tid < 16) MISC[c.tid] = 0u;
    __syncthreads();
    XcdBarrier bar; bar.bar = (unsigned*)args.ws + CW_BAR; bar.x = 0; bar.st = nullptr;
    const int lo = args.ph_lo, hi = args.ph_hi;
    const bool one = (hi - lo) > 1;
    if (one) bar = xcd_barrier_post((unsigned*)args.ws + CW_BAR, MISC + 8);
    if (lo <= 0 && 0 < hi) {
        const Ptrs P = make_ptrs(args.ws, 0);
        Ctx c0 = c; asm volatile("" : "+v"(c.tid)); c.lane = c.tid & 63; c.gtid = blockIdx.x * NT + c.tid;
        for (int r = 0; r < RPT_PRO; ++r) { nv_prologue(c, args.in[0], P.XB); small_weights(c, args, P.GMW, P.PWT, P.POOLT); weights_prologue(c, args, args.ws); }
        if (one && 1 < hi) xcd_barrier(bar);
    }
    run_layer<0>(args, c, bar, one, lo, hi);
    run_layer<1>(args, c, bar, one, lo, hi);
}

extern "C" void kernel_launch(void* const* d_in, const int* in_sizes, int n_in, void* d_out, int out_size, void* d_ws, size_t ws_size, hipStream_t stream) {
    static int grid = 0;
    if (grid == 0) {
        if (n_in != 25 || in_sizes[0] != M * DM || out_size != M * DM || ws_size < WS_END) { fprintf(stderr, "kernel_launch: unexpected shapes/ws (n_in %d ws %zu)\n", n_in, ws_size); grid = -1; return; }
        int dev = 0, cus = 0;
        if (hipGetDevice(&dev) != hipSuccess || hipDeviceGetAttribute(&cus, hipDeviceAttributeMultiprocessorCount, dev) != hipSuccess) { grid = -1; return; }
        if (hipFuncSetAttribute((const void*)fwd_kernel, hipFuncAttributeMaxDynamicSharedMemorySize, LDS_BYTES) != hipSuccess) { grid = -1; return; }
        (void)hipGetLastError();
        grid = cus;
    }
    if (grid < 0) return;
    (void)hipMemsetAsync((char*)d_ws + WS_CTL, 0, CTL_ZERO_BYTES, stream);
    Args a{};
    for (int i = 0; i < 25; ++i) a.in[i] = (const float*)d_in[i];
    a.out = (float*)d_out; a.ws = (unsigned char*)d_ws;
#if MK_ONE_LAUNCH
    a.ph_lo = 0; a.ph_hi = N_PHASES;
    hipLaunchKernelGGL(fwd_kernel, dim3(grid), dim3(NT), LDS_BYTES, stream, a);
#else
    for (int ph = 0; ph < N_PHASES; ++ph) { a.ph_lo = ph; a.ph_hi = ph + 1; hipLaunchKernelGGL(fwd_kernel, dim3(grid), dim3(NT), LDS_BYTES, stream, a); }
#endif
}
```
